# Optimizing an MI355X kernel written in HIP

```python
import math
import jax, jax.numpy as jnp
from jax import lax
import numpy as np

D_MODEL = 2048
BATCH = 4
SEQ = 8192
DEPTH = 2

MIX_WIDTH = D_MODEL
S5_WIDTH = MIX_WIDTH // 4
SGU_WIDTH = MIX_WIDTH // 2
POOL_WIDTH = MIX_WIDTH - S5_WIDTH - SGU_WIDTH
S5_GROUP_CH = 16
S5_GROUPS = S5_WIDTH // S5_GROUP_CH
S5_STATE = 64
DT_MIN = 0.001
DT_MAX = 0.1
CHUNK = 128
SGU_HEAD_DIM = 128
SGU_HEADS = SGU_WIDTH // SGU_HEAD_DIM
POOL_WINDOWS = (2, 4, 8, 16)
POOL_GROUPS = len(POOL_WINDOWS)
POOL_GROUP_CH = POOL_WIDTH // POOL_GROUPS
SPLIT_SIZES = (S5_WIDTH, SGU_WIDTH, SGU_WIDTH, POOL_WIDTH, S5_WIDTH, SGU_WIDTH, POOL_WIDTH)
IN_COLS = sum(SPLIT_SIZES)
SPLIT_POINTS = tuple(int(s) for s in np.cumsum(SPLIT_SIZES)[:-1])
RMS_EPS = 1e-6
LN_EPS = 1e-5

kernel_name = 'hymba_style_s5_gmlp_pool_hybrid'


def rms_norm(x, g):
    xf = x.astype(jnp.float32)
    y = xf * lax.rsqrt(jnp.mean(xf * xf, axis=-1, keepdims=True) + RMS_EPS)
    return (y * g.astype(jnp.float32)).astype(x.dtype)


def s5_mixer(xa, lam_re, lam_im, b_re, b_im, c_re, c_im, d_skip, log_dt, w_glu, b_glu):
    bsz, seq, _ = xa.shape
    f32 = jnp.float32
    xg = xa.astype(f32).reshape(bsz, seq, S5_GROUPS, S5_GROUP_CH)
    lam = lax.complex(lam_re.astype(f32), lam_im.astype(f32))
    dt = jnp.exp(log_dt.astype(f32))[:, None]
    lam_bar = jnp.exp(lam * dt)
    b = lax.complex(b_re.astype(f32), b_im.astype(f32))
    b_bar = ((lam_bar - 1.0) / lam)[..., None] * b
    c = lax.complex(c_re.astype(f32), c_im.astype(f32))
    bu = jnp.einsum('blgh,gph->blgp', xg.astype(jnp.complex64), b_bar)
    a = jnp.broadcast_to(lam_bar, (1, seq) + lam_bar.shape)

    def combine(left, right):
        a_l, b_l = left
        a_r, b_r = right
        return a_r * a_l, a_r * b_l + b_r

    _, states = lax.associative_scan(combine, (a, bu), axis=1)
    y = jnp.einsum('blgp,ghp->blgh', states, c).real + d_skip.astype(f32) * xg
    y = jax.nn.gelu(y.reshape(bsz, seq, S5_WIDTH)).astype(xa.dtype)
    return y * jax.nn.sigmoid(y @ w_glu + b_glu)


def sgu_mixer(u, v, ln_g, ln_b, w_s, b_s):
    bsz, seq, _ = v.shape
    u = jax.nn.gelu(u)
    vf = jax.nn.gelu(v).astype(jnp.float32)
    mu = jnp.mean(vf, axis=-1, keepdims=True)
    var = jnp.mean(jnp.square(vf - mu), axis=-1, keepdims=True)
    vn = ((vf - mu) * lax.rsqrt(var + LN_EPS) * ln_g.astype(jnp.float32)
          + ln_b.astype(jnp.float32)).astype(v.dtype)
    vn = vn.reshape(bsz, seq // CHUNK, CHUNK, SGU_HEADS, SGU_HEAD_DIM)
    causal = jnp.tril(jnp.ones((CHUNK, CHUNK), dtype=bool))
    ws = jnp.where(causal[None], w_s, jnp.zeros_like(w_s))
    s = jnp.einsum('hts,bcshd->bcthd', ws, vn) + jnp.transpose(b_s)[:, :, None]
    return u * s.reshape(bsz, seq, SGU_WIDTH)


def pool_mixer(xc, w_pool, pool_scale):
    bsz, seq, _ = xc.shape
    xg = xc.astype(jnp.float32).reshape(bsz, seq, POOL_GROUPS, POOL_GROUP_CH)
    cs = jnp.cumsum(xg, axis=1)
    pos = jnp.arange(1, seq + 1, dtype=jnp.float32)[None, :, None]
    outs = []
    for g, w in enumerate(POOL_WINDOWS):
        c = cs[:, :, g]
        lagged = jnp.pad(c[:, :seq - w], ((0, 0), (w, 0), (0, 0)))
        mean = (c - lagged) / jnp.minimum(pos, float(w))
        outs.append(mean - xg[:, :, g])
    p = jnp.stack(outs, axis=2).astype(xc.dtype)
    y = jnp.einsum('blgc,gcd->blgd', p, w_pool).reshape(bsz, seq, POOL_WIDTH)
    return y * pool_scale


def setup_inputs(seed: int = 0) -> dict:
    key = jax.random.key(seed)
    ks = jax.random.split(key, 24)
    f32 = jnp.float32
    nrm = lambda k, shape: jax.random.normal(k, shape, dtype=f32)
    L, D = DEPTH, D_MODEL
    G, P, H = S5_GROUPS, S5_STATE, S5_GROUP_CH
    x = nrm(ks[0], (BATCH, SEQ, D))
    norm_g = 1.0 + 0.02 * nrm(ks[1], (L, D))
    w_in = nrm(ks[2], (L, D, IN_COLS)) * D ** -0.5
    lam_re = -0.5 + 0.01 * nrm(ks[3], (L, G, P))
    lam_im = math.pi * jnp.arange(P, dtype=f32)[None, None, :] + 0.01 * nrm(ks[4], (L, G, P))
    b_re = nrm(ks[5], (L, G, P, H)) * (2.0 * H) ** -0.5
    b_im = nrm(ks[6], (L, G, P, H)) * (2.0 * H) ** -0.5
    c_re = nrm(ks[7], (L, G, H, P)) * P ** -0.5
    c_im = nrm(ks[8], (L, G, H, P)) * P ** -0.5
    d_skip = nrm(ks[9], (L, G, H))
    log_dt = jax.random.uniform(ks[10], (L, G), dtype=f32,
                                minval=math.log(DT_MIN), maxval=math.log(DT_MAX))
    w_glu = nrm(ks[11], (L, S5_WIDTH, S5_WIDTH)) * S5_WIDTH ** -0.5
    b_glu = 0.01 * nrm(ks[12], (L, S5_WIDTH))
    ln_g = 1.0 + 0.02 * nrm(ks[13], (L, SGU_WIDTH))
    ln_b = 0.02 * nrm(ks[14], (L, SGU_WIDTH))
    w_s = nrm(ks[15], (L, SGU_HEADS, CHUNK, CHUNK)) * CHUNK ** -0.5
    b_s = 1.0 + 0.02 * nrm(ks[16], (L, SGU_HEADS, CHUNK))
    w_pool = nrm(ks[17], (L, POOL_GROUPS, POOL_GROUP_CH, POOL_GROUP_CH)) * POOL_GROUP_CH ** -0.5
    pool_scale = 1.0 + 0.1 * nrm(ks[18], (L, POOL_WIDTH))
    w_out = nrm(ks[19], (L, MIX_WIDTH, D)) * MIX_WIDTH ** -0.5
    final_g = 1.0 + 0.02 * nrm(ks[20], (D,))
    return {'x': x, 'norm_g': norm_g, 'w_in': w_in, 'lam_re': lam_re, 'lam_im': lam_im,
            'b_re': b_re, 'b_im': b_im, 'c_re': c_re, 'c_im': c_im, 'd_skip': d_skip,
            'log_dt': log_dt, 'w_glu': w_glu, 'b_glu': b_glu, 'ln_g': ln_g, 'ln_b': ln_b,
            'w_s': w_s, 'b_s': b_s, 'w_pool': w_pool, 'pool_scale': pool_scale,
            'w_out': w_out, 'final_g': final_g}


def reference(x, norm_g, w_in, lam_re, lam_im, b_re, b_im, c_re, c_im, d_skip, log_dt,
              w_glu, b_glu, ln_g, ln_b, w_s, b_s, w_pool, pool_scale, w_out, final_g):
    for i in range(DEPTH):
        h = rms_norm(x, norm_g[i])
        z = h @ w_in[i]
        xa, u, v, xc, ga, gb, gc = jnp.split(z, SPLIT_POINTS, axis=-1)
        ya = s5_mixer(xa, lam_re[i], lam_im[i], b_re[i], b_im[i], c_re[i], c_im[i],
                      d_skip[i], log_dt[i], w_glu[i], b_glu[i]) * jax.nn.silu(ga)
        yb = sgu_mixer(u, v, ln_g[i], ln_b[i], w_s[i], b_s[i]) * jax.nn.silu(gb)
        yc = pool_mixer(xc, w_pool[i], pool_scale[i]) * jax.nn.silu(gc)
        y = jnp.concatenate([ya.astype(x.dtype), yb.astype(x.dtype), yc.astype(x.dtype)], axis=-1)
        x = x + y @ w_out[i]
    return rms_norm(x, final_g)
```

```cpp
#include <hip/hip_runtime.h>
#include <cstdio>
#include <cstdint>

#ifndef MK_MULTI
#define MK_MULTI 0
#endif

#define LAS __attribute__((address_space(3)))
#define GAS __attribute__((address_space(1)))
typedef unsigned short bf16_t;
typedef short bf16x8 __attribute__((ext_vector_type(8)));
typedef float f32x4 __attribute__((ext_vector_type(4)));
typedef float f32x2 __attribute__((ext_vector_type(2)));
typedef unsigned u32x4 __attribute__((ext_vector_type(4)));
typedef unsigned u32x2 __attribute__((ext_vector_type(2)));
typedef unsigned long long u64;

constexpr int DM = 2048, NB = 4, SEQ = 8192, DEPTH = 2, MTOK = NB * SEQ;
constexpr int S5W = 512, SGUW = 1024, POOLW = 512, INC = 5120;
constexpr int S5G = 32, S5H = 16, S5P = 64;
constexpr int NSEG = MTOK / 16, SEGB = SEQ / 16;
constexpr float RMS_EPS = 1e-6f, LN_EPS = 1e-5f;
constexpr float SSQ_SCALE = 16777216.0f;

constexpr size_t MiB = 1u << 20;
constexpr size_t WS_CTL = 0, CTL_ZERO_BYTES = 64 * 1024;
constexpr size_t WS_SSQ = 1 * MiB;
constexpr size_t WS_POW = 2 * MiB;
constexpr size_t WS_BBAR = WS_POW + 640 * 1024;
constexpr size_t WS_PAR = 3 * MiB + 256 * 1024;
constexpr int PAR_BGLU = 0, PAR_LNG = 1024, PAR_LNB = 3072, PAR_BS = 5120, PAR_PSC = 7168, PAR_FG = 8192, PAR_N = 10240;
constexpr size_t WS_KT = 4 * MiB;
constexpr size_t WS_WEND = 5 * MiB;
constexpr size_t WS_WS5 = 9 * MiB;
constexpr size_t WS_WSG = 21 * MiB;
constexpr size_t WS_WGLU = 22 * MiB;
constexpr size_t WS_WPD = 23 * MiB;
constexpr size_t WS_WA = 24 * MiB;
constexpr size_t WS_WB = 56 * MiB;
constexpr size_t WS_WOUT = 64 * MiB;
constexpr size_t WS_XB = 80 * MiB;
constexpr size_t WS_XA = 208 * MiB;
constexpr size_t WS_GVT = 240 * MiB;
constexpr size_t WS_UG = 304 * MiB;
constexpr size_t WS_XC = 368 * MiB;
constexpr size_t WS_SG = 400 * MiB;
constexpr size_t WS_PF = 464 * MiB;
constexpr size_t WS_YG = 496 * MiB;
constexpr size_t WS_Y = 528 * MiB;
constexpr size_t WS_SE = 656 * MiB;
constexpr size_t WS_CARRY = 688 * MiB;
constexpr size_t WS_END = 704 * MiB;

__device__ __forceinline__ unsigned cvt_pk_bf16(float lo, float hi) { unsigned r; asm volatile("v_cvt_pk_bf16_f32 %0, %1, %2" : "=v"(r) : "v"(lo), "v"(hi)); return r; }
__device__ __forceinline__ float bf_lo(unsigned w) { return __uint_as_float(w << 16); }
__device__ __forceinline__ float bf_hi(unsigned w) { return __uint_as_float(w & 0xffff0000u); }
__device__ __forceinline__ float bf2f(bf16_t b) { return __uint_as_float(((unsigned)b) << 16); }
__device__ __forceinline__ float sigmoid_f(float x) { return __builtin_amdgcn_rcpf(1.0f + __builtin_amdgcn_exp2f(-1.4426950408889634f * x)); }
__device__ __forceinline__ float silu_f(float x) { return x * sigmoid_f(x); }
__device__ __forceinline__ float gelu_f(float x) {
    const float u = x * (1.0f + 0.044715f * x * x);
    return x * __builtin_amdgcn_rcpf(1.0f + __builtin_amdgcn_exp2f(-2.302208198f * u));
}
__device__ __forceinline__ float wave_sum(float v) {
#pragma unroll
    for (int o = 1; o < 64; o <<= 1) v += __shfl_xor(v, o);
    return v;
}

namespace pg8 {
constexpr int BM = 256, BK = 64, HALF = 128, HTB = HALF * BK * 2, STAGE_BYTES = 8 * HTB, NXCD = 8, WGM = 8;
__host__ __device__ __forceinline__ int lds_byte(int r, int c) { const int st = (r >> 4) * 2 + (c >> 5), rr = r & 15, cc = c & 31, ob = rr * 64 + cc * 2; return st * 1024 + (ob ^ (((ob >> 9) & 1) << 5)); }
__host__ __device__ __forceinline__ void stage_rc(int b, int& R, int& C) { const int st = b / 1024, sb = b % 1024, swz = sb ^ (((sb >> 9) & 1) << 5); R = (st >> 1) * 16 + swz / 64; C = (st & 1) * 32 + (swz % 64) / 2; }
__host__ __device__ __forceinline__ int perm32(int rho) { const int n = rho >> 4, i = rho & 15; return 8 * (i >> 2) + 4 * n + (i & 3); }

struct Unit { int pm, pn, type, cb; const char* A; const char* B; };
__device__ __forceinline__ void tile_of(int L, int nM, int nN, int& pm, int& pn) {
    const int nwg = nM * nN; int wgid = L; { const int q = nwg / NXCD, r = nwg % NXCD, xcd = wgid % NXCD, off = wgid / NXCD; wgid = (xcd < r ? xcd * (q + 1) : r * (q + 1) + (xcd - r) * q) + off; }
    const int nig = WGM * nN, gid = wgid / nig, fm = gid * WGM, gsz = (nM - fm) < WGM ? (nM - fm) : WGM;
    pm = fm + ((wgid % nig) % gsz); pn = (wgid % nig) / gsz;
}

template <class Epi, class Sched, bool ALIGN_EPI, bool SP2>
__device__ __forceinline__ void gemm_phase(LAS unsigned char* lds, const int K, const int ldA, const int ldB, const Sched& S, const Epi& E) {
    int tid_ = threadIdx.x; asm volatile("" : "+v"(tid_));
    const int tid = tid_, wid = __builtin_amdgcn_readfirstlane(tid >> 6), lane = tid & 63, wr = wid >> 2, wc = wid & 3, fr = lane & 15, fq = lane >> 4;
    const int nt = K / BK;
    unsigned voffA[2], voffB[2];
#pragma unroll
    for (int i = 0; i < 2; ++i) { int R, C; stage_rc(tid * 16 + i * 8192, R, C); const int Rb = (R & ~31) + perm32(R & 31);
        voffA[i] = (unsigned)(R * ldA + C) * 2u; voffB[i] = (unsigned)(Rb * ldB + C) * 2u; }
    const size_t kstep = (size_t)(BK * 2);
    const size_t hstepA = (size_t)HALF * ldA * 2, hstepB = (size_t)HALF * ldB * 2;
    const unsigned ldsw = (unsigned)wid * 1024u;
    const int aoff = lds_byte(wr * 64 + fr, fq * 8), boff = lds_byte(wc * 32 + fr, fq * 8);
#define PG8_SA(b, h) (((b) * 2 + (h)) * HTB)
#define PG8_SB(b, h) ((4 + (b) * 2 + (h)) * HTB)
#define PG8_STAGE(bufoff, gbase, voff) do { _Pragma("unroll") for (int _i = 0; _i < 2; ++_i) \
        __builtin_amdgcn_global_load_lds((const unsigned*)((const char*)(gbase) + (voff)[_i]), (LAS unsigned*)(lds + (bufoff) + ldsw + _i * 8192), 16, 0, 0); } while (0)
#define PG8_LDA(dst, b, h) do { _Pragma("unroll") for (int m = 0; m < 4; ++m) _Pragma("unroll") for (int k = 0; k < 2; ++k) dst[m][k] = *(const LAS bf16x8*)(lds + PG8_SA(b, h) + aoff + m * 2048 + k * 1024); } while (0)
#define PG8_LDB(dst, b, h) do { _Pragma("unroll") for (int n = 0; n < 2; ++n) _Pragma("unroll") for (int k = 0; k < 2; ++k) dst[n][k] = *(const LAS bf16x8*)(lds + PG8_SB(b, h) + boff + n * 2048 + k * 1024); } while (0)
#define PG8_MMA(ai, bj, At, Bt) do { __builtin_amdgcn_s_setprio(1); _Pragma("unroll") for (int m = 0; m < 4; ++m) _Pragma("unroll") for (int n = 0; n < 2; ++n) _Pragma("unroll") for (int k = 0; k < 2; ++k) \
        acc[ai][bj][m][n] = __builtin_amdgcn_mfma_f32_16x16x32_bf16(Bt[n][k], At[m][k], acc[ai][bj][m][n], 0, 0, 0); __builtin_amdgcn_s_setprio(0); } while (0)
#define PG8_WAIT_V(n) asm volatile("s_waitcnt vmcnt(" #n ")" ::: "memory")
#define PG8_WAIT_L(n) asm volatile("s_waitcnt lgkmcnt(" #n ")" ::: "memory")
#define PG8_BAR __builtin_amdgcn_s_barrier()
#define PG8_SCHED __builtin_amdgcn_sched_barrier(0)
    Unit cur, nxt; int ui = 0;
    if (!S.next(0, cur)) return;
    f32x4 acc[2][2][4][2];
#pragma unroll
    for (int a = 0; a < 2; ++a)
#pragma unroll
        for (int b = 0; b < 2; ++b)
#pragma unroll
            for (int m = 0; m < 4; ++m)
#pragma unroll
                for (int n = 0; n < 2; ++n) acc[a][b][m][n] = (f32x4){0.f, 0.f, 0.f, 0.f};
    bf16x8 At[4][2], B0[2][2], B1[2][2];
    const char* cA = cur.A; const char* cB = cur.B;
    if constexpr (SP2) {
        PG8_STAGE(PG8_SB(0, 0), cB, voffB); PG8_STAGE(PG8_SB(0, 1), cB + hstepB, voffB); PG8_STAGE(PG8_SA(0, 0), cA, voffA); PG8_STAGE(PG8_SA(0, 1), cA + hstepA, voffA);
        if (wr == 1) PG8_BAR;
        PG8_WAIT_V(2); PG8_BAR;
        PG8_STAGE(PG8_SB(1, 0), cB + kstep, voffB); PG8_STAGE(PG8_SA(1, 0), cA + kstep, voffA); PG8_STAGE(PG8_SB(1, 1), cB + hstepB + kstep, voffB);
        PG8_WAIT_V(6); PG8_BAR;
    } else {
        PG8_STAGE(PG8_SB(0, 0), cB, voffB); PG8_STAGE(PG8_SA(0, 0), cA, voffA); PG8_STAGE(PG8_SB(0, 1), cB + hstepB, voffB); PG8_STAGE(PG8_SA(0, 1), cA + hstepA, voffA);
        if (wr == 1) PG8_BAR;
        PG8_WAIT_V(4); PG8_BAR;
        PG8_STAGE(PG8_SB(1, 0), cB + kstep, voffB); PG8_STAGE(PG8_SA(1, 0), cA + kstep, voffA); PG8_STAGE(PG8_SB(1, 1), cB + hstepB + kstep, voffB);
        PG8_WAIT_V(6); PG8_BAR;
    }
    for (;;) {
        const bool has_next = S.next(ui + 1, nxt);
        const char* nA = has_next ? nxt.A : cA; const char* nB = has_next ? nxt.B : cB;
        for (int t = 0; t < nt; t += 2) {
            const bool last = (t == nt - 2);
            const char* a1 = cA + (size_t)(t + 1) * kstep;
            const char* a2 = last ? nA : cA + (size_t)(t + 2) * kstep; const char* b2 = last ? nB : cB + (size_t)(t + 2) * kstep;
            const char* a3 = a2 + kstep; const char* b3 = b2 + kstep;
            if constexpr (SP2) {
            PG8_LDB(B0, 0, 0); PG8_LDB(B1, 0, 1); PG8_SCHED; PG8_LDA(At, 0, 0); PG8_STAGE(PG8_SA(1, 1), a1 + hstepA, voffA);
            PG8_WAIT_V(8); PG8_WAIT_L(0); PG8_BAR; PG8_MMA(0, 0, At, B0); PG8_MMA(0, 1, At, B1); PG8_BAR; PG8_SCHED;
            PG8_LDA(At, 0, 1); PG8_STAGE(PG8_SB(0, 0), b2, voffB); PG8_STAGE(PG8_SB(0, 1), b2 + hstepB, voffB); PG8_STAGE(PG8_SA(0, 0), a2, voffA);
            PG8_WAIT_V(8); PG8_WAIT_L(0); PG8_BAR; PG8_MMA(1, 0, At, B0); PG8_MMA(1, 1, At, B1); PG8_BAR; PG8_SCHED;
            PG8_LDB(B0, 1, 0); PG8_LDB(B1, 1, 1); PG8_SCHED; PG8_LDA(At, 1, 0); PG8_STAGE(PG8_SA(0, 1), a2 + hstepA, voffA);
            PG8_WAIT_V(8); PG8_WAIT_L(0); PG8_BAR; PG8_MMA(0, 0, At, B0); PG8_MMA(0, 1, At, B1); PG8_BAR; PG8_SCHED;
            PG8_LDA(At, 1, 1); PG8_STAGE(PG8_SB(1, 0), b3, voffB); PG8_STAGE(PG8_SB(1, 1), b3 + hstepB, voffB); PG8_STAGE(PG8_SA(1, 0), a3, voffA);
            PG8_WAIT_V(8); PG8_WAIT_L(0); PG8_BAR; PG8_MMA(1, 0, At, B0); PG8_MMA(1, 1, At, B1); PG8_BAR; PG8_SCHED;
            } else {
            PG8_LDB(B0, 0, 0); PG8_SCHED; PG8_LDA(At, 0, 0); PG8_STAGE(PG8_SA(1, 1), a1 + hstepA, voffA);
            PG8_WAIT_L(8); PG8_BAR; PG8_WAIT_L(0); PG8_MMA(0, 0, At, B0); PG8_BAR; PG8_SCHED;
            PG8_LDB(B1, 0, 1); PG8_STAGE(PG8_SB(0, 0), b2, voffB);
            PG8_BAR; PG8_WAIT_L(0); PG8_MMA(0, 1, At, B1); PG8_BAR;
            PG8_LDA(At, 0, 1); PG8_STAGE(PG8_SA(0, 0), a2, voffA);
            PG8_BAR; PG8_WAIT_L(0); PG8_MMA(1, 0, At, B0); PG8_BAR; PG8_SCHED;
            PG8_STAGE(PG8_SB(0, 1), b2 + hstepB, voffB);
            PG8_WAIT_V(6); PG8_BAR; PG8_MMA(1, 1, At, B1); PG8_BAR;
            PG8_LDB(B0, 1, 0); PG8_SCHED; PG8_LDA(At, 1, 0); PG8_STAGE(PG8_SA(0, 1), a2 + hstepA, voffA);
            PG8_WAIT_L(8); PG8_BAR; PG8_WAIT_L(0); PG8_MMA(0, 0, At, B0); PG8_BAR; PG8_SCHED;
            PG8_LDB(B1, 1, 1); PG8_STAGE(PG8_SB(1, 0), b3, voffB);
            PG8_BAR; PG8_WAIT_L(0); PG8_MMA(0, 1, At, B1); PG8_BAR;
            PG8_LDA(At, 1, 1); PG8_STAGE(PG8_SA(1, 0), a3, voffA);
            PG8_BAR; PG8_WAIT_L(0); PG8_MMA(1, 0, At, B0); PG8_BAR; PG8_SCHED;
            PG8_STAGE(PG8_SB(1, 1), b3 + hstepB, voffB);
            PG8_WAIT_V(6); PG8_BAR; PG8_MMA(1, 1, At, B1); PG8_BAR;
            }
        }
        if constexpr (ALIGN_EPI) { if (wr == 0) PG8_BAR; }
        E(acc, cur, wr, wc, fr, fq);
        if (!has_next) break;
#pragma unroll
        for (int a = 0; a < 2; ++a)
#pragma unroll
            for (int b = 0; b < 2; ++b)
#pragma unroll
                for (int m = 0; m < 4; ++m)
#pragma unroll
                    for (int n = 0; n < 2; ++n) acc[a][b][m][n] = (f32x4){0.f, 0.f, 0.f, 0.f};
        cur = nxt; cA = nA; cB = nB; ++ui;
        if constexpr (ALIGN_EPI) { if (wr == 1) PG8_BAR; }
    }
    PG8_WAIT_V(0);
    if constexpr (!ALIGN_EPI) { if (wr == 0) PG8_BAR; }
    PG8_BAR;
#undef PG8_SA
#undef PG8_SB
#undef PG8_STAGE
#undef PG8_LDA
#undef PG8_LDB
#undef PG8_MMA
#undef PG8_WAIT_V
#undef PG8_WAIT_L
#undef PG8_BAR
#undef PG8_SCHED
}
}
using pg8::Unit;

struct SchedIn {
    int G, c; const char* XB; const char* WA; const char* WB;
    __device__ __forceinline__ bool next(int i, Unit& u) const {
        const int L = i * G + c;
        if (L < 2048) { pg8::tile_of(L, 128, 16, u.pm, u.pn);
            u.A = XB + (size_t)u.pm * 256 * DM * 2; u.B = WA + (size_t)u.pn * 256 * DM * 2;
            const int pn = u.pn;
            if (pn < 2) { u.type = 0; u.cb = 256 * pn; }
            else if (pn < 10) { u.type = 1; u.cb = 128 * (pn - 2); }
            else if (pn < 12) { u.type = 2; u.cb = 256 * (pn - 10); }
            else { u.type = 3; u.cb = 256 * (pn - 12); }
            return true; }
        const int L2 = L - 2048; if (L2 >= 512) return false;
        pg8::tile_of(L2, 4, 128, u.pm, u.pn);
        u.A = WB + (size_t)u.pm * 256 * DM * 2; u.B = XB + (size_t)u.pn * 256 * DM * 2; u.type = 4; u.cb = 0; return true;
    }
};
struct SchedMix {
    int G, c; const char* YG; const char* PF; const char* WG; const char* WP;
    __device__ __forceinline__ bool next(int i, Unit& u) const {
        const int L = i * G + c; if (L >= 512) return false;
        pg8::tile_of(L, 128, 4, u.pm, u.pn);
        if (u.pn < 2) { u.type = 0; u.cb = 256 * u.pn; u.A = YG + (size_t)u.pm * 256 * 512 * 2; u.B = WG + (size_t)u.pn * 256 * 512 * 2; }
        else { u.type = 1; u.cb = 256 * (u.pn - 2); u.A = PF + (size_t)u.pm * 256 * 512 * 2; u.B = WP + (size_t)(u.pn - 2) * 256 * 512 * 2; }
        return true;
    }
};
struct SchedOut {
    int G, c; const char* Y; const char* W;
    __device__ __forceinline__ bool next(int i, Unit& u) const {
        const int L = i * G + c; if (L >= 1024) return false;
        pg8::tile_of(L, 128, 8, u.pm, u.pn); u.type = 0; u.cb = 256 * u.pn;
        u.A = Y + (size_t)u.pm * 256 * DM * 2; u.B = W + (size_t)u.pn * 256 * DM * 2; return true;
    }
};

struct EpiIn {
    const u64* ssq; bf16_t *XA, *UG, *XC, *SG, *GVT;
    __device__ __forceinline__ float rstd_of(int row) const { return rsqrtf((float)ssq[row] * (1.0f / (SSQ_SCALE * (float)DM)) + RMS_EPS); }
    __device__ __forceinline__ void operator()(const f32x4 (&acc)[2][2][4][2], const Unit& u, int wr, int wc, int fr, int fq) const {
        const int type = u.type;
        if (type == 4) {
            const int col0 = u.pn * 256 + wc * 32 + 8 * fq;
            float cs[2][8];
#pragma unroll
            for (int bj = 0; bj < 2; ++bj)
#pragma unroll
                for (int e = 0; e < 8; ++e) cs[bj][e] = rstd_of(col0 + bj * 128 + e);
#pragma unroll
            for (int ai = 0; ai < 2; ++ai)
#pragma unroll
                for (int m = 0; m < 4; ++m) {
                    const int r = u.pm * 256 + ai * 128 + wr * 64 + m * 16 + fr; bf16_t* rowp = GVT + (size_t)r * MTOK + col0;
#pragma unroll
                    for (int bj = 0; bj < 2; ++bj) { const f32x4 v0 = acc[ai][bj][m][0], v1 = acc[ai][bj][m][1]; u32x4 w;
                        w.x = cvt_pk_bf16(gelu_f(v0[0] * cs[bj][0]), gelu_f(v0[1] * cs[bj][1])); w.y = cvt_pk_bf16(gelu_f(v0[2] * cs[bj][2]), gelu_f(v0[3] * cs[bj][3]));
                        w.z = cvt_pk_bf16(gelu_f(v1[0] * cs[bj][4]), gelu_f(v1[1] * cs[bj][5])); w.w = cvt_pk_bf16(gelu_f(v1[2] * cs[bj][6]), gelu_f(v1[3] * cs[bj][7]));
                        *(u32x4*)(rowp + bj * 128) = w; }
                }
            return;
        }
        const int row0 = u.pm * 256 + wr * 64 + fr, cw = wc * 32 + 8 * fq;
        if (type == 1) {
#pragma unroll
            for (int ai = 0; ai < 2; ++ai)
#pragma unroll
                for (int m = 0; m < 4; ++m) { const int row = row0 + ai * 128 + m * 16; const float rs = rstd_of(row);
                    const f32x4 a0 = acc[ai][0][m][0] * rs, a1 = acc[ai][0][m][1] * rs, g0 = acc[ai][1][m][0] * rs, g1 = acc[ai][1][m][1] * rs; u32x4 w;
                    w.x = cvt_pk_bf16(gelu_f(a0[0]) * silu_f(g0[0]), gelu_f(a0[1]) * silu_f(g0[1])); w.y = cvt_pk_bf16(gelu_f(a0[2]) * silu_f(g0[2]), gelu_f(a0[3]) * silu_f(g0[3]));
                    w.z = cvt_pk_bf16(gelu_f(a1[0]) * silu_f(g1[0]), gelu_f(a1[1]) * silu_f(g1[1])); w.w = cvt_pk_bf16(gelu_f(a1[2]) * silu_f(g1[2]), gelu_f(a1[3]) * silu_f(g1[3]));
                    *(u32x4*)(UG + (size_t)row * 1024 + u.cb + cw) = w; }
            return;
        }
        bf16_t* base = type == 0 ? XA : (type == 2 ? XC : SG); const int ld = type == 3 ? 1024 : 512;
#pragma unroll
        for (int ai = 0; ai < 2; ++ai)
#pragma unroll
            for (int m = 0; m < 4; ++m) { const int row = row0 + ai * 128 + m * 16; const float rs = rstd_of(row); bf16_t* rowp = base + (size_t)row * ld + u.cb + cw;
#pragma unroll
                for (int bj = 0; bj < 2; ++bj) { f32x4 v0 = acc[ai][bj][m][0] * rs, v1 = acc[ai][bj][m][1] * rs;
                    if (type == 3) {
#pragma unroll
                        for (int e = 0; e < 4; ++e) { v0[e] = silu_f(v0[e]); v1[e] = silu_f(v1[e]); } }
                    u32x4 w; w.x = cvt_pk_bf16(v0[0], v0[1]); w.y = cvt_pk_bf16(v0[2], v0[3]); w.z = cvt_pk_bf16(v1[0], v1[1]); w.w = cvt_pk_bf16(v1[2], v1[3]);
                    *(u32x4*)(rowp + bj * 128) = w; } }
    }
};
struct EpiMix {
    const bf16_t *YG, *SG; const float *bglu, *pscale; bf16_t* Y;
    __device__ __forceinline__ void operator()(const f32x4 (&acc)[2][2][4][2], const Unit& u, int wr, int wc, int fr, int fq) const {
        const int row0 = u.pm * 256 + wr * 64 + fr, cw = u.cb + wc * 32 + 8 * fq;
        f32x4 cv[2][2];
#pragma unroll
        for (int bj = 0; bj < 2; ++bj)
#pragma unroll
            for (int n = 0; n < 2; ++n) cv[bj][n] = *(const f32x4*)((u.type == 0 ? bglu : pscale) + cw + bj * 128 + 4 * n);
#pragma unroll
        for (int ai = 0; ai < 2; ++ai)
#pragma unroll
            for (int m = 0; m < 4; ++m) { const int row = row0 + ai * 128 + m * 16;
#pragma unroll
                for (int bj = 0; bj < 2; ++bj) { const int col = cw + bj * 128; const f32x4 a0 = acc[ai][bj][m][0], a1 = acc[ai][bj][m][1]; float o[8];
                    if (u.type == 0) {
                        const u32x4 yg = *(const u32x4*)(YG + (size_t)row * 512 + col), sg = *(const u32x4*)(SG + (size_t)row * 1024 + col);
                        o[0] = bf_lo(yg.x) * sigmoid_f(a0[0] + cv[bj][0][0]) * bf_lo(sg.x); o[1] = bf_hi(yg.x) * sigmoid_f(a0[1] + cv[bj][0][1]) * bf_hi(sg.x);
                        o[2] = bf_lo(yg.y) * sigmoid_f(a0[2] + cv[bj][0][2]) * bf_lo(sg.y); o[3] = bf_hi(yg.y) * sigmoid_f(a0[3] + cv[bj][0][3]) * bf_hi(sg.y);
                        o[4] = bf_lo(yg.z) * sigmoid_f(a1[0] + cv[bj][1][0]) * bf_lo(sg.z); o[5] = bf_hi(yg.z) * sigmoid_f(a1[1] + cv[bj][1][1]) * bf_hi(sg.z);
                        o[6] = bf_lo(yg.w) * sigmoid_f(a1[2] + cv[bj][1][2]) * bf_lo(sg.w); o[7] = bf_hi(yg.w) * sigmoid_f(a1[3] + cv[bj][1][3]) * bf_hi(sg.w);
                        u32x4 w; w.x = cvt_pk_bf16(o[0], o[1]); w.y = cvt_pk_bf16(o[2], o[3]); w.z = cvt_pk_bf16(o[4], o[5]); w.w = cvt_pk_bf16(o[6], o[7]);
                        *(u32x4*)(Y + (size_t)row * DM + col) = w;
                    } else {
                        const u32x4 sg = *(const u32x4*)(SG + (size_t)row * 1024 + 512 + col);
                        o[0] = a0[0] * cv[bj][0][0] * bf_lo(sg.x); o[1] = a0[1] * cv[bj][0][1] * bf_hi(sg.x); o[2] = a0[2] * cv[bj][0][2] * bf_lo(sg.y); o[3] = a0[3] * cv[bj][0][3] * bf_hi(sg.y);
                        o[4] = a1[0] * cv[bj][1][0] * bf_lo(sg.z); o[5] = a1[1] * cv[bj][1][1] * bf_hi(sg.z); o[6] = a1[2] * cv[bj][1][2] * bf_lo(sg.w); o[7] = a1[3] * cv[bj][1][3] * bf_hi(sg.w);
                        u32x4 w; w.x = cvt_pk_bf16(o[0], o[1]); w.y = cvt_pk_bf16(o[2], o[3]); w.z = cvt_pk_bf16(o[4], o[5]); w.w = cvt_pk_bf16(o[6], o[7]);
                        *(u32x4*)(Y + (size_t)row * DM + 1536 + col) = w;
                    } } }
    }
};
struct EpiOut {
    const float* base; float* out; bf16_t* XB; u64* ssq_next;
    __device__ __forceinline__ void operator()(const f32x4 (&acc)[2][2][4][2], const Unit& u, int wr, int wc, int fr, int fq) const {
        const int row0 = u.pm * 256 + wr * 64 + fr, cw = u.cb + wc * 32 + 8 * fq;
#pragma unroll
        for (int ai = 0; ai < 2; ++ai)
#pragma unroll
            for (int m = 0; m < 4; ++m) { const int row = row0 + ai * 128 + m * 16; float s = 0.f;
#pragma unroll
                for (int bj = 0; bj < 2; ++bj) { const size_t off = (size_t)row * DM + cw + bj * 128;
                    const f32x4 v0 = *(const f32x4*)(base + off) + acc[ai][bj][m][0], v1 = *(const f32x4*)(base + off + 4) + acc[ai][bj][m][1];
                    *(f32x4*)(out + off) = v0; *(f32x4*)(out + off + 4) = v1;
                    u32x4 w; w.x = cvt_pk_bf16(v0[0], v0[1]); w.y = cvt_pk_bf16(v0[2], v0[3]); w.z = cvt_pk_bf16(v1[0], v1[1]); w.w = cvt_pk_bf16(v1[2], v1[3]);
                    *(u32x4*)(XB + off) = w;
                    s += (v0[0] * v0[0] + v0[1] * v0[1]) + (v0[2] * v0[2] + v0[3] * v0[3]) + (v1[0] * v1[0] + v1[1] * v1[1]) + (v1[2] * v1[2] + v1[3] * v1[3]); }
                s += __shfl_xor(s, 16); s += __shfl_xor(s, 32);
                if (fq == 0) atomicAdd(ssq_next + row, (u64)(s * SSQ_SCALE)); }
    }
};

#define XB_TMO      128
#define XB_XCNT(j)  (256  + 64 * (j))
#define XB_XSUB(j)  (1280 + 64 * (j))
#define XB_XGEN(j)  (2304 + 64 * (j))
#define XB_TOP      3328
#define XB_TOPGEN   3392
#define XCD_BAR_WORDS 3456
#define XB_SPIN_CAP (1u << 18)
__device__ __forceinline__ unsigned xb_ld(unsigned* p)              { return __hip_atomic_load(p, __ATOMIC_RELAXED, __HIP_MEMORY_SCOPE_AGENT); }
__device__ __forceinline__ unsigned xb_add(unsigned* p, unsigned v) { return __hip_atomic_fetch_add(p, v, __ATOMIC_RELAXED, __HIP_MEMORY_SCOPE_AGENT); }
__device__ __forceinline__ unsigned xb_xcc_id() { return (unsigned)__builtin_amdgcn_s_getreg((3 << 11) | 20) & 0xFu; }
#define XB_SPIN(cond, bar) do { unsigned _sp = 0; while (cond) { __builtin_amdgcn_s_sleep(1); \
    if ((++_sp & 255u) == 0u) { if (xb_ld(&(bar)[XB_TMO])) break; if (_sp > XB_SPIN_CAP) { atomicAdd(&(bar)[XB_TMO], 1u); break; } } } } while (0)
struct XcdBarrier { unsigned* bar; unsigned x; volatile LAS unsigned* st; };
__device__ __forceinline__ XcdBarrier xcd_barrier_post(unsigned* bar, volatile LAS unsigned* st) {
    XcdBarrier b; b.bar = bar; b.x = xb_xcc_id(); b.st = st;
    if (threadIdx.x == 0) (void)xb_add(&bar[XB_XCNT(b.x)], 1u);
    return b;
}
__device__ __forceinline__ void xcd_barrier_complete(unsigned* bar, unsigned x, unsigned& nloc, unsigned& nx) {
    const unsigned G = gridDim.x * gridDim.y * gridDim.z;
    unsigned sum, cnt, mine, sp = 0u;
    for (;;) {
        sum = 0u; cnt = 0u; mine = 0u;
#pragma unroll
        for (unsigned j = 0; j < 16; ++j) { const unsigned c = xb_ld(&bar[XB_XCNT(j)]); sum += c; cnt += (c > 0u) ? 1u : 0u; mine = (j == x) ? c : mine; }
        if (sum == G) break;
        __builtin_amdgcn_s_sleep(1);
        if ((++sp & 255u) == 0u) { if (xb_ld(&bar[XB_TMO])) break; if (sp > XB_SPIN_CAP) { atomicAdd(&bar[XB_TMO], 1u); break; } }
    }
    nloc = mine > 0u ? mine : 1u; nx = cnt > 0u ? cnt : 1u;
}
__device__ __forceinline__ void xcd_barrier(const XcdBarrier& b) {
    asm volatile("s_waitcnt vmcnt(0)" ::: "memory");
    __syncthreads();
    if (threadIdx.x == 0) {
        unsigned* bar = b.bar;
        __builtin_amdgcn_s_waitcnt(0);
        unsigned nloc = b.st[0], nx = b.st[1];
        if (nloc == 0u) { xcd_barrier_complete(bar, b.x, nloc, nx); b.st[0] = nloc; b.st[1] = nx; }
        const unsigned old = xb_add(&bar[XB_XSUB(b.x)], 1u);
        const unsigned gen = old / nloc;
        if (old + 1u == (gen + 1u) * nloc) {
            __builtin_amdgcn_fence(__ATOMIC_RELEASE, "agent");
            asm volatile("s_waitcnt vmcnt(0)" ::: "memory");
            const unsigned og = xb_add(&bar[XB_TOP], 1u);
            const unsigned tg = og / nx;
            if (og + 1u == (tg + 1u) * nx) xb_add(&bar[XB_TOPGEN], 1u);
            else XB_SPIN(xb_ld(&bar[XB_TOPGEN]) == tg, bar);
            __builtin_amdgcn_fence(__ATOMIC_ACQUIRE, "agent");
            xb_add(&bar[XB_XGEN(b.x)], 1u);
            asm volatile("s_waitcnt vmcnt(0)" ::: "memory");
        } else {
            XB_SPIN(xb_ld(&bar[XB_XGEN(b.x)]) == gen, bar);
            __builtin_amdgcn_fence(__ATOMIC_ACQUIRE, "agent");
            asm volatile("s_waitcnt vmcnt(0)" ::: "memory");
        }
    }
    __syncthreads();
}

constexpr int NWAVES = 8, NTHR = 512;
constexpr int RING_BYTES = 131072, LDSCTL_OFF = RING_BYTES, LDS_BYTES = 147456;
struct Args { const float* in[21]; float* out; unsigned char* ws; int ph_lo, ph_hi; };
struct Frame {
    LAS unsigned char* lds; int tid, lane, wave, vcu, G, gw, NGW; unsigned char* ws;
};
__device__ __forceinline__ Frame mkframe(unsigned char* ws, LAS unsigned char* lds) {
    Frame F; int tid = threadIdx.x; asm volatile("" : "+v"(tid)); int bx = blockIdx.x, G = gridDim.x; asm volatile("" : "+s"(bx), "+s"(G));
    F.lds = lds; F.tid = tid; F.lane = tid & 63; F.wave = __builtin_amdgcn_readfirstlane(tid >> 6);
    F.G = G; F.vcu = (G % 8 == 0) ? (bx % 8) * (G / 8) + bx / 8 : bx;
    F.gw = F.vcu * 8 + F.wave; F.NGW = G * 8; F.ws = ws; return F;
}
#define MFMA16(a, b, c) __builtin_amdgcn_mfma_f32_16x16x32_bf16((a), (b), (c), 0, 0, 0)

__device__ __forceinline__ void p0_transpose_item(const float* W, int K, int N, const float* gk, bf16_t* WT, int kb, int n0src, int rowdst, LAS float* scr, int lane) {
    const int k0 = 64 * kb;
#pragma unroll 8
    for (int i = 0; i < 32; ++i) { const int kk = 2 * i + (lane >> 5); float v = W[(size_t)(k0 + kk) * N + n0src + (lane & 31)]; if (gk) v *= gk[k0 + kk]; scr[kk * 33 + (lane & 31)] = v; }
    asm volatile("s_waitcnt lgkmcnt(0)" ::: "memory");
    const int c = lane & 7;
#pragma unroll
    for (int j = 0; j < 4; ++j) { const int n = (lane >> 3) + 8 * j; const LAS float* s = scr + (8 * c) * 33 + n;
        u32x4 o; o.x = cvt_pk_bf16(s[0 * 33], s[1 * 33]); o.y = cvt_pk_bf16(s[2 * 33], s[3 * 33]); o.z = cvt_pk_bf16(s[4 * 33], s[5 * 33]); o.w = cvt_pk_bf16(s[6 * 33], s[7 * 33]);
        *(u32x4*)(WT + (size_t)(rowdst + n) * K + k0 + 8 * c) = o; }
    asm volatile("s_waitcnt lgkmcnt(0)" ::: "memory");
}
__device__ __forceinline__ void win_map(int s, int& isB, int& row) {
    isB = 0;
    if (s < 512) row = s;
    else if (s < 1536) { const int j = (s - 512) >> 7, i = (s - 512) & 127; row = 512 + 256 * j + i; }
    else if (s < 2560) { isB = 1; row = s - 1536; }
    else if (s < 3072) row = s;
    else if (s < 3584) row = s;
    else if (s < 4608) { const int j = (s - 3584) >> 7, i = (s - 3584) & 127; row = 512 + 256 * j + 128 + i; }
    else row = 3584 + (s - 4608);
}
__device__ __forceinline__ void p0_prologue(const Frame& F, const Args& a) {
    const float* x = a.in[0]; const float* norm_g = a.in[1]; const float* w_in = a.in[2];
    const float *lam_re = a.in[3], *lam_im = a.in[4], *b_re = a.in[5], *b_im = a.in[6], *log_dt = a.in[10];
    const float *w_glu = a.in[11], *w_s = a.in[15], *w_pool = a.in[17], *w_out = a.in[19];
    unsigned char* ws = F.ws;
    LAS float* scr = (LAS float*)(F.lds + F.wave * 16384);
    constexpr int I_IN = 32 * 160, I_OUT = 32 * 64, I_GLU = 8 * 16, I_ALL = 2 * (I_IN + I_OUT + I_GLU);
    for (int it = F.gw; it < I_ALL; it += F.NGW) {
        int r = it; const int l = r / (I_IN + I_OUT + I_GLU); r -= l * (I_IN + I_OUT + I_GLU);
        if (r < I_IN) { const int kb = r / 160, nb = r % 160; int isB, row; win_map(32 * nb, isB, row);
            bf16_t* dst = isB ? (bf16_t*)(ws + WS_WB) + (size_t)l * 1024 * DM : (bf16_t*)(ws + WS_WA) + (size_t)l * 4096 * DM;
            p0_transpose_item(w_in + (size_t)l * DM * INC, DM, INC, norm_g + l * DM, dst, kb, 32 * nb, row, scr, F.lane); continue; }
        r -= I_IN;
        if (r < I_OUT) { const int kb = r / 64, nb = r % 64;
            p0_transpose_item(w_out + (size_t)l * DM * DM, DM, DM, nullptr, (bf16_t*)(ws + WS_WOUT) + (size_t)l * DM * DM, kb, 32 * nb, 32 * nb, scr, F.lane); continue; }
        r -= I_OUT;
        { const int kb = r / 16, nb = r % 16;
            p0_transpose_item(w_glu + (size_t)l * 512 * 512, 512, 512, nullptr, (bf16_t*)(ws + WS_WGLU) + (size_t)l * 512 * 512, kb, 32 * nb, 32 * nb, scr, F.lane); }
    }
    { bf16_t* XB = (bf16_t*)(ws + WS_XB); u64* ssq0 = (u64*)(ws + WS_SSQ);
      for (int m = F.gw; m < MTOK; m += F.NGW) {
          const f32x4* xr = (const f32x4*)(x + (size_t)m * DM) + F.lane; u32x2* o = (u32x2*)(XB + (size_t)m * DM) + F.lane; float s = 0.f;
#pragma unroll
          for (int j = 0; j < 8; ++j) { const f32x4 v = xr[64 * j]; s += (v[0] * v[0] + v[1] * v[1]) + (v[2] * v[2] + v[3] * v[3]);
              u32x2 w; w.x = cvt_pk_bf16(v[0], v[1]); w.y = cvt_pk_bf16(v[2], v[3]); o[64 * j] = w; }
          s = wave_sum(s);
          if (F.lane == 0) ssq0[m] = (u64)(s * SSQ_SCALE);
      } }
    const int gt = F.vcu * NTHR + F.tid, NGT = F.G * NTHR;
    { u64* ssq = (u64*)(ws + WS_SSQ) + MTOK; for (int i = gt; i < 2 * MTOK; i += NGT) ssq[i] = 0ull; }
    { float* PAR = (float*)(ws + WS_PAR);
      for (int i = gt; i < PAR_N; i += NGT) { float v;
          if (i < PAR_LNG) v = a.in[12][i - PAR_BGLU]; else if (i < PAR_LNB) v = a.in[13][i - PAR_LNG]; else if (i < PAR_BS) v = a.in[14][i - PAR_LNB];
          else if (i < PAR_PSC) v = a.in[16][i - PAR_BS]; else if (i < PAR_FG) v = a.in[18][i - PAR_PSC]; else v = a.in[20][i - PAR_FG];
          PAR[i] = v; } }
    { bf16_t* WSG = (bf16_t*)(ws + WS_WSG);
      for (int i = gt; i < 2 * 8 * 128 * 128; i += NGT) { const int s = i & 127, t = (i >> 7) & 127; WSG[i] = (bf16_t)(cvt_pk_bf16(s <= t ? w_s[i] : 0.f, 0.f) & 0xffffu); }
      bf16_t* WPD = (bf16_t*)(ws + WS_WPD);
      for (int i = gt; i < 2 * 512 * 512; i += NGT) { const int k = i & 511, n = (i >> 9) & 511, l = i >> 18; const int g = n >> 7;
          const float v = (k >> 7) == g ? w_pool[(((size_t)l * 4 + g) * 128 + (k & 127)) * 128 + (n & 127)] : 0.f;
          WPD[i] = (bf16_t)(cvt_pk_bf16(v, 0.f) & 0xffffu); } }
    { f32x2* POW = (f32x2*)(ws + WS_POW); f32x2* BBAR = (f32x2*)(ws + WS_BBAR);
      for (int i = gt; i < 2 * S5G * S5P; i += NGT) { const int lg = i >> 6;
          const double dt = exp((double)log_dt[lg]), lr = (double)lam_re[i], li = (double)lam_im[i];
          for (int n = 0; n <= 16; ++n) { const double mg = exp(lr * dt * n), th = li * dt * n; POW[(size_t)i * 17 + n] = (f32x2){(float)(mg * cos(th)), (float)(mg * sin(th))}; }
          const double mg = exp(lr * dt), th = li * dt, nr = mg * cos(th) - 1.0, ni = mg * sin(th), den = lr * lr + li * li;
          const double qr = (nr * lr + ni * li) / den, qi = (ni * lr - nr * li) / den;
          for (int h = 0; h < 16; ++h) { const double br = (double)b_re[(size_t)i * 16 + h], bi = (double)b_im[(size_t)i * 16 + h];
              BBAR[(size_t)i * 16 + h] = (f32x2){(float)(qr * br - qi * bi), (float)(qr * bi + qi * br)}; } } }
}
__device__ __forceinline__ void s5_tables_a(const Frame& F, const Args& a) {
    const float *c_re = a.in[7], *c_im = a.in[8], *d_skip = a.in[9];
    unsigned char* ws = F.ws; const f32x2* POW = (const f32x2*)(ws + WS_POW); const f32x2* BBAR = (const f32x2*)(ws + WS_BBAR);
    const int gt = F.vcu * NTHR + F.tid, NGT = F.G * NTHR;
    float* KT = (float*)(ws + WS_KT);
    for (int i = gt; i < 2 * S5G * 16 * 256; i += NGT) {
        const int h2 = i & 15, h = (i >> 4) & 15, d = (i >> 8) & 15, lg = i >> 12; float s = 0.f;
        for (int p = 0; p < 64; ++p) { const f32x2 pw = POW[((size_t)lg * 64 + p) * 17 + d], bb = BBAR[((size_t)lg * 64 + p) * 16 + h2];
            const float cr = c_re[((size_t)lg * 16 + h) * 64 + p], ci = c_im[((size_t)lg * 16 + h) * 64 + p];
            const float zr = pw.x * bb.x - pw.y * bb.y, zi = pw.x * bb.y + pw.y * bb.x; s += cr * zr - ci * zi; }
        if (d == 0 && h == h2) s += d_skip[lg * 16 + h];
        KT[i] = s; }
    bf16_t* WEND = (bf16_t*)(ws + WS_WEND);
    for (int i = gt; i < 2 * S5G * 128 * 256; i += NGT) {
        const int h = i & 15, t = (i >> 4) & 15, p2 = (i >> 8) & 127, lg = i >> 15, p = p2 & 63;
        const f32x2 pw = POW[((size_t)lg * 64 + p) * 17 + (15 - t)], bb = BBAR[((size_t)lg * 64 + p) * 16 + h];
        const float v = p2 < 64 ? pw.x * bb.x - pw.y * bb.y : pw.x * bb.y + pw.y * bb.x;
        WEND[i] = (bf16_t)(cvt_pk_bf16(v, 0.f) & 0xffffu); }
    bf16_t* WS5 = (bf16_t*)(ws + WS_WS5);
    for (int i = gt; i < 2 * S5G * 256 * 128; i += NGT) {
        const int p2 = i & 127, row = (i >> 7) & 255, lg = i >> 15, p = p2 & 63, t = row >> 4, h = row & 15;
        const f32x2 pw = POW[((size_t)lg * 64 + p) * 17 + (t + 1)];
        const float cr = c_re[((size_t)lg * 16 + h) * 64 + p], ci = c_im[((size_t)lg * 16 + h) * 64 + p];
        const float v = p2 < 64 ? cr * pw.x - ci * pw.y : -(cr * pw.y + ci * pw.x);
        WS5[((size_t)lg * 256 + row) * 384 + 256 + p2] = (bf16_t)(cvt_pk_bf16(v, 0.f) & 0xffffu); }
}
__device__ __forceinline__ void s5_tables_b(const Frame& F) {
    unsigned char* ws = F.ws; const float* KT = (const float*)(ws + WS_KT); bf16_t* WS5 = (bf16_t*)(ws + WS_WS5);
    const int gt = F.vcu * NTHR + F.tid, NGT = F.G * NTHR;
    for (int i = gt; i < 2 * S5G * 256 * 256; i += NGT) {
        const int k = i & 255, row = (i >> 8) & 255, lg = i >> 16, t = row >> 4, h = row & 15, t2 = k >> 4, h2 = k & 15;
        const float v = t2 <= t ? KT[(((size_t)lg * 16 + (t - t2)) * 16 + h) * 16 + h2] : 0.f;
        WS5[((size_t)lg * 256 + row) * 384 + k] = (bf16_t)(cvt_pk_bf16(v, 0.f) & 0xffffu); }
}

__device__ __forceinline__ void p2_ln(const Frame& F, const float* ln_g, const float* ln_b) {
    bf16_t* GVT = (bf16_t*)(F.ws + WS_GVT);
    LAS float* red = (LAS float*)F.lds;
    LAS float* stat = (LAS float*)(F.lds + 32768);
    const int o = F.tid & 15, r0 = F.tid >> 4;
    for (int c = F.vcu; c < MTOK / 128; c += F.G) {
        bf16_t* gp = GVT + (size_t)r0 * MTOK + c * 128 + 8 * o;
        float s[8], q[8];
#pragma unroll
        for (int j = 0; j < 8; ++j) { s[j] = 0.f; q[j] = 0.f; }
#pragma unroll 4
        for (int i = 0; i < 32; ++i) { const u32x4 v = *(const u32x4*)(gp + (size_t)(32 * i) * MTOK);
            const float e0 = bf_lo(v.x), e1 = bf_hi(v.x), e2 = bf_lo(v.y), e3 = bf_hi(v.y), e4 = bf_lo(v.z), e5 = bf_hi(v.z), e6 = bf_lo(v.w), e7 = bf_hi(v.w);
            s[0] += e0; q[0] += e0 * e0; s[1] += e1; q[1] += e1 * e1; s[2] += e2; q[2] += e2 * e2; s[3] += e3; q[3] += e3 * e3;
            s[4] += e4; q[4] += e4 * e4; s[5] += e5; q[5] += e5 * e5; s[6] += e6; q[6] += e6 * e6; s[7] += e7; q[7] += e7 * e7; }
#pragma unroll
        for (int j = 0; j < 8; ++j) { red[(r0 * 128 + 8 * o + j) * 2] = s[j]; red[(r0 * 128 + 8 * o + j) * 2 + 1] = q[j]; }
        __syncthreads();
        if (F.tid < 128) { float ss = 0.f, qq = 0.f;
            for (int r = 0; r < 32; ++r) { ss += red[(r * 128 + F.tid) * 2]; qq += red[(r * 128 + F.tid) * 2 + 1]; }
            const float mean = ss * (1.0f / 1024.0f), var = fmaxf(qq * (1.0f / 1024.0f) - mean * mean, 0.f);
            stat[F.tid * 2] = mean; stat[F.tid * 2 + 1] = rsqrtf(var + LN_EPS); }
        __syncthreads();
        float mu[8], rs[8];
#pragma unroll
        for (int j = 0; j < 8; ++j) { mu[j] = stat[(8 * o + j) * 2]; rs[j] = stat[(8 * o + j) * 2 + 1]; }
#pragma unroll 4
        for (int i = 0; i < 32; ++i) { const int ch = 32 * i + r0; const float g = ln_g[ch], b = ln_b[ch]; const u32x4 v = *(const u32x4*)(gp + (size_t)(32 * i) * MTOK); u32x4 w;
            w.x = cvt_pk_bf16((bf_lo(v.x) - mu[0]) * rs[0] * g + b, (bf_hi(v.x) - mu[1]) * rs[1] * g + b);
            w.y = cvt_pk_bf16((bf_lo(v.y) - mu[2]) * rs[2] * g + b, (bf_hi(v.y) - mu[3]) * rs[3] * g + b);
            w.z = cvt_pk_bf16((bf_lo(v.z) - mu[4]) * rs[4] * g + b, (bf_hi(v.z) - mu[5]) * rs[5] * g + b);
            w.w = cvt_pk_bf16((bf_lo(v.w) - mu[6]) * rs[6] * g + b, (bf_hi(v.w) - mu[7]) * rs[7] * g + b);
            *(u32x4*)(gp + (size_t)(32 * i) * MTOK) = w; }
        __syncthreads();
    }
}
__device__ __forceinline__ void p2_send(const Frame& F, int layer) {
    const bf16_t* WEND = (const bf16_t*)(F.ws + WS_WEND) + (size_t)layer * S5G * 128 * 256;
    const bf16_t* XA = (const bf16_t*)(F.ws + WS_XA); float* SE = (float*)(F.ws + WS_SE);
    const int c = F.lane & 15, q = F.lane >> 4;
    for (int it = F.gw; it < S5G * (NSEG / 16); it += F.NGW) {
        const int g = it & 31, st = it >> 5, seg = st * 16 + c;
        f32x4 acc[8];
#pragma unroll
        for (int r = 0; r < 8; ++r) acc[r] = (f32x4){0.f, 0.f, 0.f, 0.f};
        const bf16_t* xb = XA + ((size_t)seg * 16 + (q >> 1)) * 512 + 16 * g + 8 * (q & 1);
        const bf16_t* wb = WEND + ((size_t)g * 128 + c) * 256 + 8 * q;
#pragma unroll
        for (int ks = 0; ks < 8; ++ks) { const bf16x8 bx = *(const bf16x8*)(xb + (size_t)(2 * ks) * 512);
#pragma unroll
            for (int r = 0; r < 8; ++r) { const bf16x8 aw = *(const bf16x8*)(wb + (size_t)(16 * r) * 256 + 32 * ks); acc[r] = MFMA16(aw, bx, acc[r]); } }
#pragma unroll
        for (int r = 0; r < 8; ++r) *(f32x4*)(SE + ((size_t)seg * 32 + g) * 128 + 16 * r + 4 * q) = acc[r];
    }
}
__device__ __forceinline__ void p2_pool(const Frame& F) {
    const bf16_t* XC = (const bf16_t*)(F.ws + WS_XC); bf16_t* PF = (bf16_t*)(F.ws + WS_PF);
    const int gt = F.vcu * NTHR + F.tid, NGT = F.G * NTHR;
    for (int it = gt; it < (MTOK / 32) * 64; it += NGT) {
        const int o = it & 63, r = it >> 6, m0 = r * 32, tl0 = m0 & (SEQ - 1), mb = m0 - tl0, w = 2 << (o >> 4);
        const int ts = tl0 - (w - 1) > 0 ? tl0 - (w - 1) : 0;
        float sum[8];
#pragma unroll
        for (int j = 0; j < 8; ++j) sum[j] = 0.f;
        for (int tl = ts; tl < tl0 + 32; ++tl) {
            const u32x4 xv = *(const u32x4*)(XC + (size_t)(mb + tl) * 512 + 8 * o);
            float xe[8] = {bf_lo(xv.x), bf_hi(xv.x), bf_lo(xv.y), bf_hi(xv.y), bf_lo(xv.z), bf_hi(xv.z), bf_lo(xv.w), bf_hi(xv.w)};
#pragma unroll
            for (int j = 0; j < 8; ++j) sum[j] += xe[j];
            if (tl - w >= ts) { const u32x4 ov = *(const u32x4*)(XC + (size_t)(mb + tl - w) * 512 + 8 * o);
                sum[0] -= bf_lo(ov.x); sum[1] -= bf_hi(ov.x); sum[2] -= bf_lo(ov.y); sum[3] -= bf_hi(ov.y); sum[4] -= bf_lo(ov.z); sum[5] -= bf_hi(ov.z); sum[6] -= bf_lo(ov.w); sum[7] -= bf_hi(ov.w); }
            if (tl >= tl0) { const float inv = 1.0f / (float)(tl + 1 < w ? tl + 1 : w); u32x4 pw;
                pw.x = cvt_pk_bf16(sum[0] * inv - xe[0], sum[1] * inv - xe[1]); pw.y = cvt_pk_bf16(sum[2] * inv - xe[2], sum[3] * inv - xe[3]);
                pw.z = cvt_pk_bf16(sum[4] * inv - xe[4], sum[5] * inv - xe[5]); pw.w = cvt_pk_bf16(sum[6] * inv - xe[6], sum[7] * inv - xe[7]);
                *(u32x4*)(PF + (size_t)(mb + tl) * 512 + 8 * o) = pw; }
        }
    }
}

__device__ __forceinline__ void p3_scan(const Frame& F, int layer) {
    const f32x2* POW = (const f32x2*)(F.ws + WS_POW); const float* SE = (const float*)(F.ws + WS_SE); bf16_t* CARRY = (bf16_t*)(F.ws + WS_CARRY);
    LAS f32x2* ends = (LAS f32x2*)F.lds;
    const int p = F.tid & 63, sc = F.tid >> 6;
    for (int it = F.vcu; it < NB * S5G; it += F.G) {
        const int b = it >> 5, g = it & 31;
        const f32x2 l16 = POW[(((size_t)layer * S5G + g) * 64 + p) * 17 + 16];
        const int seg0 = b * SEGB + sc * 64;
        float sr = 0.f, si = 0.f;
#pragma unroll 8
        for (int j = 0; j < 64; ++j) { const float* e = SE + ((size_t)(seg0 + j) * 32 + g) * 128; const float er = e[p], ei = e[64 + p];
            const float nr = l16.x * sr - l16.y * si + er, ni = l16.x * si + l16.y * sr + ei; sr = nr; si = ni; }
        ends[sc * 64 + p] = (f32x2){sr, si};
        float mr = l16.x, mi = l16.y;
#pragma unroll
        for (int k = 0; k < 6; ++k) { const float tr = mr * mr - mi * mi, ti = 2.f * mr * mi; mr = tr; mi = ti; }
        __syncthreads();
        float cr = 0.f, ci = 0.f;
        for (int k = 0; k < sc; ++k) { const f32x2 e = ends[k * 64 + p]; const float nr = mr * cr - mi * ci + e.x, ni = mr * ci + mi * cr + e.y; cr = nr; ci = ni; }
        sr = cr; si = ci;
#pragma unroll 8
        for (int j = 0; j < 64; ++j) { const size_t base = ((size_t)(seg0 + j) * 32 + g) * 128; const float er = SE[base + p], ei = SE[base + 64 + p];
            CARRY[base + p] = (bf16_t)(cvt_pk_bf16(sr, 0.f) & 0xffffu); CARRY[base + 64 + p] = (bf16_t)(cvt_pk_bf16(si, 0.f) & 0xffffu);
            const float nr = l16.x * sr - l16.y * si + er, ni = l16.x * si + l16.y * sr + ei; sr = nr; si = ni; }
        __syncthreads();
    }
}
__device__ __forceinline__ void p3_sgu(const Frame& F, int layer, const float* b_s) {
    const bf16_t* WSG = (const bf16_t*)(F.ws + WS_WSG) + (size_t)layer * 8 * 128 * 128;
    const bf16_t* VNT = (const bf16_t*)(F.ws + WS_GVT); const bf16_t* UG = (const bf16_t*)(F.ws + WS_UG); bf16_t* Y = (bf16_t*)(F.ws + WS_Y);
    const int c = F.lane & 15, q = F.lane >> 4;
    for (int it = F.gw; it < (MTOK / 128) * 64; it += F.NGW) {
        const int ch = it >> 6, h = (it >> 3) & 7, tt = ((it & 7) + (it >> 11)) & 7, t0 = 16 * tt, nks = (tt >> 1) + 1;
        f32x4 acc[8];
#pragma unroll
        for (int r = 0; r < 8; ++r) acc[r] = (f32x4){0.f, 0.f, 0.f, 0.f};
        const bf16_t* wb = WSG + ((size_t)h * 128 + t0 + c) * 128 + 8 * q;
        const bf16_t* vb = VNT + (size_t)(h * 128 + c) * MTOK + ch * 128 + 8 * q;
        for (int ks = 0; ks < nks; ++ks) { const bf16x8 bw = *(const bf16x8*)(wb + 32 * ks);
#pragma unroll
            for (int r = 0; r < 8; ++r) { const bf16x8 av = *(const bf16x8*)(vb + (size_t)(16 * r) * MTOK + 32 * ks); acc[r] = MFMA16(av, bw, acc[r]); } }
        const int m = ch * 128 + t0 + c; const float bs = b_s[h * 128 + t0 + c];
#pragma unroll
        for (int r = 0; r < 8; ++r) { const int col = h * 128 + 16 * r + 4 * q; const u32x2 ug = *(const u32x2*)(UG + (size_t)m * 1024 + col); u32x2 w;
            w.x = cvt_pk_bf16((acc[r][0] + bs) * bf_lo(ug.x), (acc[r][1] + bs) * bf_hi(ug.x)); w.y = cvt_pk_bf16((acc[r][2] + bs) * bf_lo(ug.y), (acc[r][3] + bs) * bf_hi(ug.y));
            *(u32x2*)(Y + (size_t)m * DM + 512 + col) = w; }
    }
}

__device__ __forceinline__ void p4_s5(const Frame& F, int layer) {
    const bf16_t* WS5 = (const bf16_t*)(F.ws + WS_WS5) + (size_t)layer * S5G * 256 * 384;
    const bf16_t* XA = (const bf16_t*)(F.ws + WS_XA); const bf16_t* CARRY = (const bf16_t*)(F.ws + WS_CARRY); bf16_t* YG = (bf16_t*)(F.ws + WS_YG);
    const int c = F.lane & 15, q = F.lane >> 4;
    for (int it = F.gw; it < S5G * (NSEG / 16); it += F.NGW) {
        const int g = it & 31, st = it >> 5, seg = st * 16 + c;
        f32x4 acc[16];
#pragma unroll
        for (int r = 0; r < 16; ++r) acc[r] = (f32x4){0.f, 0.f, 0.f, 0.f};
        const bf16_t* xb = XA + ((size_t)seg * 16 + (q >> 1)) * 512 + 16 * g + 8 * (q & 1);
        const bf16_t* cb = CARRY + ((size_t)seg * 32 + g) * 128 + 8 * q;
        const bf16_t* wb = WS5 + ((size_t)g * 256 + c) * 384 + 8 * q;
#pragma unroll
        for (int ks = 0; ks < 12; ++ks) {
            const bf16x8 bx = ks < 8 ? *(const bf16x8*)(xb + (size_t)(2 * ks) * 512) : *(const bf16x8*)(cb + 32 * (ks - 8));
#pragma unroll
            for (int r = 0; r < 16; ++r) { if (ks < 8 && r < 2 * ks) continue;
                const bf16x8 aw = *(const bf16x8*)(wb + (size_t)(16 * r) * 384 + 32 * ks); acc[r] = MFMA16(aw, bx, acc[r]); } }
#pragma unroll
        for (int r = 0; r < 16; ++r) { const int m = seg * 16 + r; u32x2 w;
            w.x = cvt_pk_bf16(gelu_f(acc[r][0]), gelu_f(acc[r][1])); w.y = cvt_pk_bf16(gelu_f(acc[r][2]), gelu_f(acc[r][3]));
            *(u32x2*)(YG + (size_t)m * 512 + 16 * g + 4 * q) = w; }
    }
}

__device__ __forceinline__ void p_final(const Frame& F, float* out, const float* final_g) {
    const u64* ssq = (const u64*)(F.ws + WS_SSQ) + 2 * (size_t)MTOK;
    for (int m = F.gw; m < MTOK; m += F.NGW) {
        const float rs = rsqrtf((float)ssq[m] * (1.0f / (SSQ_SCALE * (float)DM)) + RMS_EPS);
        f32x4* xr = (f32x4*)(out + (size_t)m * DM) + F.lane; const f32x4* gr = (const f32x4*)final_g + F.lane;
#pragma unroll
        for (int j = 0; j < 8; ++j) { const f32x4 v = xr[64 * j], g = gr[64 * j]; xr[64 * j] = v * rs * g; }
    }
}

constexpr int N_PHASES = 14;
__global__ void __launch_bounds__(NTHR, 2) hybrid_fwd(Args args) {
    extern __shared__ __attribute__((aligned(16))) unsigned char lds_raw[];
    LAS unsigned char* lds = (LAS unsigned char*)lds_raw;
    volatile LAS unsigned* MISC = (volatile LAS unsigned*)(lds + LDSCTL_OFF);
    if (threadIdx.x < 64) MISC[threadIdx.x] = 0u;
    __syncthreads();
    unsigned char* ws = args.ws;
    XcdBarrier bar; bar.bar = (unsigned*)(ws + WS_CTL) + 1024; bar.x = 0; bar.st = nullptr;
#if !MK_MULTI
    bar = xcd_barrier_post((unsigned*)(ws + WS_CTL) + 1024, MISC + 8);
#endif
    const int lo = args.ph_lo, hi = args.ph_hi;
#define IN(k) (lo <= (k) && (k) < hi)
#define SEAM(k) do { if (IN(k) && IN((k) + 1)) xcd_barrier(bar); } while (0)
    const float* PAR = (const float*)(ws + WS_PAR);
#ifndef DIS_P0
    if (IN(0)) { const Frame F = mkframe(ws, lds); p0_prologue(F, args); }
#endif
    SEAM(0);
#pragma unroll 1
    for (int l = 0; l < DEPTH; ++l) {
        const int pb = 1 + 6 * l;
        if (IN(pb)) {
#ifndef DIS_TA
            if (l == 0) { const Frame F = mkframe(ws, lds); s5_tables_a(F, args); }
#endif
#ifndef DIS_G1
            SchedIn S{(int)gridDim.x, (int)blockIdx.x, (const char*)(ws + WS_XB), (const char*)(ws + WS_WA) + (size_t)l * 4096 * DM * 2, (const char*)(ws + WS_WB) + (size_t)l * 1024 * DM * 2};
            EpiIn E{(const u64*)(ws + WS_SSQ) + (size_t)l * MTOK, (bf16_t*)(ws + WS_XA), (bf16_t*)(ws + WS_UG), (bf16_t*)(ws + WS_XC), (bf16_t*)(ws + WS_SG), (bf16_t*)(ws + WS_GVT)};
            pg8::gemm_phase<EpiIn, SchedIn, true, true>(lds, DM, DM, DM, S, E);
#endif
        }
        SEAM(pb);
        if (IN(pb + 1)) {
            const Frame F = mkframe(ws, lds);
#ifndef DIS_TB
            if (l == 0) s5_tables_b(F);
#endif
#ifndef DIS_LN
            p2_ln(F, PAR + PAR_LNG + l * SGUW, PAR + PAR_LNB + l * SGUW);
#endif
#ifndef DIS_SEND
            p2_send(F, l);
#endif
#ifndef DIS_POOL
            p2_pool(F);
#endif
        }
        SEAM(pb + 1);
        if (IN(pb + 2)) {
            const Frame F = mkframe(ws, lds);
#ifndef DIS_SCAN
            p3_scan(F, l);
#endif
#ifndef DIS_SGU
            p3_sgu(F, l, PAR + PAR_BS + l * 8 * 128);
#endif
        }
        SEAM(pb + 2);
#ifndef DIS_S5
        if (IN(pb + 3)) { const Frame F = mkframe(ws, lds); p4_s5(F, l); }
#endif
        SEAM(pb + 3);
        if (IN(pb + 4)) {
#ifndef DIS_G5
            SchedMix S{(int)gridDim.x, (int)blockIdx.x, (const char*)(ws + WS_YG), (const char*)(ws + WS_PF), (const char*)(ws + WS_WGLU) + (size_t)l * 512 * 512 * 2, (const char*)(ws + WS_WPD) + (size_t)l * 512 * 512 * 2};
            EpiMix E{(const bf16_t*)(ws + WS_YG), (const bf16_t*)(ws + WS_SG), PAR + PAR_BGLU + l * S5W, PAR + PAR_PSC + l * POOLW, (bf16_t*)(ws + WS_Y)};
            pg8::gemm_phase<EpiMix, SchedMix, true, true>(lds, 512, 512, 512, S, E);
#endif
        }
        SEAM(pb + 4);
        if (IN(pb + 5)) {
#ifndef DIS_G6
            const float* base_x = l == 0 ? args.in[0] : args.out;
            SchedOut S{(int)gridDim.x, (int)blockIdx.x, (const char*)(ws + WS_Y), (const char*)(ws + WS_WOUT) + (size_t)l * DM * DM * 2};
            EpiOut E{base_x, args.out, (bf16_t*)(ws + WS_XB), (u64*)(ws + WS_SSQ) + (size_t)(l + 1) * MTOK};
            pg8::gemm_phase<EpiOut, SchedOut, true, true>(lds, DM, DM, DM, S, E);
#endif
        }
        SEAM(pb + 5);
    }
#ifndef DIS_FIN
    if (IN(13)) { const Frame F = mkframe(ws, lds); p_final(F, args.out, PAR + PAR_FG); }
#endif
#undef IN
#undef SEAM
}

extern "C" void kernel_launch(void* const* d_in, const int* in_sizes, int n_in, void* d_out, int out_size, void* d_ws, size_t ws_size, hipStream_t stream) {
    static int grid = 0;
    if (grid == 0) {
        if (n_in != 21 || in_sizes[0] != MTOK * DM || out_size != MTOK * DM || ws_size < WS_END) { fprintf(stderr, "kernel_launch: unexpected shapes (n_in %d, in0 %d, out %d, ws %zu)\n", n_in, n_in > 0 ? in_sizes[0] : -1, out_size, ws_size); grid = -1; return; }
        int dev = 0, cus = 0, per_cu = 0;
        if (hipGetDevice(&dev) != hipSuccess || hipDeviceGetAttribute(&cus, hipDeviceAttributeMultiprocessorCount, dev) != hipSuccess) { grid = -1; return; }
        if (hipFuncSetAttribute((const void*)hybrid_fwd, hipFuncAttributeMaxDynamicSharedMemorySize, LDS_BYTES) != hipSuccess) { fprintf(stderr, "kernel_launch: hipFuncSetAttribute failed\n"); grid = -1; return; }
        if (hipOccupancyMaxActiveBlocksPerMultiprocessor(&per_cu, (const void*)hybrid_fwd, NTHR, LDS_BYTES) != hipSuccess || per_cu < 1) { fprintf(stderr, "kernel_launch: occupancy query says %d blocks per CU\n", per_cu); per_cu = 1; }
        (void)hipGetLastError();
        grid = cus;
    }
    if (grid < 0) return;
    (void)hipMemsetAsync((char*)d_ws + WS_CTL, 0, CTL_ZERO_BYTES, stream);
    Args a{};
    for (int i = 0; i < 21; ++i) a.in[i] = (const float*)d_in[i];
    a.out = (float*)d_out; a.ws = (unsigned char*)d_ws;
#if MK_MULTI
    for (int ph = 0; ph < N_PHASES; ++ph) { a.ph_lo = ph; a.ph_hi = ph + 1; hipLaunchKernelGGL(hybrid_fwd, dim3(grid), dim3(NTHR), LDS_BYTES, stream, a); }
#else
    a.ph_lo = 0; a.ph_hi = N_PHASES;
    void* kargs[] = {&a};
    hipError_t e = hipLaunchCooperativeKernel((const void*)hybrid_fwd, dim3(grid), dim3(NTHR), kargs, LDS_BYTES, stream);
    if (e != hipSuccess) fprintf(stderr, "kernel_launch: cooperative launch failed: %s (grid %d)\n", hipGetErrorString(e), grid);
#endif
}
```

```cpp
#include <hip/hip_runtime.h>
#include <cstdio>
#include <cstdint>

#ifndef MK_MULTI
#define MK_MULTI 0
#endif

#define LAS __attribute__((address_space(3)))
#define GAS __attribute__((address_space(1)))
typedef unsigned short bf16_t;
typedef short bf16x8 __attribute__((ext_vector_type(8)));
typedef float f32x4 __attribute__((ext_vector_type(4)));
typedef float f32x2 __attribute__((ext_vector_type(2)));
typedef unsigned u32x4 __attribute__((ext_vector_type(4)));
typedef unsigned u32x2 __attribute__((ext_vector_type(2)));
typedef unsigned long long u64;

constexpr int DM = 2048, NB = 4, SEQ = 8192, DEPTH = 2, MTOK = NB * SEQ;
constexpr int S5W = 512, SGUW = 1024, POOLW = 512, INC = 5120;
constexpr int S5G = 32, S5H = 16, S5P = 64;
constexpr int NSEG = MTOK / 16, SEGB = SEQ / 16; constexpr int WA_ROWS = 3584, WB_ROWS = 1536;
constexpr float RMS_EPS = 1e-6f, LN_EPS = 1e-5f;
constexpr float SSQ_SCALE = 16777216.0f;

constexpr size_t MiB = 1u << 20;
constexpr size_t WS_CTL = 0, CTL_ZERO_BYTES = 64 * 1024;
constexpr size_t WS_SSQ = 1 * MiB;
constexpr size_t WS_POW = 2 * MiB;
constexpr size_t WS_BBAR = WS_POW + 640 * 1024;
constexpr size_t WS_PAR = 3 * MiB + 256 * 1024;
constexpr int PAR_BGLU = 0, PAR_LNG = 1024, PAR_LNB = 3072, PAR_BS = 5120, PAR_PSC = 7168, PAR_FG = 8192, PAR_N = 10240;
constexpr size_t WS_KT = 4 * MiB;
constexpr size_t WS_WEND = 5 * MiB;
constexpr size_t WS_WS5 = 9 * MiB;
constexpr size_t WS_WSG = 21 * MiB;
constexpr size_t WS_WGLU = 22 * MiB;
constexpr size_t WS_WPD = 23 * MiB;
constexpr size_t WS_WA = 24 * MiB;
constexpr size_t WS_WB = 52 * MiB;
constexpr size_t WS_WOUT = 64 * MiB;
constexpr size_t WS_XB = 80 * MiB;
constexpr size_t WS_XA = 208 * MiB;
constexpr size_t WS_GVT = 240 * MiB;
constexpr size_t WS_UG = 304 * MiB;
constexpr size_t WS_XC = 368 * MiB;
constexpr size_t WS_SG = 400 * MiB;
constexpr size_t WS_PF = 464 * MiB;
constexpr size_t WS_YG = 496 * MiB;
constexpr size_t WS_Y = 528 * MiB;
constexpr size_t WS_SE = 656 * MiB;
constexpr size_t WS_CARRY = 688 * MiB;
constexpr size_t WS_END = 704 * MiB;

__device__ __forceinline__ unsigned cvt_pk_bf16(float lo, float hi) { unsigned r; asm volatile("v_cvt_pk_bf16_f32 %0, %1, %2" : "=v"(r) : "v"(lo), "v"(hi)); return r; }
__device__ __forceinline__ unsigned f2bf_rne(float f) { unsigned u = __float_as_uint(f); return (u + 0x7fffu + ((u >> 16) & 1u)) >> 16; }
__device__ __forceinline__ unsigned pk_bf16_c(float lo, float hi) { return f2bf_rne(lo) | (f2bf_rne(hi) << 16); }
__device__ __forceinline__ float bf_lo(unsigned w) { return __uint_as_float(w << 16); }
__device__ __forceinline__ float bf_hi(unsigned w) { return __uint_as_float(w & 0xffff0000u); }
__device__ __forceinline__ float bf2f(bf16_t b) { return __uint_as_float(((unsigned)b) << 16); }
__device__ __forceinline__ float sigmoid_f(float x) { return __builtin_amdgcn_rcpf(1.0f + __builtin_amdgcn_exp2f(-1.4426950408889634f * x)); }
__device__ __forceinline__ float silu_f(float x) { return x * sigmoid_f(x); }
__device__ __forceinline__ float gelu_f(float x) {
    const float u = x * (1.0f + 0.044715f * x * x);
    return x * __builtin_amdgcn_rcpf(1.0f + __builtin_amdgcn_exp2f(-2.302208198f * u));
}
__device__ __forceinline__ float wave_sum(float v) {
#pragma unroll
    for (int o = 1; o < 64; o <<= 1) v += __shfl_xor(v, o);
    return v;
}

namespace pg8 {
constexpr int BM = 256, BK = 64, HALF = 128, HTB = HALF * BK * 2, STAGE_BYTES = 8 * HTB, NXCD = 8, WGM = 8;
__host__ __device__ __forceinline__ int lds_byte(int r, int c) { const int st = (r >> 4) * 2 + (c >> 5), rr = r & 15, cc = c & 31, ob = rr * 64 + cc * 2; return st * 1024 + (ob ^ (((ob >> 9) & 1) << 5)); }
__host__ __device__ __forceinline__ void stage_rc(int b, int& R, int& C) { const int st = b / 1024, sb = b % 1024, swz = sb ^ (((sb >> 9) & 1) << 5); R = (st >> 1) * 16 + swz / 64; C = (st & 1) * 32 + (swz % 64) / 2; }
__host__ __device__ __forceinline__ int perm32(int rho) { const int n = rho >> 4, i = rho & 15; return 8 * (i >> 2) + 4 * n + (i & 3); }

struct Unit { int pm, pn, type, cb; const char* A; const char* B; };
__device__ __forceinline__ void tile_of(int L, int nM, int nN, int& pm, int& pn) {
    const int nwg = nM * nN; int wgid = L; { const int q = nwg / NXCD, r = nwg % NXCD, xcd = wgid % NXCD, off = wgid / NXCD; wgid = (xcd < r ? xcd * (q + 1) : r * (q + 1) + (xcd - r) * q) + off; }
    const int nig = WGM * nN, gid = wgid / nig, fm = gid * WGM, gsz = (nM - fm) < WGM ? (nM - fm) : WGM;
    pm = fm + ((wgid % nig) % gsz); pn = (wgid % nig) / gsz;
}

template <class Epi, class Sched, bool ALIGN_EPI, bool SP2>
__device__ __forceinline__ void gemm_phase(LAS unsigned char* lds, const int wave_s, const int K, const int ldA, const int ldB, const Sched& S, const Epi& E) {
    int tid_ = (wave_s << 6) | (int)__builtin_amdgcn_mbcnt_hi(~0u, __builtin_amdgcn_mbcnt_lo(~0u, 0u)); asm volatile("" : "+v"(tid_));
    const int tid = tid_, wid = __builtin_amdgcn_readfirstlane(tid >> 6), lane = tid & 63, wr = wid >> 2, wc = wid & 3, fr = lane & 15, fq = lane >> 4;
    const int nt = K / BK;
    unsigned voffA[2], voffB[2];
#pragma unroll
    for (int i = 0; i < 2; ++i) { int R, C; stage_rc(tid * 16 + i * 8192, R, C); const int Rb = (R & ~31) + perm32(R & 31);
        voffA[i] = (unsigned)(R * ldA + C) * 2u; voffB[i] = (unsigned)(Rb * ldB + C) * 2u; }
    const size_t kstep = (size_t)(BK * 2);
    const size_t hstepA = (size_t)HALF * ldA * 2, hstepB = (size_t)HALF * ldB * 2;
    const unsigned ldsw = (unsigned)wid * 1024u;
    const int aoff = lds_byte(wr * 64 + fr, fq * 8), boff = lds_byte(wc * 32 + fr, fq * 8);
#define PG8_SA(b, h) (((b) * 2 + (h)) * HTB)
#define PG8_SB(b, h) ((4 + (b) * 2 + (h)) * HTB)
#define PG8_STAGE(bufoff, gbase, voff) do { _Pragma("unroll") for (int _i = 0; _i < 2; ++_i) \
        __builtin_amdgcn_global_load_lds((const unsigned*)((const char*)(gbase) + (voff)[_i]), (LAS unsigned*)(lds + (bufoff) + ldsw + _i * 8192), 16, 0, 0); } while (0)
#define PG8_LDA(dst, b, h) do { _Pragma("unroll") for (int m = 0; m < 4; ++m) _Pragma("unroll") for (int k = 0; k < 2; ++k) dst[m][k] = *(const LAS bf16x8*)(lds + PG8_SA(b, h) + aoff + m * 2048 + k * 1024); } while (0)
#define PG8_LDB(dst, b, h) do { _Pragma("unroll") for (int n = 0; n < 2; ++n) _Pragma("unroll") for (int k = 0; k < 2; ++k) dst[n][k] = *(const LAS bf16x8*)(lds + PG8_SB(b, h) + boff + n * 2048 + k * 1024); } while (0)
#define PG8_MMA(ai, bj, At, Bt) do { __builtin_amdgcn_s_setprio(1); _Pragma("unroll") for (int m = 0; m < 4; ++m) _Pragma("unroll") for (int n = 0; n < 2; ++n) _Pragma("unroll") for (int k = 0; k < 2; ++k) \
        acc[ai][bj][m][n] = __builtin_amdgcn_mfma_f32_16x16x32_bf16(Bt[n][k], At[m][k], acc[ai][bj][m][n], 0, 0, 0); __builtin_amdgcn_s_setprio(0); } while (0)
#define PG8_WAIT_V(n) asm volatile("s_waitcnt vmcnt(" #n ")" ::: "memory")
#define PG8_WAIT_L(n) asm volatile("s_waitcnt lgkmcnt(" #n ")" ::: "memory")
#define PG8_BAR __builtin_amdgcn_s_barrier()
#define PG8_SCHED __builtin_amdgcn_sched_barrier(0)
    Unit cur, nxt; int ui = 0;
    if (!S.next(0, cur)) return;
    f32x4 acc[2][2][4][2];
#pragma unroll
    for (int a = 0; a < 2; ++a)
#pragma unroll
        for (int b = 0; b < 2; ++b)
#pragma unroll
            for (int m = 0; m < 4; ++m)
#pragma unroll
                for (int n = 0; n < 2; ++n) acc[a][b][m][n] = (f32x4){0.f, 0.f, 0.f, 0.f};
    bf16x8 At[4][2], B0[2][2], B1[2][2];
    const char* cA = cur.A; const char* cB = cur.B;
    if constexpr (SP2) {
        PG8_STAGE(PG8_SB(0, 0), cB, voffB); PG8_STAGE(PG8_SB(0, 1), cB + hstepB, voffB); PG8_STAGE(PG8_SA(0, 0), cA, voffA); PG8_STAGE(PG8_SA(0, 1), cA + hstepA, voffA);
        if (wr == 1) PG8_BAR;
        PG8_WAIT_V(2); PG8_BAR;
        PG8_STAGE(PG8_SB(1, 0), cB + kstep, voffB); PG8_STAGE(PG8_SA(1, 0), cA + kstep, voffA); PG8_STAGE(PG8_SB(1, 1), cB + hstepB + kstep, voffB);
        PG8_WAIT_V(6); PG8_BAR;
    } else {
        PG8_STAGE(PG8_SB(0, 0), cB, voffB); PG8_STAGE(PG8_SA(0, 0), cA, voffA); PG8_STAGE(PG8_SB(0, 1), cB + hstepB, voffB); PG8_STAGE(PG8_SA(0, 1), cA + hstepA, voffA);
        if (wr == 1) PG8_BAR;
        PG8_WAIT_V(4); PG8_BAR;
        PG8_STAGE(PG8_SB(1, 0), cB + kstep, voffB); PG8_STAGE(PG8_SA(1, 0), cA + kstep, voffA); PG8_STAGE(PG8_SB(1, 1), cB + hstepB + kstep, voffB);
        PG8_WAIT_V(6); PG8_BAR;
    }
    for (;;) {
        const bool has_next = S.next(ui + 1, nxt);
        const char* nA = has_next ? nxt.A : cA; const char* nB = has_next ? nxt.B : cB;
        for (int t = 0; t < nt; t += 2) {
            const bool last = (t == nt - 2);
            const char* a1 = cA + (size_t)(t + 1) * kstep;
            const char* a2 = last ? nA : cA + (size_t)(t + 2) * kstep; const char* b2 = last ? nB : cB + (size_t)(t + 2) * kstep;
            const char* a3 = a2 + kstep; const char* b3 = b2 + kstep;
            if constexpr (SP2) {
            PG8_LDB(B0, 0, 0); PG8_LDB(B1, 0, 1); PG8_SCHED; PG8_LDA(At, 0, 0); PG8_STAGE(PG8_SA(1, 1), a1 + hstepA, voffA);
            PG8_WAIT_V(8); PG8_WAIT_L(0); PG8_BAR; PG8_MMA(0, 0, At, B0); PG8_MMA(0, 1, At, B1); PG8_BAR; PG8_SCHED;
            PG8_LDA(At, 0, 1); PG8_STAGE(PG8_SB(0, 0), b2, voffB); PG8_STAGE(PG8_SB(0, 1), b2 + hstepB, voffB); PG8_STAGE(PG8_SA(0, 0), a2, voffA);
            PG8_WAIT_V(8); PG8_WAIT_L(0); PG8_BAR; PG8_MMA(1, 0, At, B0); PG8_MMA(1, 1, At, B1); PG8_BAR; PG8_SCHED;
            PG8_LDB(B0, 1, 0); PG8_LDB(B1, 1, 1); PG8_SCHED; PG8_LDA(At, 1, 0); PG8_STAGE(PG8_SA(0, 1), a2 + hstepA, voffA);
            PG8_WAIT_V(8); PG8_WAIT_L(0); PG8_BAR; PG8_MMA(0, 0, At, B0); PG8_MMA(0, 1, At, B1); PG8_BAR; PG8_SCHED;
            PG8_LDA(At, 1, 1); PG8_STAGE(PG8_SB(1, 0), b3, voffB); PG8_STAGE(PG8_SB(1, 1), b3 + hstepB, voffB); PG8_STAGE(PG8_SA(1, 0), a3, voffA);
            PG8_WAIT_V(8); PG8_WAIT_L(0); PG8_BAR; PG8_MMA(1, 0, At, B0); PG8_MMA(1, 1, At, B1); PG8_BAR; PG8_SCHED;
            } else {
            PG8_LDB(B0, 0, 0); PG8_SCHED; PG8_LDA(At, 0, 0); PG8_STAGE(PG8_SA(1, 1), a1 + hstepA, voffA);
            PG8_WAIT_L(8); PG8_BAR; PG8_WAIT_L(0); PG8_MMA(0, 0, At, B0); PG8_BAR; PG8_SCHED;
            PG8_LDB(B1, 0, 1); PG8_STAGE(PG8_SB(0, 0), b2, voffB);
            PG8_BAR; PG8_WAIT_L(0); PG8_MMA(0, 1, At, B1); PG8_BAR;
            PG8_LDA(At, 0, 1); PG8_STAGE(PG8_SA(0, 0), a2, voffA);
            PG8_BAR; PG8_WAIT_L(0); PG8_MMA(1, 0, At, B0); PG8_BAR; PG8_SCHED;
            PG8_STAGE(PG8_SB(0, 1), b2 + hstepB, voffB);
            PG8_WAIT_V(6); PG8_BAR; PG8_MMA(1, 1, At, B1); PG8_BAR;
            PG8_LDB(B0, 1, 0); PG8_SCHED; PG8_LDA(At, 1, 0); PG8_STAGE(PG8_SA(0, 1), a2 + hstepA, voffA);
            PG8_WAIT_L(8); PG8_BAR; PG8_WAIT_L(0); PG8_MMA(0, 0, At, B0); PG8_BAR; PG8_SCHED;
            PG8_LDB(B1, 1, 1); PG8_STAGE(PG8_SB(1, 0), b3, voffB);
            PG8_BAR; PG8_WAIT_L(0); PG8_MMA(0, 1, At, B1); PG8_BAR;
            PG8_LDA(At, 1, 1); PG8_STAGE(PG8_SA(1, 0), a3, voffA);
            PG8_BAR; PG8_WAIT_L(0); PG8_MMA(1, 0, At, B0); PG8_BAR; PG8_SCHED;
            PG8_STAGE(PG8_SB(1, 1), b3 + hstepB, voffB);
            PG8_WAIT_V(6); PG8_BAR; PG8_MMA(1, 1, At, B1); PG8_BAR;
            }
        }
        if constexpr (ALIGN_EPI) { if (wr == 0) PG8_BAR; }
        E(acc, cur, wr, wc, fr, fq);
        if (!has_next) break;
#pragma unroll
        for (int a = 0; a < 2; ++a)
#pragma unroll
            for (int b = 0; b < 2; ++b)
#pragma unroll
                for (int m = 0; m < 4; ++m)
#pragma unroll
                    for (int n = 0; n < 2; ++n) acc[a][b][m][n] = (f32x4){0.f, 0.f, 0.f, 0.f};
        cur = nxt; cA = nA; cB = nB; ++ui;
        if constexpr (ALIGN_EPI) { if (wr == 1) PG8_BAR; }
    }
    PG8_WAIT_V(0);
    if constexpr (!ALIGN_EPI) { if (wr == 0) PG8_BAR; }
    PG8_BAR;
#undef PG8_SA
#undef PG8_SB
#undef PG8_STAGE
#undef PG8_LDA
#undef PG8_LDB
#undef PG8_MMA
#undef PG8_WAIT_V
#undef PG8_WAIT_L
#undef PG8_BAR
#undef PG8_SCHED
}
}
using pg8::Unit;

struct SchedIn {
    int G, c, l; const char* ws;
    __device__ __forceinline__ bool next(int i, Unit& u) const {
        const int L = i * G + c; const char* XB = ws + WS_XB;
        if (L < 1792) { pg8::tile_of(L, 128, 14, u.pm, u.pn);
            u.A = XB + (size_t)u.pm * 256 * DM * 2; u.B = ws + WS_WA + ((size_t)l * WA_ROWS + (size_t)u.pn * 256) * DM * 2;
            const int pn = u.pn;
            if (pn < 8) { u.type = 1; u.cb = 128 * pn; }
            else if (pn < 10) { u.type = 2; u.cb = 256 * (pn - 8); }
            else { u.type = 3; u.cb = 256 * (pn - 10); }
            return true; }
        const int L2 = L - 1792; if (L2 >= 768) return false;
        pg8::tile_of(L2, 6, 128, u.pm, u.pn);
        u.A = ws + WS_WB + ((size_t)l * WB_ROWS + (size_t)u.pm * 256) * DM * 2; u.B = XB + (size_t)u.pn * 256 * DM * 2;
        if (u.pm < 2) { u.type = 5; u.cb = 256 * u.pm; } else { u.type = 4; u.cb = 256 * (u.pm - 2); }
        return true;
    }
};
struct SchedMix {
    int G, c, l; const char* ws;
    __device__ __forceinline__ bool next(int i, Unit& u) const {
        const int L = i * G + c; if (L >= 256) return false;
        pg8::tile_of(L, 128, 2, u.pm, u.pn);
        u.type = 0; u.cb = 256 * u.pn; u.A = ws + WS_YG + (size_t)u.pm * 256 * 512 * 2; u.B = ws + WS_WGLU + ((size_t)l * 512 + (size_t)u.pn * 256) * 512 * 2;
        return true;
    }
};
struct SchedOut {
    int G, c, l; const char* ws;
    __device__ __forceinline__ bool next(int i, Unit& u) const {
        const int L = i * G + c; if (L >= 1024) return false;
        pg8::tile_of(L, 128, 8, u.pm, u.pn); u.type = 0; u.cb = 256 * u.pn;
        u.A = ws + WS_Y + (size_t)u.pm * 256 * DM * 2; u.B = ws + WS_WOUT + ((size_t)l * DM + (size_t)u.pn * 256) * DM * 2; return true;
    }
};

struct EpiIn {
    unsigned char* ws; int l;
    __device__ __forceinline__ float rstd_of(int row) const { const u64* ssq = (const u64*)(ws + WS_SSQ) + (size_t)l * MTOK; return rsqrtf((float)ssq[row] * (1.0f / (SSQ_SCALE * (float)DM)) + RMS_EPS); }
    __device__ __forceinline__ void operator()(const f32x4 (&acc)[2][2][4][2], const Unit& u, int wr, int wc, int fr, int fq) const {
        const int type = u.type;
        if (type >= 4) {
            const int col0 = u.pn * 256 + wc * 32 + 8 * fq;
            float cs[2][8];
#pragma unroll
            for (int bj = 0; bj < 2; ++bj)
#pragma unroll
                for (int e = 0; e < 8; ++e) cs[bj][e] = rstd_of(col0 + bj * 128 + e);
#pragma unroll
            for (int ai = 0; ai < 2; ++ai)
#pragma unroll
                for (int m = 0; m < 4; ++m) {
                    const int r = u.cb + ai * 128 + wr * 64 + m * 16 + fr; bf16_t* rowp = (bf16_t*)(ws + (type == 4 ? WS_GVT : WS_XA)) + (size_t)r * MTOK + col0;
#pragma unroll
                    for (int bj = 0; bj < 2; ++bj) { const f32x4 v0 = acc[ai][bj][m][0], v1 = acc[ai][bj][m][1]; u32x4 w;
                        float e[8] = {v0[0] * cs[bj][0], v0[1] * cs[bj][1], v0[2] * cs[bj][2], v0[3] * cs[bj][3], v1[0] * cs[bj][4], v1[1] * cs[bj][5], v1[2] * cs[bj][6], v1[3] * cs[bj][7]};
                        if (type == 4) {
#pragma unroll
                            for (int k = 0; k < 8; ++k) e[k] = gelu_f(e[k]); }
                        w.x = cvt_pk_bf16(e[0], e[1]); w.y = cvt_pk_bf16(e[2], e[3]); w.z = cvt_pk_bf16(e[4], e[5]); w.w = cvt_pk_bf16(e[6], e[7]);
                        *(u32x4*)(rowp + bj * 128) = w; }
                }
            return;
        }
        const int row0 = u.pm * 256 + wr * 64 + fr, cw = wc * 32 + 8 * fq;
        if (type == 1) {
#pragma unroll
            for (int ai = 0; ai < 2; ++ai)
#pragma unroll
                for (int m = 0; m < 4; ++m) { const int row = row0 + ai * 128 + m * 16; const float rs = rstd_of(row);
                    const f32x4 a0 = acc[ai][0][m][0] * rs, a1 = acc[ai][0][m][1] * rs, g0 = acc[ai][1][m][0] * rs, g1 = acc[ai][1][m][1] * rs; u32x4 w;
                    w.x = cvt_pk_bf16(gelu_f(a0[0]) * silu_f(g0[0]), gelu_f(a0[1]) * silu_f(g0[1])); w.y = cvt_pk_bf16(gelu_f(a0[2]) * silu_f(g0[2]), gelu_f(a0[3]) * silu_f(g0[3]));
                    w.z = cvt_pk_bf16(gelu_f(a1[0]) * silu_f(g1[0]), gelu_f(a1[1]) * silu_f(g1[1])); w.w = cvt_pk_bf16(gelu_f(a1[2]) * silu_f(g1[2]), gelu_f(a1[3]) * silu_f(g1[3]));
                    *(u32x4*)((bf16_t*)(ws + WS_UG) + (size_t)row * 1024 + u.cb + cw) = w; }
            return;
        }
        bf16_t* base = (bf16_t*)(ws + (type == 2 ? WS_XC : WS_SG)); const int ld = type == 3 ? 1024 : 512;
#pragma unroll
        for (int ai = 0; ai < 2; ++ai)
#pragma unroll
            for (int m = 0; m < 4; ++m) { const int row = row0 + ai * 128 + m * 16; const float rs = rstd_of(row); bf16_t* rowp = base + (size_t)row * ld + u.cb + cw;
#pragma unroll
                for (int bj = 0; bj < 2; ++bj) { f32x4 v0 = acc[ai][bj][m][0] * rs, v1 = acc[ai][bj][m][1] * rs;
                    if (type == 3) {
#pragma unroll
                        for (int e = 0; e < 4; ++e) { v0[e] = silu_f(v0[e]); v1[e] = silu_f(v1[e]); } }
                    u32x4 w; w.x = cvt_pk_bf16(v0[0], v0[1]); w.y = cvt_pk_bf16(v0[2], v0[3]); w.z = cvt_pk_bf16(v1[0], v1[1]); w.w = cvt_pk_bf16(v1[2], v1[3]);
                    *(u32x4*)(rowp + bj * 128) = w; } }
    }
};
struct EpiMix {
    unsigned char* ws; int l;
    __device__ __forceinline__ void operator()(const f32x4 (&acc)[2][2][4][2], const Unit& u, int wr, int wc, int fr, int fq) const {
        const int row0 = u.pm * 256 + wr * 64 + fr, cw = u.cb + wc * 32 + 8 * fq;
        const bf16_t* YG = (const bf16_t*)(ws + WS_YG); const bf16_t* SG = (const bf16_t*)(ws + WS_SG); bf16_t* Y = (bf16_t*)(ws + WS_Y);
        const float* bglu = (const float*)(ws + WS_PAR) + PAR_BGLU + l * S5W; const float* pscale = (const float*)(ws + WS_PAR) + PAR_PSC + l * POOLW;
        f32x4 cv[2][2];
#pragma unroll
        for (int bj = 0; bj < 2; ++bj)
#pragma unroll
            for (int n = 0; n < 2; ++n) cv[bj][n] = *(const f32x4*)((u.type == 0 ? bglu : pscale) + cw + bj * 128 + 4 * n);
#pragma unroll
        for (int ai = 0; ai < 2; ++ai)
#pragma unroll
            for (int m = 0; m < 4; ++m) { const int row = row0 + ai * 128 + m * 16;
#pragma unroll
                for (int bj = 0; bj < 2; ++bj) { const int col = cw + bj * 128; const f32x4 a0 = acc[ai][bj][m][0], a1 = acc[ai][bj][m][1]; float o[8];
                    if (u.type == 0) {
                        const u32x4 yg = *(const u32x4*)(YG + (size_t)row * 512 + col), sg = *(const u32x4*)(SG + (size_t)row * 1024 + col);
                        o[0] = bf_lo(yg.x) * sigmoid_f(a0[0] + cv[bj][0][0]) * bf_lo(sg.x); o[1] = bf_hi(yg.x) * sigmoid_f(a0[1] + cv[bj][0][1]) * bf_hi(sg.x);
                        o[2] = bf_lo(yg.y) * sigmoid_f(a0[2] + cv[bj][0][2]) * bf_lo(sg.y); o[3] = bf_hi(yg.y) * sigmoid_f(a0[3] + cv[bj][0][3]) * bf_hi(sg.y);
                        o[4] = bf_lo(yg.z) * sigmoid_f(a1[0] + cv[bj][1][0]) * bf_lo(sg.z); o[5] = bf_hi(yg.z) * sigmoid_f(a1[1] + cv[bj][1][1]) * bf_hi(sg.z);
                        o[6] = bf_lo(yg.w) * sigmoid_f(a1[2] + cv[bj][1][2]) * bf_lo(sg.w); o[7] = bf_hi(yg.w) * sigmoid_f(a1[3] + cv[bj][1][3]) * bf_hi(sg.w);
                        u32x4 w; w.x = cvt_pk_bf16(o[0], o[1]); w.y = cvt_pk_bf16(o[2], o[3]); w.z = cvt_pk_bf16(o[4], o[5]); w.w = cvt_pk_bf16(o[6], o[7]);
                        *(u32x4*)(Y + (size_t)row * DM + col) = w;
                    } else {
                        const u32x4 sg = *(const u32x4*)(SG + (size_t)row * 1024 + 512 + col);
                        o[0] = a0[0] * cv[bj][0][0] * bf_lo(sg.x); o[1] = a0[1] * cv[bj][0][1] * bf_hi(sg.x); o[2] = a0[2] * cv[bj][0][2] * bf_lo(sg.y); o[3] = a0[3] * cv[bj][0][3] * bf_hi(sg.y);
                        o[4] = a1[0] * cv[bj][1][0] * bf_lo(sg.z); o[5] = a1[1] * cv[bj][1][1] * bf_hi(sg.z); o[6] = a1[2] * cv[bj][1][2] * bf_lo(sg.w); o[7] = a1[3] * cv[bj][1][3] * bf_hi(sg.w);
                        u32x4 w; w.x = cvt_pk_bf16(o[0], o[1]); w.y = cvt_pk_bf16(o[2], o[3]); w.z = cvt_pk_bf16(o[4], o[5]); w.w = cvt_pk_bf16(o[6], o[7]);
                        *(u32x4*)(Y + (size_t)row * DM + 1536 + col) = w;
                    } } }
    }
};
struct EpiOut {
    const float* base; float* out; unsigned char* ws; int l; int do_ssq;
    __device__ __forceinline__ void operator()(const f32x4 (&acc)[2][2][4][2], const Unit& u, int wr, int wc, int fr, int fq) const {
        const int row0 = u.pm * 256 + wr * 64 + fr, cw = u.cb + wc * 32 + 8 * fq;
        bf16_t* XB = (bf16_t*)(ws + WS_XB); u64* ssq_next = (u64*)(ws + WS_SSQ) + (size_t)(l + 1) * MTOK;
#pragma unroll
        for (int ai = 0; ai < 2; ++ai)
#pragma unroll
            for (int m = 0; m < 4; ++m) { const int row = row0 + ai * 128 + m * 16; float s = 0.f;
#pragma unroll
                for (int bj = 0; bj < 2; ++bj) { const size_t off = (size_t)row * DM + cw + bj * 128;
                    const f32x4 v0 = *(const f32x4*)(base + off) + acc[ai][bj][m][0], v1 = *(const f32x4*)(base + off + 4) + acc[ai][bj][m][1];
                    *(f32x4*)(out + off) = v0; *(f32x4*)(out + off + 4) = v1;
                    u32x4 w; w.x = cvt_pk_bf16(v0[0], v0[1]); w.y = cvt_pk_bf16(v0[2], v0[3]); w.z = cvt_pk_bf16(v1[0], v1[1]); w.w = cvt_pk_bf16(v1[2], v1[3]);
                    *(u32x4*)(XB + off) = w;
                    s += (v0[0] * v0[0] + v0[1] * v0[1]) + (v0[2] * v0[2] + v0[3] * v0[3]) + (v1[0] * v1[0] + v1[1] * v1[1]) + (v1[2] * v1[2] + v1[3] * v1[3]); }
                s += __shfl_xor(s, 16); s += __shfl_xor(s, 32);
                if (fq == 0 && do_ssq) atomicAdd(ssq_next + row, (u64)(s * SSQ_SCALE)); }
    }
};

#define XB_TMO      128
#define XB_XCNT(j)  (256  + 64 * (j))
#define XB_XSUB(j)  (1280 + 64 * (j))
#define XB_XGEN(j)  (2304 + 64 * (j))
#define XB_TOP      3328
#define XB_TOPGEN   3392
#define XCD_BAR_WORDS 3456
#define XB_SPIN_CAP (1u << 18)
__device__ __forceinline__ unsigned xb_ld(unsigned* p)              { return __hip_atomic_load(p, __ATOMIC_RELAXED, __HIP_MEMORY_SCOPE_AGENT); }
__device__ __forceinline__ unsigned xb_add(unsigned* p, unsigned v) { return __hip_atomic_fetch_add(p, v, __ATOMIC_RELAXED, __HIP_MEMORY_SCOPE_AGENT); }
__device__ __forceinline__ unsigned xb_xcc_id() { return (unsigned)__builtin_amdgcn_s_getreg((3 << 11) | 20) & 0xFu; }
#define XB_SPIN(cond, bar) do { unsigned _sp = 0; while (cond) { __builtin_amdgcn_s_sleep(1); \
    if ((++_sp & 255u) == 0u) { if (xb_ld(&(bar)[XB_TMO])) break; if (_sp > XB_SPIN_CAP) { atomicAdd(&(bar)[XB_TMO], 1u); break; } } } } while (0)
struct XcdBarrier { unsigned* bar; unsigned x; volatile LAS unsigned* st; };
__device__ __forceinline__ XcdBarrier xcd_barrier_post(unsigned* bar, volatile LAS unsigned* st) {
    XcdBarrier b; b.bar = bar; b.x = xb_xcc_id(); b.st = st;
    if (threadIdx.x == 0) (void)xb_add(&bar[XB_XCNT(b.x)], 1u);
    return b;
}
__device__ __forceinline__ void xcd_barrier_complete(unsigned* bar, unsigned x, unsigned& nloc, unsigned& nx) {
    const unsigned G = gridDim.x * gridDim.y * gridDim.z;
    unsigned sum, cnt, mine, sp = 0u;
    for (;;) {
        sum = 0u; cnt = 0u; mine = 0u;
#pragma unroll
        for (unsigned j = 0; j < 16; ++j) { const unsigned c = xb_ld(&bar[XB_XCNT(j)]); sum += c; cnt += (c > 0u) ? 1u : 0u; mine = (j == x) ? c : mine; }
        if (sum == G) break;
        __builtin_amdgcn_s_sleep(1);
        if ((++sp & 255u) == 0u) { if (xb_ld(&bar[XB_TMO])) break; if (sp > XB_SPIN_CAP) { atomicAdd(&bar[XB_TMO], 1u); break; } }
    }
    nloc = mine > 0u ? mine : 1u; nx = cnt > 0u ? cnt : 1u;
}
__device__ __forceinline__ void xcd_barrier(const XcdBarrier& b) {
    asm volatile("s_waitcnt vmcnt(0)" ::: "memory");
    __syncthreads();
    if (threadIdx.x == 0) {
        unsigned* bar = b.bar;
        __builtin_amdgcn_s_waitcnt(0);
        unsigned nloc = b.st[0], nx = b.st[1];
        if (nloc == 0u) { xcd_barrier_complete(bar, b.x, nloc, nx); b.st[0] = nloc; b.st[1] = nx; }
        const unsigned old = xb_add(&bar[XB_XSUB(b.x)], 1u);
        const unsigned gen = old / nloc;
        if (old + 1u == (gen + 1u) * nloc) {
            __builtin_amdgcn_fence(__ATOMIC_RELEASE, "agent");
            asm volatile("s_waitcnt vmcnt(0)" ::: "memory");
            const unsigned og = xb_add(&bar[XB_TOP], 1u);
            const unsigned tg = og / nx;
            if (og + 1u == (tg + 1u) * nx) xb_add(&bar[XB_TOPGEN], 1u);
            else XB_SPIN(xb_ld(&bar[XB_TOPGEN]) == tg, bar);
            __builtin_amdgcn_fence(__ATOMIC_ACQUIRE, "agent");
            xb_add(&bar[XB_XGEN(b.x)], 1u);
            asm volatile("s_waitcnt vmcnt(0)" ::: "memory");
        } else {
            XB_SPIN(xb_ld(&bar[XB_XGEN(b.x)]) == gen, bar);
            __builtin_amdgcn_fence(__ATOMIC_ACQUIRE, "agent");
            asm volatile("s_waitcnt vmcnt(0)" ::: "memory");
        }
    }
    __syncthreads();
}

constexpr int NWAVES = 8, NTHR = 512;
constexpr int RING_BYTES = 131072, LDSCTL_OFF = RING_BYTES, LDS_BYTES = 147456;
struct Args { const float* in[21]; float* out; unsigned char* ws; int ph_lo, ph_hi; };
struct Frame {
    LAS unsigned char* lds; int tid, lane, wave, vcu, G, gw, NGW; unsigned char* ws;
};
__device__ __forceinline__ Frame mkframe(unsigned char* ws, LAS unsigned char* lds, int wave_s) {
    Frame F; int tid = (wave_s << 6) | (int)__builtin_amdgcn_mbcnt_hi(~0u, __builtin_amdgcn_mbcnt_lo(~0u, 0u)); asm volatile("" : "+v"(tid)); int bx = blockIdx.x, G = gridDim.x; asm volatile("" : "+s"(bx), "+s"(G));
    F.lds = lds; F.tid = tid; F.lane = tid & 63; F.wave = __builtin_amdgcn_readfirstlane(tid >> 6);
    F.G = G; F.vcu = (G % 8 == 0) ? (bx % 8) * (G / 8) + bx / 8 : bx;
    F.gw = F.vcu * 8 + F.wave; F.NGW = G * 8; F.ws = ws; return F;
}
#define MFMA16(a, b, c) __builtin_amdgcn_mfma_f32_16x16x32_bf16((a), (b), (c), 0, 0, 0)

__device__ __forceinline__ void p0_transpose_item(const float* W, int K, int N, const float* gk, bf16_t* WT, int kb, int n0src, int rowdst, LAS float* scr, int lane) {
    const int k0 = 64 * kb;
#pragma unroll 8
    for (int i = 0; i < 32; ++i) { const int kk = 2 * i + (lane >> 5); float v = W[(size_t)(k0 + kk) * N + n0src + (lane & 31)]; if (gk) v *= gk[k0 + kk]; scr[kk * 33 + (lane & 31)] = v; }
    asm volatile("s_waitcnt lgkmcnt(0)" ::: "memory");
    const int c = lane & 7;
#pragma unroll
    for (int j = 0; j < 4; ++j) { const int n = (lane >> 3) + 8 * j; const LAS float* s = scr + (8 * c) * 33 + n;
        u32x4 o; o.x = cvt_pk_bf16(s[0 * 33], s[1 * 33]); o.y = cvt_pk_bf16(s[2 * 33], s[3 * 33]); o.z = cvt_pk_bf16(s[4 * 33], s[5 * 33]); o.w = cvt_pk_bf16(s[6 * 33], s[7 * 33]);
        *(u32x4*)(WT + (size_t)(rowdst + n) * K + k0 + 8 * c) = o; }
    asm volatile("s_waitcnt lgkmcnt(0)" ::: "memory");
}
__device__ __forceinline__ void win_map(int s, int& isB, int& row) {
    isB = 0;
    if (s < 512) { isB = 1; row = s; }
    else if (s < 1536) { const int j = (s - 512) >> 7, i = (s - 512) & 127; row = 256 * j + i; }
    else if (s < 2560) { isB = 1; row = 512 + (s - 1536); }
    else if (s < 3072) row = 2048 + (s - 2560);
    else if (s < 3584) row = 2560 + (s - 3072);
    else if (s < 4608) { const int j = (s - 3584) >> 7, i = (s - 3584) & 127; row = 256 * j + 128 + i; }
    else row = 3072 + (s - 4608);
}
__device__ __forceinline__ void p0_prologue(const Frame& F, const Args& a) {
    const float* x = a.in[0]; const float* norm_g = a.in[1]; const float* w_in = a.in[2];
    const float *lam_re = a.in[3], *lam_im = a.in[4], *b_re = a.in[5], *b_im = a.in[6], *log_dt = a.in[10];
    const float *w_glu = a.in[11], *w_s = a.in[15], *w_pool = a.in[17], *w_out = a.in[19];
    unsigned char* ws = F.ws;
    LAS float* scr = (LAS float*)(F.lds + F.wave * 16384);
    constexpr int I_IN = 32 * 160, I_OUT = 32 * 64, I_GLU = 8 * 16, I_ALL = 2 * (I_IN + I_OUT + I_GLU);
    for (int it = F.gw; it < I_ALL; it += F.NGW) {
        int r = it; const int l = r / (I_IN + I_OUT + I_GLU); r -= l * (I_IN + I_OUT + I_GLU);
        if (r < I_IN) { const int kb = r / 160, nb = r % 160; int isB, row; win_map(32 * nb, isB, row);
            if (32 * nb >= 2560 && 32 * nb < 3072) {
                const int dq = 32 * nb - 2560, g = dq >> 7, k0 = 64 * kb, cc = F.lane & 15, qq = F.lane >> 4;
                bf16_t* WT = (bf16_t*)(ws + WS_WA) + (size_t)l * WA_ROWS * DM;
                f32x4 accq[4][2];
#pragma unroll
                for (int mt = 0; mt < 4; ++mt) { accq[mt][0] = (f32x4){0.f, 0.f, 0.f, 0.f}; accq[mt][1] = (f32x4){0.f, 0.f, 0.f, 0.f}; }
#pragma unroll
                for (int ks = 0; ks < 4; ++ks) {
                    bf16x8 bq[2];
#pragma unroll
                    for (int nt = 0; nt < 2; ++nt) { const float* wp = w_pool + (((size_t)l * 4 + g) * 128 + 32 * ks + 8 * qq) * 128 + (dq & 127) + 16 * nt + cc; u32x4 p;
                        p.x = pk_bf16_c(wp[0], wp[128]); p.y = pk_bf16_c(wp[256], wp[384]); p.z = pk_bf16_c(wp[512], wp[640]); p.w = pk_bf16_c(wp[768], wp[896]); bq[nt] = __builtin_bit_cast(bf16x8, p); }
#pragma unroll
                    for (int mt = 0; mt < 4; ++mt) { const int k = k0 + 16 * mt + cc; const float gs = norm_g[l * DM + k];
                        const f32x4* ap = (const f32x4*)(w_in + ((size_t)l * DM + k) * INC + 2560 + 128 * g + 32 * ks + 8 * qq); const f32x4 a0 = ap[0] * gs, a1 = ap[1] * gs; u32x4 p;
                        p.x = pk_bf16_c(a0[0], a0[1]); p.y = pk_bf16_c(a0[2], a0[3]); p.z = pk_bf16_c(a1[0], a1[1]); p.w = pk_bf16_c(a1[2], a1[3]); const bf16x8 aq = __builtin_bit_cast(bf16x8, p);
                        accq[mt][0] = MFMA16(aq, bq[0], accq[mt][0]); accq[mt][1] = MFMA16(aq, bq[1], accq[mt][1]); } }
#pragma unroll
                for (int mt = 0; mt < 4; ++mt)
#pragma unroll
                    for (int nt = 0; nt < 2; ++nt) { u32x2 o; o.x = cvt_pk_bf16(accq[mt][nt][0], accq[mt][nt][1]); o.y = cvt_pk_bf16(accq[mt][nt][2], accq[mt][nt][3]);
                        *(u32x2*)(WT + (size_t)(row + 16 * nt + cc) * DM + k0 + 16 * mt + 4 * qq) = o; }
                continue; }
            bf16_t* dst = isB ? (bf16_t*)(ws + WS_WB) + (size_t)l * WB_ROWS * DM : (bf16_t*)(ws + WS_WA) + (size_t)l * WA_ROWS * DM;
            p0_transpose_item(w_in + (size_t)l * DM * INC, DM, INC, norm_g + l * DM, dst, kb, 32 * nb, row, scr, F.lane); continue; }
        r -= I_IN;
        if (r < I_OUT) { const int kb = r / 64, nb = r % 64;
            p0_transpose_item(w_out + (size_t)l * DM * DM, DM, DM, nullptr, (bf16_t*)(ws + WS_WOUT) + (size_t)l * DM * DM, kb, 32 * nb, 32 * nb, scr, F.lane); continue; }
        r -= I_OUT;
        { const int kb = r / 16, nb = r % 16;
            p0_transpose_item(w_glu + (size_t)l * 512 * 512, 512, 512, nullptr, (bf16_t*)(ws + WS_WGLU) + (size_t)l * 512 * 512, kb, 32 * nb, 32 * nb, scr, F.lane); }
    }
    { bf16_t* XB = (bf16_t*)(ws + WS_XB); u64* ssq0 = (u64*)(ws + WS_SSQ);
      for (int m = F.gw; m < MTOK; m += F.NGW) {
          const f32x4* xr = (const f32x4*)(x + (size_t)m * DM) + F.lane; u32x2* o = (u32x2*)(XB + (size_t)m * DM) + F.lane; float s = 0.f;
#pragma unroll
          for (int j = 0; j < 8; ++j) { const f32x4 v = xr[64 * j]; s += (v[0] * v[0] + v[1] * v[1]) + (v[2] * v[2] + v[3] * v[3]);
              u32x2 w; w.x = cvt_pk_bf16(v[0], v[1]); w.y = cvt_pk_bf16(v[2], v[3]); o[64 * j] = w; }
          s = wave_sum(s);
          if (F.lane == 0) ssq0[m] = (u64)(s * SSQ_SCALE);
      } }
    const int gt = F.vcu * NTHR + F.tid, NGT = F.G * NTHR;
    { u64* ssq = (u64*)(ws + WS_SSQ) + MTOK; for (int i = gt; i < 2 * MTOK; i += NGT) ssq[i] = 0ull; }
    { float* PAR = (float*)(ws + WS_PAR);
      for (int i = gt; i < PAR_N; i += NGT) { float v;
          if (i < PAR_LNG) v = a.in[12][i - PAR_BGLU]; else if (i < PAR_LNB) v = a.in[13][i - PAR_LNG]; else if (i < PAR_BS) v = a.in[14][i - PAR_LNB];
          else if (i < PAR_PSC) v = a.in[16][i - PAR_BS]; else if (i < PAR_FG) v = a.in[18][i - PAR_PSC]; else v = a.in[20][i - PAR_FG];
          PAR[i] = v; } }
    { bf16_t* WSG = (bf16_t*)(ws + WS_WSG);
      for (int i = gt; i < 2 * 8 * 128 * 128; i += NGT) { const int s = i & 127, t = (i >> 7) & 127; WSG[i] = (bf16_t)(cvt_pk_bf16(s <= t ? w_s[i] : 0.f, 0.f) & 0xffffu); }
    }
    { f32x2* POW = (f32x2*)(ws + WS_POW); f32x2* BBAR = (f32x2*)(ws + WS_BBAR);
      for (int i = gt; i < 2 * S5G * S5P; i += NGT) { const int lg = i >> 6;
          const double dt = exp((double)log_dt[lg]), lr = (double)lam_re[i], li = (double)lam_im[i];
          for (int n = 0; n <= 16; ++n) { const double mg = exp(lr * dt * n), th = li * dt * n; POW[(size_t)i * 17 + n] = (f32x2){(float)(mg * cos(th)), (float)(mg * sin(th))}; }
          const double mg = exp(lr * dt), th = li * dt, nr = mg * cos(th) - 1.0, ni = mg * sin(th), den = lr * lr + li * li;
          const double qr = (nr * lr + ni * li) / den, qi = (ni * lr - nr * li) / den;
          for (int h = 0; h < 16; ++h) { const double br = (double)b_re[(size_t)i * 16 + h], bi = (double)b_im[(size_t)i * 16 + h];
              BBAR[(size_t)i * 16 + h] = (f32x2){(float)(qr * br - qi * bi), (float)(qr * bi + qi * br)}; } } }
}
__device__ __forceinline__ void s5_tables_a(const Frame& F, const Args& a) {
    const float *c_re = a.in[7], *c_im = a.in[8], *d_skip = a.in[9];
    unsigned char* ws = F.ws; const f32x2* POW = (const f32x2*)(ws + WS_POW); const f32x2* BBAR = (const f32x2*)(ws + WS_BBAR);
    const int gt = F.vcu * NTHR + F.tid, NGT = F.G * NTHR;
    float* KT = (float*)(ws + WS_KT);
    for (int i = gt; i < 2 * S5G * 16 * 256; i += NGT) {
        const int h2 = i & 15, h = (i >> 4) & 15, d = (i >> 8) & 15, lg = i >> 12; float s = 0.f;
        for (int p = 0; p < 64; ++p) { const f32x2 pw = POW[((size_t)lg * 64 + p) * 17 + d], bb = BBAR[((size_t)lg * 64 + p) * 16 + h2];
            const float cr = c_re[((size_t)lg * 16 + h) * 64 + p], ci = c_im[((size_t)lg * 16 + h) * 64 + p];
            const float zr = pw.x * bb.x - pw.y * bb.y, zi = pw.x * bb.y + pw.y * bb.x; s += cr * zr - ci * zi; }
        if (d == 0 && h == h2) s += d_skip[lg * 16 + h];
        KT[i] = s; }
    bf16_t* WEND = (bf16_t*)(ws + WS_WEND);
    for (int i = gt; i < 2 * S5G * 128 * 256; i += NGT) {
        const int t = i & 15, h = (i >> 4) & 15, p2 = (i >> 8) & 127, lg = i >> 15, p = p2 & 63;
        const f32x2 pw = POW[((size_t)lg * 64 + p) * 17 + (15 - t)], bb = BBAR[((size_t)lg * 64 + p) * 16 + h];
        const float v = p2 < 64 ? pw.x * bb.x - pw.y * bb.y : pw.x * bb.y + pw.y * bb.x;
        WEND[i] = (bf16_t)(cvt_pk_bf16(v, 0.f) & 0xffffu); }
    bf16_t* WS5 = (bf16_t*)(ws + WS_WS5);
    for (int i = gt; i < 2 * S5G * 256 * 128; i += NGT) {
        const int p2 = i & 127, row = (i >> 7) & 255, lg = i >> 15, p = p2 & 63, rr = row >> 4, t = 4 * (rr >> 2) + ((row >> 2) & 3), h = 4 * (rr & 3) + (row & 3);
        const f32x2 pw = POW[((size_t)lg * 64 + p) * 17 + (t + 1)];
        const float cr = c_re[((size_t)lg * 16 + h) * 64 + p], ci = c_im[((size_t)lg * 16 + h) * 64 + p];
        const float v = p2 < 64 ? cr * pw.x - ci * pw.y : -(cr * pw.y + ci * pw.x);
        WS5[((size_t)lg * 256 + row) * 384 + 256 + p2] = (bf16_t)(cvt_pk_bf16(v, 0.f) & 0xffffu); }
}
__device__ __forceinline__ void s5_tables_b(const Frame& F) {
    unsigned char* ws = F.ws; const float* KT = (const float*)(ws + WS_KT); bf16_t* WS5 = (bf16_t*)(ws + WS_WS5);
    const int gt = F.vcu * NTHR + F.tid, NGT = F.G * NTHR;
    for (int i = gt; i < 2 * S5G * 256 * 256; i += NGT) {
        const int k = i & 255, row = (i >> 8) & 255, lg = i >> 16, rr = row >> 4, t = 4 * (rr >> 2) + ((row >> 2) & 3), h = 4 * (rr & 3) + (row & 3), h2 = k >> 4, t2 = k & 15;
        const float v = t2 <= t ? KT[(((size_t)lg * 16 + (t - t2)) * 16 + h) * 16 + h2] : 0.f;
        WS5[((size_t)lg * 256 + row) * 384 + k] = (bf16_t)(cvt_pk_bf16(v, 0.f) & 0xffffu); }
}

__device__ __forceinline__ void p2_ln(const Frame& F, const float* ln_g, const float* ln_b, bf16_t* DST) {
    bf16_t* GVT = (bf16_t*)(F.ws + WS_GVT);
    LAS float* red = (LAS float*)F.lds;
    LAS float* stat = (LAS float*)(F.lds + 32768);
    const int o = F.tid & 15, r0 = F.tid >> 4;
    for (int c = F.vcu; c < MTOK / 128; c += F.G) {
        bf16_t* gp = GVT + (size_t)r0 * MTOK + c * 128 + 8 * o; bf16_t* dp = DST + (size_t)r0 * MTOK + c * 128 + 8 * o;
        float s[8], q[8];
#pragma unroll
        for (int j = 0; j < 8; ++j) { s[j] = 0.f; q[j] = 0.f; }
#pragma unroll 4
        for (int i = 0; i < 32; ++i) { const u32x4 v = *(const u32x4*)(gp + (size_t)(32 * i) * MTOK);
            const float e0 = bf_lo(v.x), e1 = bf_hi(v.x), e2 = bf_lo(v.y), e3 = bf_hi(v.y), e4 = bf_lo(v.z), e5 = bf_hi(v.z), e6 = bf_lo(v.w), e7 = bf_hi(v.w);
            s[0] += e0; q[0] += e0 * e0; s[1] += e1; q[1] += e1 * e1; s[2] += e2; q[2] += e2 * e2; s[3] += e3; q[3] += e3 * e3;
            s[4] += e4; q[4] += e4 * e4; s[5] += e5; q[5] += e5 * e5; s[6] += e6; q[6] += e6 * e6; s[7] += e7; q[7] += e7 * e7; }
#pragma unroll
        for (int j = 0; j < 8; ++j) { red[(r0 * 128 + 8 * o + j) * 2] = s[j]; red[(r0 * 128 + 8 * o + j) * 2 + 1] = q[j]; }
        __syncthreads();
        if (F.tid < 128) { float ss = 0.f, qq = 0.f;
            for (int r = 0; r < 32; ++r) { ss += red[(r * 128 + F.tid) * 2]; qq += red[(r * 128 + F.tid) * 2 + 1]; }
            const float mean = ss * (1.0f / 1024.0f), var = fmaxf(qq * (1.0f / 1024.0f) - mean * mean, 0.f);
            stat[F.tid * 2] = mean; stat[F.tid * 2 + 1] = rsqrtf(var + LN_EPS); }
        __syncthreads();
        float mu[8], rs[8];
#pragma unroll
        for (int j = 0; j < 8; ++j) { mu[j] = stat[(8 * o + j) * 2]; rs[j] = stat[(8 * o + j) * 2 + 1]; }
#pragma unroll 4
        for (int i = 0; i < 32; ++i) { const int ch = 32 * i + r0; const float g = ln_g[ch], b = ln_b[ch]; const u32x4 v = *(const u32x4*)(gp + (size_t)(32 * i) * MTOK); u32x4 w;
            w.x = cvt_pk_bf16((bf_lo(v.x) - mu[0]) * rs[0] * g + b, (bf_hi(v.x) - mu[1]) * rs[1] * g + b);
            w.y = cvt_pk_bf16((bf_lo(v.y) - mu[2]) * rs[2] * g + b, (bf_hi(v.y) - mu[3]) * rs[3] * g + b);
            w.z = cvt_pk_bf16((bf_lo(v.z) - mu[4]) * rs[4] * g + b, (bf_hi(v.z) - mu[5]) * rs[5] * g + b);
            w.w = cvt_pk_bf16((bf_lo(v.w) - mu[6]) * rs[6] * g + b, (bf_hi(v.w) - mu[7]) * rs[7] * g + b);
            *(u32x4*)(dp + (size_t)(32 * i) * MTOK) = w; }
        __syncthreads();
    }
}
constexpr int SGU_ROWB = 272;
constexpr int SGU_TILE = 128 * SGU_ROWB;
__device__ __forceinline__ void m1_sgu(const Frame& F, int layer) {
    const bf16_t* GVT = (const bf16_t*)(F.ws + WS_GVT); const bf16_t* UG = (const bf16_t*)(F.ws + WS_UG); bf16_t* Y = (bf16_t*)(F.ws + WS_Y);
    const bf16_t* WSG = (const bf16_t*)(F.ws + WS_WSG) + (size_t)layer * 8 * 128 * 128;
    const float* PAR = (const float*)(F.ws + WS_PAR);
    const float* ln_g = PAR + PAR_LNG + layer * SGUW; const float* ln_b = PAR + PAR_LNB + layer * SGUW; const float* b_s = PAR + PAR_BS + layer * 1024;
    LAS float* red = (LAS float*)F.lds;
    LAS float* stat = (LAS float*)(F.lds + 32768);
    LAS unsigned char* tiles = F.lds + 36864;
    const int o = F.tid & 15, r0 = F.tid >> 4, c = F.lane & 15, q = F.lane >> 4, w = F.wave;
    for (int ch = F.vcu; ch < MTOK / 128; ch += F.G) {
        const bf16_t* gp = GVT + (size_t)r0 * MTOK + ch * 128 + 8 * o;
        { float s[8], qq[8];
#pragma unroll
          for (int j = 0; j < 8; ++j) { s[j] = 0.f; qq[j] = 0.f; }
#pragma unroll 8
          for (int i = 0; i < 32; ++i) { const u32x4 v = *(const u32x4*)(gp + (size_t)(32 * i) * MTOK);
              const float e0 = bf_lo(v.x), e1 = bf_hi(v.x), e2 = bf_lo(v.y), e3 = bf_hi(v.y), e4 = bf_lo(v.z), e5 = bf_hi(v.z), e6 = bf_lo(v.w), e7 = bf_hi(v.w);
              s[0] += e0; qq[0] += e0 * e0; s[1] += e1; qq[1] += e1 * e1; s[2] += e2; qq[2] += e2 * e2; s[3] += e3; qq[3] += e3 * e3;
              s[4] += e4; qq[4] += e4 * e4; s[5] += e5; qq[5] += e5 * e5; s[6] += e6; qq[6] += e6 * e6; s[7] += e7; qq[7] += e7 * e7; }
#pragma unroll
          for (int j = 0; j < 8; ++j) { red[(r0 * 128 + 8 * o + j) * 2] = s[j]; red[(r0 * 128 + 8 * o + j) * 2 + 1] = qq[j]; } }
        __syncthreads();
        if (F.tid < 128) { float ss = 0.f, q2 = 0.f;
            for (int r = 0; r < 32; ++r) { ss += red[(r * 128 + F.tid) * 2]; q2 += red[(r * 128 + F.tid) * 2 + 1]; }
            const float mean = ss * (1.0f / 1024.0f), var = fmaxf(q2 * (1.0f / 1024.0f) - mean * mean, 0.f);
            stat[F.tid * 2] = mean; stat[F.tid * 2 + 1] = rsqrtf(var + LN_EPS); }
        __syncthreads();
        float mu[8], rs[8];
#pragma unroll
        for (int j = 0; j < 8; ++j) { mu[j] = stat[(8 * o + j) * 2]; rs[j] = stat[(8 * o + j) * 2 + 1]; }
        u32x4 stg[4]; bf16x8 wnx[4];
#pragma unroll
        for (int i = 0; i < 4; ++i) stg[i] = *(const u32x4*)(gp + (size_t)(32 * i) * MTOK);
        { const int t0n = 16 * (w & 7);
#pragma unroll
          for (int ks = 0; ks < 4; ++ks) wnx[ks] = *(const bf16x8*)(WSG + ((size_t)0 * 128 + t0n + c) * 128 + 8 * q + 32 * ks); }
#pragma unroll 1
        for (int h = 0; h < 8; ++h) {
            LAS unsigned char* tile = tiles + (h & 1) * SGU_TILE;
#pragma unroll
            for (int i = 0; i < 4; ++i) { const int d = r0 + 32 * i, chn = h * 128 + d, rho = 16 * ((d >> 2) & 7) + 4 * (d >> 5) + (d & 3); const float g = ln_g[chn], b = ln_b[chn]; u32x4 wv;
                wv.x = cvt_pk_bf16((bf_lo(stg[i].x) - mu[0]) * rs[0] * g + b, (bf_hi(stg[i].x) - mu[1]) * rs[1] * g + b);
                wv.y = cvt_pk_bf16((bf_lo(stg[i].y) - mu[2]) * rs[2] * g + b, (bf_hi(stg[i].y) - mu[3]) * rs[3] * g + b);
                wv.z = cvt_pk_bf16((bf_lo(stg[i].z) - mu[4]) * rs[4] * g + b, (bf_hi(stg[i].z) - mu[5]) * rs[5] * g + b);
                wv.w = cvt_pk_bf16((bf_lo(stg[i].w) - mu[6]) * rs[6] * g + b, (bf_hi(stg[i].w) - mu[7]) * rs[7] * g + b);
                *(LAS u32x4*)(tile + rho * SGU_ROWB + 16 * o) = wv; }
            const int tt = (w + h) & 7, t0 = 16 * tt, nks = (tt >> 1) + 1;
            const int m = ch * 128 + t0 + c;
            bf16x8 wcur[4];
#pragma unroll
            for (int ks = 0; ks < 4; ++ks) wcur[ks] = wnx[ks];
            u32x4 ugv[4];
#pragma unroll
            for (int j = 0; j < 4; ++j) ugv[j] = *(const u32x4*)(UG + (size_t)m * 1024 + h * 128 + 32 * q + 8 * j);
            if (h < 7) { const int t0n = 16 * ((w + h + 1) & 7);
#pragma unroll
                for (int i = 0; i < 4; ++i) stg[i] = *(const u32x4*)(gp + (size_t)((h + 1) * 128 + 32 * i) * MTOK);
#pragma unroll
                for (int ks = 0; ks < 4; ++ks) wnx[ks] = *(const bf16x8*)(WSG + ((size_t)(h + 1) * 128 + t0n + c) * 128 + 8 * q + 32 * ks); }
            __syncthreads();
            f32x4 acc[8];
#pragma unroll
            for (int r = 0; r < 8; ++r) acc[r] = (f32x4){0.f, 0.f, 0.f, 0.f};
            const LAS unsigned char* ab = tile + c * SGU_ROWB + 16 * q;
#pragma unroll
            for (int ks = 0; ks < 4; ++ks) { if (ks < nks) {
#pragma unroll
                for (int r = 0; r < 8; ++r) { const bf16x8 av = *(const LAS bf16x8*)(ab + (16 * r) * SGU_ROWB + 64 * ks); acc[r] = MFMA16(av, wcur[ks], acc[r]); } } }
            const float bs = b_s[h * 128 + t0 + c];
#pragma unroll
            for (int j = 0; j < 4; ++j) { const int col = h * 128 + 32 * q + 8 * j; const u32x4 ug = ugv[j]; u32x4 wv;
                wv.x = cvt_pk_bf16((acc[2 * j][0] + bs) * bf_lo(ug.x), (acc[2 * j][1] + bs) * bf_hi(ug.x)); wv.y = cvt_pk_bf16((acc[2 * j][2] + bs) * bf_lo(ug.y), (acc[2 * j][3] + bs) * bf_hi(ug.y));
                wv.z = cvt_pk_bf16((acc[2 * j + 1][0] + bs) * bf_lo(ug.z), (acc[2 * j + 1][1] + bs) * bf_hi(ug.z)); wv.w = cvt_pk_bf16((acc[2 * j + 1][2] + bs) * bf_lo(ug.w), (acc[2 * j + 1][3] + bs) * bf_hi(ug.w));
                *(u32x4*)(Y + (size_t)m * DM + 512 + col) = wv; }
        }
        __syncthreads();
    }
}
constexpr int WE_ROWB = 528;
__device__ __forceinline__ void m1_send(const Frame& F, int layer) {
    const bf16_t* WEND = (const bf16_t*)(F.ws + WS_WEND) + (size_t)layer * S5G * 128 * 256;
    const bf16_t* XAT = (const bf16_t*)(F.ws + WS_XA); float* SE = (float*)(F.ws + WS_SE);
    const int c = F.lane & 15, q = F.lane >> 4, w = F.wave;
    for (int it = F.vcu; it < S5G * 8; it += F.G) {
        const int g = it & 31, rg = it >> 5;
        const bf16_t* xb = XAT + (size_t)(16 * g + (q >> 1)) * MTOK + 8 * (q & 1);
        bf16x8 bx[2][8];
#pragma unroll
        for (int s = 0; s < 2; ++s)
#pragma unroll
            for (int ks = 0; ks < 8; ++ks) bx[s][ks] = *(const bf16x8*)(xb + (size_t)(2 * ks) * MTOK + (size_t)((16 * rg + 2 * w + s) * 16 + c) * 16);
#pragma unroll
        for (int i = 0; i < 8; ++i) { const int e = F.tid + 512 * i, row = e >> 5, ch = e & 31;
            *(LAS u32x4*)(F.lds + row * WE_ROWB + 16 * ch) = *(const u32x4*)(WEND + ((size_t)g * 128 + row) * 256 + 8 * ch); }
        __syncthreads();
#pragma unroll
        for (int s = 0; s < 2; ++s) { const int seg = (16 * rg + 2 * w + s) * 16 + c;
#pragma unroll
            for (int r = 0; r < 8; ++r) { f32x4 acc = (f32x4){0.f, 0.f, 0.f, 0.f};
#pragma unroll
                for (int ks = 0; ks < 8; ++ks) { const bf16x8 aw = *(const LAS bf16x8*)(F.lds + (16 * r + c) * WE_ROWB + 64 * ks + 16 * q); acc = MFMA16(aw, bx[s][ks], acc); }
                *(f32x4*)(SE + ((size_t)seg * 32 + g) * 128 + 16 * r + 4 * q) = acc; } }
        __syncthreads();
    }
}
template <int W> __device__ __forceinline__ void pool_item(const Frame& F, int layer, int r4, int g) {
    constexpr int R = 8;
    const bf16_t* Q = (const bf16_t*)(F.ws + WS_XC); const bf16_t* SG = (const bf16_t*)(F.ws + WS_SG); bf16_t* Y = (bf16_t*)(F.ws + WS_Y);
    const float* psc = (const float*)(F.ws + WS_PAR) + PAR_PSC + layer * POOLW;
    const int o16 = F.lane & 15, sub = F.lane >> 4, m0 = (r4 * 4 + sub) * R, tl0 = m0 & (SEQ - 1), col = g * 128 + 8 * o16;
    u32x4 xs[W - 1 + R];
#pragma unroll
    for (int k = 0; k < W - 1 + R; ++k) { const int tl = tl0 - (W - 1) + k;
        xs[k] = tl >= 0 ? *(const u32x4*)(Q + (size_t)(m0 - (W - 1) + k) * 512 + col) : (u32x4){0u, 0u, 0u, 0u}; }
    const f32x4 p0 = *(const f32x4*)(psc + col), p1 = *(const f32x4*)(psc + col + 4);
    float S[8];
#pragma unroll
    for (int e = 0; e < 8; ++e) S[e] = 0.f;
#pragma unroll
    for (int k = 0; k < W - 1; ++k) { S[0] += bf_lo(xs[k].x); S[1] += bf_hi(xs[k].x); S[2] += bf_lo(xs[k].y); S[3] += bf_hi(xs[k].y); S[4] += bf_lo(xs[k].z); S[5] += bf_hi(xs[k].z); S[6] += bf_lo(xs[k].w); S[7] += bf_hi(xs[k].w); }
#pragma unroll
    for (int i = 0; i < R; ++i) { const u32x4 xv = xs[i + W - 1];
        const float xe[8] = {bf_lo(xv.x), bf_hi(xv.x), bf_lo(xv.y), bf_hi(xv.y), bf_lo(xv.z), bf_hi(xv.z), bf_lo(xv.w), bf_hi(xv.w)};
#pragma unroll
        for (int e = 0; e < 8; ++e) S[e] += xe[e];
        const int cnt = tl0 + i + 1 < W ? tl0 + i + 1 : W; const float inv = 1.0f / (float)cnt;
        const u32x4 sg = *(const u32x4*)(SG + (size_t)(m0 + i) * 1024 + 512 + col); u32x4 wv;
        wv.x = cvt_pk_bf16((S[0] * inv - xe[0]) * p0[0] * bf_lo(sg.x), (S[1] * inv - xe[1]) * p0[1] * bf_hi(sg.x));
        wv.y = cvt_pk_bf16((S[2] * inv - xe[2]) * p0[2] * bf_lo(sg.y), (S[3] * inv - xe[3]) * p0[3] * bf_hi(sg.y));
        wv.z = cvt_pk_bf16((S[4] * inv - xe[4]) * p1[0] * bf_lo(sg.z), (S[5] * inv - xe[5]) * p1[1] * bf_hi(sg.z));
        wv.w = cvt_pk_bf16((S[6] * inv - xe[6]) * p1[2] * bf_lo(sg.w), (S[7] * inv - xe[7]) * p1[3] * bf_hi(sg.w));
        *(u32x4*)(Y + (size_t)(m0 + i) * DM + 1536 + col) = wv;
        const u32x4 ov = xs[i];
        S[0] -= bf_lo(ov.x); S[1] -= bf_hi(ov.x); S[2] -= bf_lo(ov.y); S[3] -= bf_hi(ov.y); S[4] -= bf_lo(ov.z); S[5] -= bf_hi(ov.z); S[6] -= bf_lo(ov.w); S[7] -= bf_hi(ov.w); }
}
__device__ __forceinline__ void p2_pool(const Frame& F, int layer) {
    for (int it = F.gw; it < (MTOK / 32) * 4; it += F.NGW) { const int g = it & 3, r4 = it >> 2;
        if (g == 0) pool_item<2>(F, layer, r4, 0); else if (g == 1) pool_item<4>(F, layer, r4, 1); else if (g == 2) pool_item<8>(F, layer, r4, 2); else pool_item<16>(F, layer, r4, 3); }
}

constexpr int CAR_ROWB = 272;
__device__ __forceinline__ void m3_s5(const Frame& F, int layer) {
    const f32x2* POW = (const f32x2*)(F.ws + WS_POW); const float* SE = (const float*)(F.ws + WS_SE);
    const bf16_t* WS5 = (const bf16_t*)(F.ws + WS_WS5) + (size_t)layer * S5G * 256 * 384;
    const bf16_t* XAT = (const bf16_t*)(F.ws + WS_XA); bf16_t* YG = (bf16_t*)(F.ws + WS_YG);
    LAS unsigned char* car = F.lds;
    LAS f32x2* ends = (LAS f32x2*)(F.lds + 256 * CAR_ROWB);
    const int c = F.lane & 15, q = F.lane >> 4, w = F.wave, p = F.lane, sc = F.wave;
    for (int it = F.vcu; it < NB * S5G * 2; it += F.G) {
        const int b = it >> 6, g = (it >> 1) & 31, half = it & 1;
        { const f32x2 l16 = POW[(((size_t)layer * S5G + g) * 64 + p) * 17 + 16];
          const float* e0 = SE + ((size_t)(b * SEGB + sc * 64) * 32 + g) * 128 + p;
          float er[64], ei[64];
          const bool need = sc < 4 * (half + 1);
          if (need) {
#pragma unroll
              for (int j = 0; j < 64; ++j) { er[j] = e0[(size_t)j * 4096]; ei[j] = e0[(size_t)j * 4096 + 64]; } }
          else {
#pragma unroll
              for (int j = 0; j < 64; ++j) { er[j] = 0.f; ei[j] = 0.f; } }
          float sr = 0.f, si = 0.f;
#pragma unroll
          for (int j = 0; j < 64; ++j) { const float nr = l16.x * sr - l16.y * si + er[j], ni = l16.x * si + l16.y * sr + ei[j]; sr = nr; si = ni; }
          ends[sc * 64 + p] = (f32x2){sr, si};
          float mr = l16.x, mi = l16.y;
#pragma unroll
          for (int k = 0; k < 6; ++k) { const float tr = mr * mr - mi * mi, ti = 2.f * mr * mi; mr = tr; mi = ti; }
          __syncthreads();
          float cr = 0.f, ci = 0.f;
          for (int k = 0; k < sc; ++k) { const f32x2 e = ends[k * 64 + p]; const float nr = mr * cr - mi * ci + e.x, ni = mr * ci + mi * cr + e.y; cr = nr; ci = ni; }
          if ((sc >> 2) == half) { sr = cr; si = ci; LAS unsigned char* rowp = car + ((sc & 3) * 64) * CAR_ROWB + 2 * p;
#pragma unroll
              for (int j = 0; j < 64; ++j) { *(LAS bf16_t*)(rowp + j * CAR_ROWB) = (bf16_t)f2bf_rne(sr); *(LAS bf16_t*)(rowp + j * CAR_ROWB + 128) = (bf16_t)f2bf_rne(si);
                  const float nr = l16.x * sr - l16.y * si + er[j], ni = l16.x * si + l16.y * sr + ei[j]; sr = nr; si = ni; } }
          __syncthreads(); }
        bf16x8 aw[2][12];
#pragma unroll
        for (int rr = 0; rr < 2; ++rr)
#pragma unroll
            for (int ks = 0; ks < 12; ++ks) aw[rr][ks] = *(const bf16x8*)(WS5 + ((size_t)g * 256 + 16 * (2 * w + rr) + c) * 384 + 32 * ks + 8 * q);
        const bf16_t* xw = XAT + (size_t)(16 * g + 2 * w + (q >> 1)) * MTOK + 8 * (q & 1);
        const int segbase = b * SEGB + half * 256;
        LAS unsigned char* xfr = F.lds + 256 * CAR_ROWB + 4096;
        u32x4 pre[4];
#pragma unroll
        for (int s = 0; s < 4; ++s) pre[s] = *(const u32x4*)(xw + (size_t)(segbase + s * 16 + c) * 16);
#pragma unroll 1
        for (int sg4 = 0; sg4 < 4; ++sg4) {
#pragma unroll
            for (int s = 0; s < 4; ++s) *(LAS u32x4*)(xfr + ((s * 8 + w) * 64 + F.lane) * 16) = pre[s];
            if (sg4 < 3) {
#pragma unroll
                for (int s = 0; s < 4; ++s) pre[s] = *(const u32x4*)(xw + (size_t)(segbase + (4 * (sg4 + 1) + s) * 16 + c) * 16); }
            __syncthreads();
#pragma unroll
            for (int s = 0; s < 4; ++s) { const int st = 4 * sg4 + s, seg = segbase + st * 16 + c;
                f32x4 a0 = (f32x4){0.f, 0.f, 0.f, 0.f}, a1 = (f32x4){0.f, 0.f, 0.f, 0.f};
#pragma unroll
                for (int ks = 0; ks < 4; ++ks) { const bf16x8 bc = *(const LAS bf16x8*)(car + (st * 16 + c) * CAR_ROWB + 64 * ks + 16 * q); a0 = MFMA16(aw[0][8 + ks], bc, a0); a1 = MFMA16(aw[1][8 + ks], bc, a1); }
#pragma unroll
                for (int ks = 0; ks < 8; ++ks) { const bf16x8 bx = *(const LAS bf16x8*)(xfr + ((s * 8 + ks) * 64 + F.lane) * 16); a0 = MFMA16(aw[0][ks], bx, a0); a1 = MFMA16(aw[1][ks], bx, a1); }
                const int m = seg * 16 + 4 * (w >> 1) + q; u32x4 o;
                o.x = cvt_pk_bf16(gelu_f(a0[0]), gelu_f(a0[1])); o.y = cvt_pk_bf16(gelu_f(a0[2]), gelu_f(a0[3])); o.z = cvt_pk_bf16(gelu_f(a1[0]), gelu_f(a1[1])); o.w = cvt_pk_bf16(gelu_f(a1[2]), gelu_f(a1[3]));
                *(u32x4*)(YG + (size_t)m * 512 + 16 * g + 8 * (w & 1)) = o; }
            __syncthreads();
        }
        __syncthreads();
    }
}

__device__ __forceinline__ void p_final(const Frame& F, float* out, const float* final_g) {
    const u64* ssq = (const u64*)(F.ws + WS_SSQ) + 2 * (size_t)MTOK;
    for (int m = F.gw; m < MTOK; m += F.NGW) {
        const float rs = rsqrtf((float)ssq[m] * (1.0f / (SSQ_SCALE * (float)DM)) + RMS_EPS);
        f32x4* xr = (f32x4*)(out + (size_t)m * DM) + F.lane; const f32x4* gr = (const f32x4*)final_g + F.lane;
#pragma unroll
        for (int j = 0; j < 8; ++j) { const f32x4 v = xr[64 * j], g = gr[64 * j]; xr[64 * j] = v * rs * g; }
    }
}

constexpr int N_PHASES = 12;
#ifndef PROBE_PHASE
#define PROBE_PHASE (-1)
#endif
#ifndef PROBE_REPS
#define PROBE_REPS 1
#endif
#ifndef PROBE_SUB
#define PROBE_SUB 0
#endif
__global__ void __launch_bounds__(NTHR, 2) hybrid_fwd(Args args) {
    extern __shared__ __attribute__((aligned(16))) unsigned char lds_raw[];
    LAS unsigned char* lds = (LAS unsigned char*)lds_raw;
    volatile LAS unsigned* MISC = (volatile LAS unsigned*)(lds + LDSCTL_OFF);
    if (threadIdx.x < 64) MISC[threadIdx.x] = 0u;
    const int wave_s = __builtin_amdgcn_readfirstlane(threadIdx.x >> 6);
    __syncthreads();
    unsigned char* ws0 = args.ws;
    XcdBarrier bar; bar.bar = (unsigned*)(ws0 + WS_CTL) + 1024; bar.x = 0; bar.st = nullptr;
#if !MK_MULTI
    bar = xcd_barrier_post((unsigned*)(ws0 + WS_CTL) + 1024, MISC + 8);
#endif
#pragma unroll 1
    for (int ph = args.ph_lo; ph < args.ph_hi; ++ph) {
        const int l = ph == 0 ? 0 : (ph - 1) / 5, sub = ph == 0 ? 0 : (ph == N_PHASES - 1 ? 6 : 1 + (ph - 1) % 5);
        const int nrep = (ph == PROBE_PHASE) ? PROBE_REPS : 1;
#pragma unroll 1
        for (int rep = 0; rep < nrep; ++rep) {
            unsigned char* ws = ws0; asm volatile("" : "+s"(ws));
            int bx = blockIdx.x, gx = gridDim.x; asm volatile("" : "+s"(bx), "+s"(gx));
            if (sub == 0) { const Frame F = mkframe(ws, lds, wave_s); p0_prologue(F, args); }
            else if (sub == 1) {
                if (l == 0 && rep == 0) { const Frame F = mkframe(ws, lds, wave_s); s5_tables_a(F, args); }
                SchedIn S{gx, bx, l, (const char*)ws};
                EpiIn E{ws, l};
                pg8::gemm_phase<EpiIn, SchedIn, true, true>(lds, wave_s, DM, DM, DM, S, E);
            } else if (sub == 2) {
                const Frame F = mkframe(ws, lds, wave_s);
                if (l == 0 && rep == 0) s5_tables_b(F);
                if (PROBE_SUB == 0 || PROBE_SUB == 1 || rep == 0) m1_sgu(F, l);
                if (PROBE_SUB == 0 || PROBE_SUB == 2 || rep == 0) m1_send(F, l);
                if (PROBE_SUB == 0 || PROBE_SUB == 3 || rep == 0) p2_pool(F, l);
            } else if (sub == 3) { const Frame F = mkframe(ws, lds, wave_s); m3_s5(F, l); }
            else if (sub == 4) {
                SchedMix S{gx, bx, l, (const char*)ws};
                EpiMix E{ws, l};
                pg8::gemm_phase<EpiMix, SchedMix, true, true>(lds, wave_s, 512, 512, 512, S, E);
            } else if (sub == 5) {
                const float* base_x = l == 0 ? args.in[0] : args.out;
                SchedOut S{gx, bx, l, (const char*)ws};
                EpiOut E{base_x, args.out, ws, l, rep == 0 ? 1 : 0};
                pg8::gemm_phase<EpiOut, SchedOut, true, true>(lds, wave_s, DM, DM, DM, S, E);
            } else { const Frame F = mkframe(ws, lds, wave_s); p_final(F, args.out, (const float*)(ws + WS_PAR) + PAR_FG); }
#if !MK_MULTI
            if (rep + 1 < nrep) xcd_barrier(bar);
#endif
        }
#if !MK_MULTI
        if (ph + 1 < args.ph_hi) xcd_barrier(bar);
#endif
    }
}

extern "C" void kernel_launch(void* const* d_in, const int* in_sizes, int n_in, void* d_out, int out_size, void* d_ws, size_t ws_size, hipStream_t stream) {
    static int grid = 0;
    if (grid == 0) {
        if (n_in != 21 || in_sizes[0] != MTOK * DM || out_size != MTOK * DM || ws_size < WS_END) { fprintf(stderr, "kernel_launch: unexpected shapes (n_in %d, in0 %d, out %d, ws %zu)\n", n_in, n_in > 0 ? in_sizes[0] : -1, out_size, ws_size); grid = -1; return; }
        int dev = 0, cus = 0, per_cu = 0;
        if (hipGetDevice(&dev) != hipSuccess || hipDeviceGetAttribute(&cus, hipDeviceAttributeMultiprocessorCount, dev) != hipSuccess) { grid = -1; return; }
        if (hipFuncSetAttribute((const void*)hybrid_fwd, hipFuncAttributeMaxDynamicSharedMemorySize, LDS_BYTES) != hipSuccess) { fprintf(stderr, "kernel_launch: hipFuncSetAttribute failed\n"); grid = -1; return; }
        if (hipOccupancyMaxActiveBlocksPerMultiprocessor(&per_cu, (const void*)hybrid_fwd, NTHR, LDS_BYTES) != hipSuccess || per_cu < 1) { fprintf(stderr, "kernel_launch: occupancy query says %d blocks per CU\n", per_cu); per_cu = 1; }
        (void)hipGetLastError();
        grid = cus;
    }
    if (grid < 0) return;
    (void)hipMemsetAsync((char*)d_ws + WS_CTL, 0, CTL_ZERO_BYTES, stream);
    Args a{};
    for (int i = 0; i < 21; ++i) a.in[i] = (const float*)d_in[i];
    a.out = (float*)d_out; a.ws = (unsigned char*)d_ws;
#if MK_MULTI
    for (int ph = 0; ph < N_PHASES; ++ph) { a.ph_lo = ph; a.ph_hi = ph + 1; hipLaunchKernelGGL(hybrid_fwd, dim3(grid), dim3(NTHR), LDS_BYTES, stream, a); }
#else
    a.ph_lo = 0; a.ph_hi = N_PHASES;
    void* kargs[] = {&a};
    hipError_t e = hipLaunchCooperativeKernel((const void*)hybrid_fwd, dim3(grid), dim3(NTHR), kargs, LDS_BYTES, stream);
    if (e != hipSuccess) fprintf(stderr, "kernel_launch: cooperative launch failed: %s (grid %d)\n", hipGetErrorString(e), grid);
#endif
}
```

```cpp
#include <hip/hip_runtime.h>
#include <cstdio>
#include <cstdint>

#ifndef MK_MULTI
#define MK_MULTI 0
#endif

#define LAS __attribute__((address_space(3)))
#define GAS __attribute__((address_space(1)))
typedef unsigned short bf16_t;
typedef short bf16x8 __attribute__((ext_vector_type(8)));
typedef float f32x4 __attribute__((ext_vector_type(4)));
typedef float f32x2 __attribute__((ext_vector_type(2)));
typedef unsigned u32x4 __attribute__((ext_vector_type(4)));
typedef unsigned u32x2 __attribute__((ext_vector_type(2)));
typedef unsigned long long u64;

constexpr int DM = 2048, NB = 4, SEQ = 8192, DEPTH = 2, MTOK = NB * SEQ;
constexpr int S5W = 512, SGUW = 1024, POOLW = 512, INC = 5120;
constexpr int S5G = 32, S5H = 16, S5P = 64;
constexpr int NSEG = MTOK / 16, SEGB = SEQ / 16; constexpr int WA_ROWS = 3584, WB_ROWS = 1536;
constexpr float RMS_EPS = 1e-6f, LN_EPS = 1e-5f;
constexpr float SSQ_SCALE = 16777216.0f;

constexpr size_t MiB = 1u << 20;
constexpr size_t WS_CTL = 0, CTL_ZERO_BYTES = 64 * 1024;
constexpr size_t WS_SSQ = 1 * MiB;
constexpr size_t WS_POW = 2 * MiB;
constexpr size_t WS_BBAR = WS_POW + 640 * 1024;
constexpr size_t WS_PAR = 3 * MiB + 256 * 1024;
constexpr int PAR_BGLU = 0, PAR_LNG = 1024, PAR_LNB = 3072, PAR_BS = 5120, PAR_PSC = 7168, PAR_FG = 8192, PAR_N = 10240;
constexpr size_t WS_KT = 4 * MiB;
constexpr size_t WS_WEND = 5 * MiB;
constexpr size_t WS_WS5 = 9 * MiB;
constexpr size_t WS_WSG = 21 * MiB;
constexpr size_t WS_WGLU = 22 * MiB;
constexpr size_t WS_WPD = 23 * MiB;
constexpr size_t WS_WA = 24 * MiB;
constexpr size_t WS_WB = 52 * MiB;
constexpr size_t WS_WOUT = 64 * MiB;
constexpr size_t WS_XB = 80 * MiB;
constexpr size_t WS_XA = 208 * MiB;
constexpr size_t WS_GVT = 240 * MiB;
constexpr size_t WS_UG = 304 * MiB;
constexpr size_t WS_XC = 368 * MiB;
constexpr size_t WS_SG = 400 * MiB;
constexpr size_t WS_PF = 464 * MiB;
constexpr size_t WS_YG = 496 * MiB;
constexpr size_t WS_Y = 528 * MiB;
constexpr size_t WS_SE = 656 * MiB;
constexpr size_t WS_CARRY = 688 * MiB;
constexpr size_t WS_END = 704 * MiB;

__device__ __forceinline__ unsigned cvt_pk_bf16(float lo, float hi) { unsigned r; asm volatile("v_cvt_pk_bf16_f32 %0, %1, %2" : "=v"(r) : "v"(lo), "v"(hi)); return r; }
__device__ __forceinline__ unsigned f2bf_rne(float f) { unsigned u = __float_as_uint(f); return (u + 0x7fffu + ((u >> 16) & 1u)) >> 16; }
__device__ __forceinline__ unsigned pk_bf16_c(float lo, float hi) { return f2bf_rne(lo) | (f2bf_rne(hi) << 16); }
__device__ __forceinline__ float bf_lo(unsigned w) { return __uint_as_float(w << 16); }
__device__ __forceinline__ float bf_hi(unsigned w) { return __uint_as_float(w & 0xffff0000u); }
__device__ __forceinline__ float bf2f(bf16_t b) { return __uint_as_float(((unsigned)b) << 16); }
__device__ __forceinline__ float sigmoid_f(float x) { return __builtin_amdgcn_rcpf(1.0f + __builtin_amdgcn_exp2f(-1.4426950408889634f * x)); }
__device__ __forceinline__ float silu_f(float x) { return x * sigmoid_f(x); }
__device__ __forceinline__ float gelu_f(float x) {
    const float u = x * (1.0f + 0.044715f * x * x);
    return x * __builtin_amdgcn_rcpf(1.0f + __builtin_amdgcn_exp2f(-2.302208198f * u));
}
__device__ __forceinline__ float wave_sum(float v) {
#pragma unroll
    for (int o = 1; o < 64; o <<= 1) v += __shfl_xor(v, o);
    return v;
}

namespace pg8 {
constexpr int BM = 256, BK = 64, HALF = 128, HTB = HALF * BK * 2, STAGE_BYTES = 8 * HTB, NXCD = 8, WGM = 8;
__host__ __device__ __forceinline__ int lds_byte(int r, int c) { const int st = (r >> 4) * 2 + (c >> 5), rr = r & 15, cc = c & 31, ob = rr * 64 + cc * 2; return st * 1024 + (ob ^ (((ob >> 9) & 1) << 5)); }
__host__ __device__ __forceinline__ void stage_rc(int b, int& R, int& C) { const int st = b / 1024, sb = b % 1024, swz = sb ^ (((sb >> 9) & 1) << 5); R = (st >> 1) * 16 + swz / 64; C = (st & 1) * 32 + (swz % 64) / 2; }
__host__ __device__ __forceinline__ int perm32(int rho) { const int n = rho >> 4, i = rho & 15; return 8 * (i >> 2) + 4 * n + (i & 3); }

struct Unit { int pm, pn, type, cb; const char* A; const char* B; };
__device__ __forceinline__ void tile_of(int L, int nM, int nN, int& pm, int& pn) {
    const int nwg = nM * nN; int wgid = L; { const int q = nwg / NXCD, r = nwg % NXCD, xcd = wgid % NXCD, off = wgid / NXCD; wgid = (xcd < r ? xcd * (q + 1) : r * (q + 1) + (xcd - r) * q) + off; }
    const int nig = WGM * nN, gid = wgid / nig, fm = gid * WGM, gsz = (nM - fm) < WGM ? (nM - fm) : WGM;
    pm = fm + ((wgid % nig) % gsz); pn = (wgid % nig) / gsz;
}

template <class Epi, class Sched, bool ALIGN_EPI, bool SP2>
__device__ __forceinline__ void gemm_phase(LAS unsigned char* lds, const int wave_s, const int K, const int ldA, const int ldB, const Sched& S, const Epi& E) {
    int tid_ = (wave_s << 6) | (int)__builtin_amdgcn_mbcnt_hi(~0u, __builtin_amdgcn_mbcnt_lo(~0u, 0u)); asm volatile("" : "+v"(tid_));
    const int tid = tid_, wid = __builtin_amdgcn_readfirstlane(tid >> 6), lane = tid & 63, wr = wid >> 2, wc = wid & 3, fr = lane & 15, fq = lane >> 4;
    const int nt = K / BK;
    unsigned voffA[2], voffB[2];
#pragma unroll
    for (int i = 0; i < 2; ++i) { int R, C; stage_rc(tid * 16 + i * 8192, R, C); const int Rb = (R & ~31) + perm32(R & 31);
        voffA[i] = (unsigned)(R * ldA + C) * 2u; voffB[i] = (unsigned)(Rb * ldB + C) * 2u; }
    const size_t kstep = (size_t)(BK * 2);
    const size_t hstepA = (size_t)HALF * ldA * 2, hstepB = (size_t)HALF * ldB * 2;
    const unsigned ldsw = (unsigned)wid * 1024u;
    const int aoff = lds_byte(wr * 64 + fr, fq * 8), boff = lds_byte(wc * 32 + fr, fq * 8);
#define PG8_SA(b, h) (((b) * 2 + (h)) * HTB)
#define PG8_SB(b, h) ((4 + (b) * 2 + (h)) * HTB)
#define PG8_STAGE(bufoff, gbase, voff) do { _Pragma("unroll") for (int _i = 0; _i < 2; ++_i) \
        __builtin_amdgcn_global_load_lds((const unsigned*)((const char*)(gbase) + (voff)[_i]), (LAS unsigned*)(lds + (bufoff) + ldsw + _i * 8192), 16, 0, 0); } while (0)
#define PG8_LDA(dst, b, h) do { _Pragma("unroll") for (int m = 0; m < 4; ++m) _Pragma("unroll") for (int k = 0; k < 2; ++k) dst[m][k] = *(const LAS bf16x8*)(lds + PG8_SA(b, h) + aoff + m * 2048 + k * 1024); } while (0)
#define PG8_LDB(dst, b, h) do { _Pragma("unroll") for (int n = 0; n < 2; ++n) _Pragma("unroll") for (int k = 0; k < 2; ++k) dst[n][k] = *(const LAS bf16x8*)(lds + PG8_SB(b, h) + boff + n * 2048 + k * 1024); } while (0)
#define PG8_MMA(ai, bj, At, Bt) do { __builtin_amdgcn_s_setprio(1); _Pragma("unroll") for (int m = 0; m < 4; ++m) _Pragma("unroll") for (int n = 0; n < 2; ++n) _Pragma("unroll") for (int k = 0; k < 2; ++k) \
        acc[ai][bj][m][n] = __builtin_amdgcn_mfma_f32_16x16x32_bf16(Bt[n][k], At[m][k], acc[ai][bj][m][n], 0, 0, 0); __builtin_amdgcn_s_setprio(0); } while (0)
#define PG8_WAIT_V(n) asm volatile("s_waitcnt vmcnt(" #n ")" ::: "memory")
#define PG8_WAIT_L(n) asm volatile("s_waitcnt lgkmcnt(" #n ")" ::: "memory")
#define PG8_BAR __builtin_amdgcn_s_barrier()
#define PG8_SCHED __builtin_amdgcn_sched_barrier(0)
    Unit cur, nxt; int ui = 0;
    if (!S.next(0, cur)) return;
    f32x4 acc[2][2][4][2];
#pragma unroll
    for (int a = 0; a < 2; ++a)
#pragma unroll
        for (int b = 0; b < 2; ++b)
#pragma unroll
            for (int m = 0; m < 4; ++m)
#pragma unroll
                for (int n = 0; n < 2; ++n) acc[a][b][m][n] = (f32x4){0.f, 0.f, 0.f, 0.f};
    bf16x8 At[4][2], B0[2][2], B1[2][2];
    const char* cA = cur.A; const char* cB = cur.B;
    if constexpr (SP2) {
        PG8_STAGE(PG8_SB(0, 0), cB, voffB); PG8_STAGE(PG8_SB(0, 1), cB + hstepB, voffB); PG8_STAGE(PG8_SA(0, 0), cA, voffA); PG8_STAGE(PG8_SA(0, 1), cA + hstepA, voffA);
        if (wr == 1) PG8_BAR;
        PG8_WAIT_V(2); PG8_BAR;
        PG8_STAGE(PG8_SB(1, 0), cB + kstep, voffB); PG8_STAGE(PG8_SA(1, 0), cA + kstep, voffA); PG8_STAGE(PG8_SB(1, 1), cB + hstepB + kstep, voffB);
        PG8_WAIT_V(6); PG8_BAR;
    } else {
        PG8_STAGE(PG8_SB(0, 0), cB, voffB); PG8_STAGE(PG8_SA(0, 0), cA, voffA); PG8_STAGE(PG8_SB(0, 1), cB + hstepB, voffB); PG8_STAGE(PG8_SA(0, 1), cA + hstepA, voffA);
        if (wr == 1) PG8_BAR;
        PG8_WAIT_V(4); PG8_BAR;
        PG8_STAGE(PG8_SB(1, 0), cB + kstep, voffB); PG8_STAGE(PG8_SA(1, 0), cA + kstep, voffA); PG8_STAGE(PG8_SB(1, 1), cB + hstepB + kstep, voffB);
        PG8_WAIT_V(6); PG8_BAR;
    }
    for (;;) {
        const bool has_next = S.next(ui + 1, nxt);
        const char* nA = has_next ? nxt.A : cA; const char* nB = has_next ? nxt.B : cB;
        for (int t = 0; t < nt; t += 2) {
            const bool last = (t == nt - 2);
            const char* a1 = cA + (size_t)(t + 1) * kstep;
            const char* a2 = last ? nA : cA + (size_t)(t + 2) * kstep; const char* b2 = last ? nB : cB + (size_t)(t + 2) * kstep;
            const char* a3 = a2 + kstep; const char* b3 = b2 + kstep;
            if constexpr (SP2) {
            PG8_LDB(B0, 0, 0); PG8_LDB(B1, 0, 1); PG8_SCHED; PG8_LDA(At, 0, 0); PG8_STAGE(PG8_SA(1, 1), a1 + hstepA, voffA);
            PG8_WAIT_V(8); PG8_WAIT_L(0); PG8_BAR; PG8_MMA(0, 0, At, B0); PG8_MMA(0, 1, At, B1); PG8_BAR; PG8_SCHED;
            PG8_LDA(At, 0, 1); PG8_STAGE(PG8_SB(0, 0), b2, voffB); PG8_STAGE(PG8_SB(0, 1), b2 + hstepB, voffB); PG8_STAGE(PG8_SA(0, 0), a2, voffA);
            PG8_WAIT_V(8); PG8_WAIT_L(0); PG8_BAR; PG8_MMA(1, 0, At, B0); PG8_MMA(1, 1, At, B1); PG8_BAR; PG8_SCHED;
            PG8_LDB(B0, 1, 0); PG8_LDB(B1, 1, 1); PG8_SCHED; PG8_LDA(At, 1, 0); PG8_STAGE(PG8_SA(0, 1), a2 + hstepA, voffA);
            PG8_WAIT_V(8); PG8_WAIT_L(0); PG8_BAR; PG8_MMA(0, 0, At, B0); PG8_MMA(0, 1, At, B1); PG8_BAR; PG8_SCHED;
            PG8_LDA(At, 1, 1); PG8_STAGE(PG8_SB(1, 0), b3, voffB); PG8_STAGE(PG8_SB(1, 1), b3 + hstepB, voffB); PG8_STAGE(PG8_SA(1, 0), a3, voffA);
            PG8_WAIT_V(8); PG8_WAIT_L(0); PG8_BAR; PG8_MMA(1, 0, At, B0); PG8_MMA(1, 1, At, B1); PG8_BAR; PG8_SCHED;
            } else {
            PG8_LDB(B0, 0, 0); PG8_SCHED; PG8_LDA(At, 0, 0); PG8_STAGE(PG8_SA(1, 1), a1 + hstepA, voffA);
            PG8_WAIT_L(8); PG8_BAR; PG8_WAIT_L(0); PG8_MMA(0, 0, At, B0); PG8_BAR; PG8_SCHED;
            PG8_LDB(B1, 0, 1); PG8_STAGE(PG8_SB(0, 0), b2, voffB);
            PG8_BAR; PG8_WAIT_L(0); PG8_MMA(0, 1, At, B1); PG8_BAR;
            PG8_LDA(At, 0, 1); PG8_STAGE(PG8_SA(0, 0), a2, voffA);
            PG8_BAR; PG8_WAIT_L(0); PG8_MMA(1, 0, At, B0); PG8_BAR; PG8_SCHED;
            PG8_STAGE(PG8_SB(0, 1), b2 + hstepB, voffB);
            PG8_WAIT_V(6); PG8_BAR; PG8_MMA(1, 1, At, B1); PG8_BAR;
            PG8_LDB(B0, 1, 0); PG8_SCHED; PG8_LDA(At, 1, 0); PG8_STAGE(PG8_SA(0, 1), a2 + hstepA, voffA);
            PG8_WAIT_L(8); PG8_BAR; PG8_WAIT_L(0); PG8_MMA(0, 0, At, B0); PG8_BAR; PG8_SCHED;
            PG8_LDB(B1, 1, 1); PG8_STAGE(PG8_SB(1, 0), b3, voffB);
            PG8_BAR; PG8_WAIT_L(0); PG8_MMA(0, 1, At, B1); PG8_BAR;
            PG8_LDA(At, 1, 1); PG8_STAGE(PG8_SA(1, 0), a3, voffA);
            PG8_BAR; PG8_WAIT_L(0); PG8_MMA(1, 0, At, B0); PG8_BAR; PG8_SCHED;
            PG8_STAGE(PG8_SB(1, 1), b3 + hstepB, voffB);
            PG8_WAIT_V(6); PG8_BAR; PG8_MMA(1, 1, At, B1); PG8_BAR;
            }
        }
        if constexpr (ALIGN_EPI) { if (wr == 0) PG8_BAR; }
        E(acc, cur, wr, wc, fr, fq);
        if (!has_next) break;
#pragma unroll
        for (int a = 0; a < 2; ++a)
#pragma unroll
            for (int b = 0; b < 2; ++b)
#pragma unroll
                for (int m = 0; m < 4; ++m)
#pragma unroll
                    for (int n = 0; n < 2; ++n) acc[a][b][m][n] = (f32x4){0.f, 0.f, 0.f, 0.f};
        cur = nxt; cA = nA; cB = nB; ++ui;
        if constexpr (ALIGN_EPI) { if (wr == 1) PG8_BAR; }
    }
    PG8_WAIT_V(0);
    if constexpr (!ALIGN_EPI) { if (wr == 0) PG8_BAR; }
    PG8_BAR;
#undef PG8_SA
#undef PG8_SB
#undef PG8_STAGE
#undef PG8_LDA
#undef PG8_LDB
#undef PG8_MMA
#undef PG8_WAIT_V
#undef PG8_WAIT_L
#undef PG8_BAR
#undef PG8_SCHED
}
}
using pg8::Unit;

struct SchedIn {
    int G, c, l; const char* ws;
    __device__ __forceinline__ bool next(int i, Unit& u) const {
        const int L = i * G + c; const char* XB = ws + WS_XB;
        if (L < 1792) { pg8::tile_of(L, 128, 14, u.pm, u.pn);
            u.A = XB + (size_t)u.pm * 256 * DM * 2; u.B = ws + WS_WA + ((size_t)l * WA_ROWS + (size_t)u.pn * 256) * DM * 2;
            const int pn = u.pn;
            if (pn < 8) { u.type = 1; u.cb = 128 * pn; }
            else if (pn < 10) { u.type = 2; u.cb = 256 * (pn - 8); }
            else { u.type = 3; u.cb = 256 * (pn - 10); }
            return true; }
        const int L2 = L - 1792; if (L2 >= 768) return false;
        pg8::tile_of(L2, 6, 128, u.pm, u.pn);
        u.A = ws + WS_WB + ((size_t)l * WB_ROWS + (size_t)u.pm * 256) * DM * 2; u.B = XB + (size_t)u.pn * 256 * DM * 2;
        if (u.pm < 2) { u.type = 5; u.cb = 256 * u.pm; } else { u.type = 4; u.cb = 256 * (u.pm - 2); }
        return true;
    }
};
struct SchedMix {
    int G, c, l; const char* ws;
    __device__ __forceinline__ bool next(int i, Unit& u) const {
        const int L = i * G + c; if (L >= 256) return false;
        pg8::tile_of(L, 128, 2, u.pm, u.pn);
        u.type = 0; u.cb = 256 * u.pn; u.A = ws + WS_YG + (size_t)u.pm * 256 * 512 * 2; u.B = ws + WS_WGLU + ((size_t)l * 512 + (size_t)u.pn * 256) * 512 * 2;
        return true;
    }
};
struct SchedOut {
    int G, c, l; const char* ws;
    __device__ __forceinline__ bool next(int i, Unit& u) const {
        const int L = i * G + c; if (L >= 1024) return false;
        pg8::tile_of(L, 128, 8, u.pm, u.pn); u.type = 0; u.cb = 256 * u.pn;
        u.A = ws + WS_Y + (size_t)u.pm * 256 * DM * 2; u.B = ws + WS_WOUT + ((size_t)l * DM + (size_t)u.pn * 256) * DM * 2; return true;
    }
};

struct EpiIn {
    unsigned char* ws; int l;
    __device__ __forceinline__ float rstd_of(int row) const { const u64* ssq = (const u64*)(ws + WS_SSQ) + (size_t)l * MTOK; return rsqrtf((float)ssq[row] * (1.0f / (SSQ_SCALE * (float)DM)) + RMS_EPS); }
    __device__ __forceinline__ void operator()(const f32x4 (&acc)[2][2][4][2], const Unit& u, int wr, int wc, int fr, int fq) const {
        const int type = u.type;
        if (type >= 4) {
            const int col0 = u.pn * 256 + wc * 32 + 8 * fq;
            float cs[2][8];
#pragma unroll
            for (int bj = 0; bj < 2; ++bj)
#pragma unroll
                for (int e = 0; e < 8; ++e) cs[bj][e] = rstd_of(col0 + bj * 128 + e);
#pragma unroll
            for (int ai = 0; ai < 2; ++ai)
#pragma unroll
                for (int m = 0; m < 4; ++m) {
                    const int r = u.cb + ai * 128 + wr * 64 + m * 16 + fr; bf16_t* rowp = (bf16_t*)(ws + (type == 4 ? WS_GVT : WS_XA)) + (size_t)r * MTOK + col0;
#pragma unroll
                    for (int bj = 0; bj < 2; ++bj) { const f32x4 v0 = acc[ai][bj][m][0], v1 = acc[ai][bj][m][1]; u32x4 w;
                        float e[8] = {v0[0] * cs[bj][0], v0[1] * cs[bj][1], v0[2] * cs[bj][2], v0[3] * cs[bj][3], v1[0] * cs[bj][4], v1[1] * cs[bj][5], v1[2] * cs[bj][6], v1[3] * cs[bj][7]};
                        if (type == 4) {
#pragma unroll
                            for (int k = 0; k < 8; ++k) e[k] = gelu_f(e[k]); }
                        w.x = cvt_pk_bf16(e[0], e[1]); w.y = cvt_pk_bf16(e[2], e[3]); w.z = cvt_pk_bf16(e[4], e[5]); w.w = cvt_pk_bf16(e[6], e[7]);
                        *(u32x4*)(rowp + bj * 128) = w; }
                }
            return;
        }
        const int row0 = u.pm * 256 + wr * 64 + fr, cw = wc * 32 + 8 * fq;
        if (type == 1) {
#pragma unroll
            for (int ai = 0; ai < 2; ++ai)
#pragma unroll
                for (int m = 0; m < 4; ++m) { const int row = row0 + ai * 128 + m * 16; const float rs = rstd_of(row);
                    const f32x4 a0 = acc[ai][0][m][0] * rs, a1 = acc[ai][0][m][1] * rs, g0 = acc[ai][1][m][0] * rs, g1 = acc[ai][1][m][1] * rs; u32x4 w;
                    w.x = cvt_pk_bf16(gelu_f(a0[0]) * silu_f(g0[0]), gelu_f(a0[1]) * silu_f(g0[1])); w.y = cvt_pk_bf16(gelu_f(a0[2]) * silu_f(g0[2]), gelu_f(a0[3]) * silu_f(g0[3]));
                    w.z = cvt_pk_bf16(gelu_f(a1[0]) * silu_f(g1[0]), gelu_f(a1[1]) * silu_f(g1[1])); w.w = cvt_pk_bf16(gelu_f(a1[2]) * silu_f(g1[2]), gelu_f(a1[3]) * silu_f(g1[3]));
                    *(u32x4*)((bf16_t*)(ws + WS_UG) + (size_t)row * 1024 + u.cb + cw) = w; }
            return;
        }
        bf16_t* base = (bf16_t*)(ws + (type == 2 ? WS_XC : WS_SG)); const int ld = type == 3 ? 1024 : 512;
#pragma unroll
        for (int ai = 0; ai < 2; ++ai)
#pragma unroll
            for (int m = 0; m < 4; ++m) { const int row = row0 + ai * 128 + m * 16; const float rs = rstd_of(row); bf16_t* rowp = base + (size_t)row * ld + u.cb + cw;
#pragma unroll
                for (int bj = 0; bj < 2; ++bj) { f32x4 v0 = acc[ai][bj][m][0] * rs, v1 = acc[ai][bj][m][1] * rs;
                    if (type == 3) {
#pragma unroll
                        for (int e = 0; e < 4; ++e) { v0[e] = silu_f(v0[e]); v1[e] = silu_f(v1[e]); } }
                    u32x4 w; w.x = cvt_pk_bf16(v0[0], v0[1]); w.y = cvt_pk_bf16(v0[2], v0[3]); w.z = cvt_pk_bf16(v1[0], v1[1]); w.w = cvt_pk_bf16(v1[2], v1[3]);
                    *(u32x4*)(rowp + bj * 128) = w; } }
    }
};
struct EpiMix {
    unsigned char* ws; int l;
    __device__ __forceinline__ void operator()(const f32x4 (&acc)[2][2][4][2], const Unit& u, int wr, int wc, int fr, int fq) const {
        const int row0 = u.pm * 256 + wr * 64 + fr, cw = u.cb + wc * 32 + 8 * fq;
        const bf16_t* YG = (const bf16_t*)(ws + WS_YG); const bf16_t* SG = (const bf16_t*)(ws + WS_SG); bf16_t* Y = (bf16_t*)(ws + WS_Y);
        const float* bglu = (const float*)(ws + WS_PAR) + PAR_BGLU + l * S5W; const float* pscale = (const float*)(ws + WS_PAR) + PAR_PSC + l * POOLW;
        f32x4 cv[2][2];
#pragma unroll
        for (int bj = 0; bj < 2; ++bj)
#pragma unroll
            for (int n = 0; n < 2; ++n) cv[bj][n] = *(const f32x4*)((u.type == 0 ? bglu : pscale) + cw + bj * 128 + 4 * n);
#pragma unroll
        for (int ai = 0; ai < 2; ++ai)
#pragma unroll
            for (int m = 0; m < 4; ++m) { const int row = row0 + ai * 128 + m * 16;
#pragma unroll
                for (int bj = 0; bj < 2; ++bj) { const int col = cw + bj * 128; const f32x4 a0 = acc[ai][bj][m][0], a1 = acc[ai][bj][m][1]; float o[8];
                    if (u.type == 0) {
                        const u32x4 yg = *(const u32x4*)(YG + (size_t)row * 512 + col), sg = *(const u32x4*)(SG + (size_t)row * 1024 + col);
                        o[0] = bf_lo(yg.x) * sigmoid_f(a0[0] + cv[bj][0][0]) * bf_lo(sg.x); o[1] = bf_hi(yg.x) * sigmoid_f(a0[1] + cv[bj][0][1]) * bf_hi(sg.x);
                        o[2] = bf_lo(yg.y) * sigmoid_f(a0[2] + cv[bj][0][2]) * bf_lo(sg.y); o[3] = bf_hi(yg.y) * sigmoid_f(a0[3] + cv[bj][0][3]) * bf_hi(sg.y);
                        o[4] = bf_lo(yg.z) * sigmoid_f(a1[0] + cv[bj][1][0]) * bf_lo(sg.z); o[5] = bf_hi(yg.z) * sigmoid_f(a1[1] + cv[bj][1][1]) * bf_hi(sg.z);
                        o[6] = bf_lo(yg.w) * sigmoid_f(a1[2] + cv[bj][1][2]) * bf_lo(sg.w); o[7] = bf_hi(yg.w) * sigmoid_f(a1[3] + cv[bj][1][3]) * bf_hi(sg.w);
                        u32x4 w; w.x = cvt_pk_bf16(o[0], o[1]); w.y = cvt_pk_bf16(o[2], o[3]); w.z = cvt_pk_bf16(o[4], o[5]); w.w = cvt_pk_bf16(o[6], o[7]);
                        *(u32x4*)(Y + (size_t)row * DM + col) = w;
                    } else {
                        const u32x4 sg = *(const u32x4*)(SG + (size_t)row * 1024 + 512 + col);
                        o[0] = a0[0] * cv[bj][0][0] * bf_lo(sg.x); o[1] = a0[1] * cv[bj][0][1] * bf_hi(sg.x); o[2] = a0[2] * cv[bj][0][2] * bf_lo(sg.y); o[3] = a0[3] * cv[bj][0][3] * bf_hi(sg.y);
                        o[4] = a1[0] * cv[bj][1][0] * bf_lo(sg.z); o[5] = a1[1] * cv[bj][1][1] * bf_hi(sg.z); o[6] = a1[2] * cv[bj][1][2] * bf_lo(sg.w); o[7] = a1[3] * cv[bj][1][3] * bf_hi(sg.w);
                        u32x4 w; w.x = cvt_pk_bf16(o[0], o[1]); w.y = cvt_pk_bf16(o[2], o[3]); w.z = cvt_pk_bf16(o[4], o[5]); w.w = cvt_pk_bf16(o[6], o[7]);
                        *(u32x4*)(Y + (size_t)row * DM + 1536 + col) = w;
                    } } }
    }
};
struct EpiOut {
    unsigned char* ws; int l; int do_ssq;
    __device__ __forceinline__ void operator()(const f32x4 (&acc)[2][2][4][2], const Unit& u, int wr, int wc, int fr, int fq) const {
        const int row0 = u.pm * 256 + wr * 64 + fr, cw = u.cb + wc * 32 + 8 * fq;
        bf16_t* XB = (bf16_t*)(ws + WS_XB); u64* ssq_next = (u64*)(ws + WS_SSQ) + (size_t)(l + 1) * MTOK;
#pragma unroll
        for (int ai = 0; ai < 2; ++ai)
#pragma unroll
            for (int m = 0; m < 4; ++m) { const int row = row0 + ai * 128 + m * 16; float s = 0.f;
#pragma unroll
                for (int bj = 0; bj < 2; ++bj) { const size_t off = (size_t)row * DM + cw + bj * 128; const u32x4 xb = *(const u32x4*)(XB + off);
                    const f32x4 a0 = acc[ai][bj][m][0], a1 = acc[ai][bj][m][1];
                    const float v0 = bf_lo(xb.x) + a0[0], v1 = bf_hi(xb.x) + a0[1], v2 = bf_lo(xb.y) + a0[2], v3 = bf_hi(xb.y) + a0[3];
                    const float v4 = bf_lo(xb.z) + a1[0], v5 = bf_hi(xb.z) + a1[1], v6 = bf_lo(xb.w) + a1[2], v7 = bf_hi(xb.w) + a1[3];
                    u32x4 w; w.x = cvt_pk_bf16(v0, v1); w.y = cvt_pk_bf16(v2, v3); w.z = cvt_pk_bf16(v4, v5); w.w = cvt_pk_bf16(v6, v7);
                    *(u32x4*)(XB + off) = w;
                    s += (v0 * v0 + v1 * v1) + (v2 * v2 + v3 * v3) + (v4 * v4 + v5 * v5) + (v6 * v6 + v7 * v7); }
                s += __shfl_xor(s, 16); s += __shfl_xor(s, 32);
                if (fq == 0 && do_ssq) atomicAdd(ssq_next + row, (u64)(s * SSQ_SCALE)); }
    }
};

#define XB_TMO      128
#define XB_XCNT(j)  (256  + 64 * (j))
#define XB_XSUB(j)  (1280 + 64 * (j))
#define XB_XGEN(j)  (2304 + 64 * (j))
#define XB_TOP      3328
#define XB_TOPGEN   3392
#define XCD_BAR_WORDS 3456
#define XB_SPIN_CAP (1u << 18)
__device__ __forceinline__ unsigned xb_ld(unsigned* p)              { return __hip_atomic_load(p, __ATOMIC_RELAXED, __HIP_MEMORY_SCOPE_AGENT); }
__device__ __forceinline__ unsigned xb_add(unsigned* p, unsigned v) { return __hip_atomic_fetch_add(p, v, __ATOMIC_RELAXED, __HIP_MEMORY_SCOPE_AGENT); }
__device__ __forceinline__ unsigned xb_xcc_id() { return (unsigned)__builtin_amdgcn_s_getreg((3 << 11) | 20) & 0xFu; }
#define XB_SPIN(cond, bar) do { unsigned _sp = 0; while (cond) { __builtin_amdgcn_s_sleep(1); \
    if ((++_sp & 255u) == 0u) { if (xb_ld(&(bar)[XB_TMO])) break; if (_sp > XB_SPIN_CAP) { atomicAdd(&(bar)[XB_TMO], 1u); break; } } } } while (0)
struct XcdBarrier { unsigned* bar; unsigned x; volatile LAS unsigned* st; };
__device__ __forceinline__ XcdBarrier xcd_barrier_post(unsigned* bar, volatile LAS unsigned* st) {
    XcdBarrier b; b.bar = bar; b.x = xb_xcc_id(); b.st = st;
    if (threadIdx.x == 0) (void)xb_add(&bar[XB_XCNT(b.x)], 1u);
    return b;
}
__device__ __forceinline__ void xcd_barrier_complete(unsigned* bar, unsigned x, unsigned& nloc, unsigned& nx) {
    const unsigned G = gridDim.x * gridDim.y * gridDim.z;
    unsigned sum, cnt, mine, sp = 0u;
    for (;;) {
        sum = 0u; cnt = 0u; mine = 0u;
#pragma unroll
        for (unsigned j = 0; j < 16; ++j) { const unsigned c = xb_ld(&bar[XB_XCNT(j)]); sum += c; cnt += (c > 0u) ? 1u : 0u; mine = (j == x) ? c : mine; }
        if (sum == G) break;
        __builtin_amdgcn_s_sleep(1);
        if ((++sp & 255u) == 0u) { if (xb_ld(&bar[XB_TMO])) break; if (sp > XB_SPIN_CAP) { atomicAdd(&bar[XB_TMO], 1u); break; } }
    }
    nloc = mine > 0u ? mine : 1u; nx = cnt > 0u ? cnt : 1u;
}
__device__ __forceinline__ void xcd_barrier(const XcdBarrier& b) {
    asm volatile("s_waitcnt vmcnt(0)" ::: "memory");
    __syncthreads();
    if (threadIdx.x == 0) {
        unsigned* bar = b.bar;
        __builtin_amdgcn_s_waitcnt(0);
        unsigned nloc = b.st[0], nx = b.st[1];
        if (nloc == 0u) { xcd_barrier_complete(bar, b.x, nloc, nx); b.st[0] = nloc; b.st[1] = nx; }
        const unsigned old = xb_add(&bar[XB_XSUB(b.x)], 1u);
        const unsigned gen = old / nloc;
        if (old + 1u == (gen + 1u) * nloc) {
            __builtin_amdgcn_fence(__ATOMIC_RELEASE, "agent");
            asm volatile("s_waitcnt vmcnt(0)" ::: "memory");
            const unsigned og = xb_add(&bar[XB_TOP], 1u);
            const unsigned tg = og / nx;
            if (og + 1u == (tg + 1u) * nx) xb_add(&bar[XB_TOPGEN], 1u);
            else XB_SPIN(xb_ld(&bar[XB_TOPGEN]) == tg, bar);
            __builtin_amdgcn_fence(__ATOMIC_ACQUIRE, "agent");
            xb_add(&bar[XB_XGEN(b.x)], 1u);
            asm volatile("s_waitcnt vmcnt(0)" ::: "memory");
        } else {
            XB_SPIN(xb_ld(&bar[XB_XGEN(b.x)]) == gen, bar);
            __builtin_amdgcn_fence(__ATOMIC_ACQUIRE, "agent");
            asm volatile("s_waitcnt vmcnt(0)" ::: "memory");
        }
    }
    __syncthreads();
}

constexpr int NWAVES = 8, NTHR = 512;
constexpr int RING_BYTES = 131072, LDS_BYTES = 163840, LDSCTL_OFF = LDS_BYTES - 512;
struct Args { const float* in[21]; float* out; unsigned char* ws; int ph_lo, ph_hi; };
struct Frame {
    LAS unsigned char* lds; int tid, lane, wave, vcu, G, gw, NGW; unsigned char* ws;
};
__device__ __forceinline__ Frame mkframe(unsigned char* ws, LAS unsigned char* lds, int wave_s) {
    Frame F; int tid = (wave_s << 6) | (int)__builtin_amdgcn_mbcnt_hi(~0u, __builtin_amdgcn_mbcnt_lo(~0u, 0u)); asm volatile("" : "+v"(tid)); int bx = blockIdx.x, G = gridDim.x; asm volatile("" : "+s"(bx), "+s"(G));
    F.lds = lds; F.tid = tid; F.lane = tid & 63; F.wave = __builtin_amdgcn_readfirstlane(tid >> 6);
    F.G = G; F.vcu = (G % 8 == 0) ? (bx % 8) * (G / 8) + bx / 8 : bx;
    F.gw = F.vcu * 8 + F.wave; F.NGW = G * 8; F.ws = ws; return F;
}
#define MFMA16(a, b, c) __builtin_amdgcn_mfma_f32_16x16x32_bf16((a), (b), (c), 0, 0, 0)

constexpr int P0_SCR = 64 * 65 * 4;
__device__ __forceinline__ void p0_transpose64(const float* W, int K, int N, const float* gk, bf16_t* WT, int kb, int n0src, int rowdst, LAS float* scr, int lane) {
    const int k0 = 64 * kb, c4 = lane & 15, rsub = lane >> 4;
#pragma unroll 8
    for (int i = 0; i < 16; ++i) { const int kk = 4 * i + rsub; f32x4 v = *(const f32x4*)(W + (size_t)(k0 + kk) * N + n0src + 4 * c4); if (gk) v = v * gk[k0 + kk];
        scr[(4 * c4 + 0) * 65 + kk] = v[0]; scr[(4 * c4 + 1) * 65 + kk] = v[1]; scr[(4 * c4 + 2) * 65 + kk] = v[2]; scr[(4 * c4 + 3) * 65 + kk] = v[3]; }
    asm volatile("s_waitcnt lgkmcnt(0)" ::: "memory");
    const int ck = lane & 7;
#pragma unroll
    for (int j = 0; j < 8; ++j) { const int n = 8 * j + (lane >> 3); const LAS float* s = scr + n * 65 + 8 * ck;
        u32x4 o; o.x = cvt_pk_bf16(s[0], s[1]); o.y = cvt_pk_bf16(s[2], s[3]); o.z = cvt_pk_bf16(s[4], s[5]); o.w = cvt_pk_bf16(s[6], s[7]);
        *(u32x4*)(WT + (size_t)(rowdst + n) * K + k0 + 8 * ck) = o; }
    asm volatile("s_waitcnt lgkmcnt(0)" ::: "memory");
}
__device__ __forceinline__ void win_map(int s, int& isB, int& row) {
    isB = 0;
    if (s < 512) { isB = 1; row = s; }
    else if (s < 1536) { const int j = (s - 512) >> 7, i = (s - 512) & 127; row = 256 * j + i; }
    else if (s < 2560) { isB = 1; row = 512 + (s - 1536); }
    else if (s < 3072) row = 2048 + (s - 2560);
    else if (s < 3584) row = 2560 + (s - 3072);
    else if (s < 4608) { const int j = (s - 3584) >> 7, i = (s - 3584) & 127; row = 256 * j + 128 + i; }
    else row = 3072 + (s - 4608);
}
__device__ __forceinline__ void p0_prologue(const Frame& F, const Args& a) {
    const float* x = a.in[0]; const float* norm_g = a.in[1]; const float* w_in = a.in[2];
    const float *lam_re = a.in[3], *lam_im = a.in[4], *b_re = a.in[5], *b_im = a.in[6], *log_dt = a.in[10];
    const float *w_glu = a.in[11], *w_s = a.in[15], *w_pool = a.in[17], *w_out = a.in[19];
    unsigned char* ws = F.ws;
    LAS float* scr = (LAS float*)(F.lds + F.wave * P0_SCR);
    constexpr int I_IN = 32 * 72, I_Q = 32 * 16, I_OUT = 32 * 32, I_GLU = 8 * 8, I_L = I_IN + I_Q + I_OUT + I_GLU, I_ALL = 2 * I_L;
    for (int it = F.gw; it < I_ALL; it += F.NGW) {
        int r = it; const int l = r / I_L; r -= l * I_L;
        if (r < I_Q) {
            const int kb = r >> 4, nb = r & 15, dq = 32 * nb, g = dq >> 7, k0 = 64 * kb, cc = F.lane & 15, qq = F.lane >> 4, row = 2048 + dq;
            bf16_t* WT = (bf16_t*)(ws + WS_WA) + (size_t)l * WA_ROWS * DM;
            f32x4 accq[4][2];
#pragma unroll
            for (int mt = 0; mt < 4; ++mt) { accq[mt][0] = (f32x4){0.f, 0.f, 0.f, 0.f}; accq[mt][1] = (f32x4){0.f, 0.f, 0.f, 0.f}; }
#pragma unroll
            for (int ks = 0; ks < 4; ++ks) {
                bf16x8 bq[2];
#pragma unroll
                for (int nt = 0; nt < 2; ++nt) { const float* wp = w_pool + (((size_t)l * 4 + g) * 128 + 32 * ks + 8 * qq) * 128 + (dq & 127) + 16 * nt + cc; u32x4 p;
                    p.x = pk_bf16_c(wp[0], wp[128]); p.y = pk_bf16_c(wp[256], wp[384]); p.z = pk_bf16_c(wp[512], wp[640]); p.w = pk_bf16_c(wp[768], wp[896]); bq[nt] = __builtin_bit_cast(bf16x8, p); }
#pragma unroll
                for (int mt = 0; mt < 4; ++mt) { const int k = k0 + 16 * mt + cc; const float gs = norm_g[l * DM + k];
                    const f32x4* ap = (const f32x4*)(w_in + ((size_t)l * DM + k) * INC + 2560 + 128 * g + 32 * ks + 8 * qq); const f32x4 a0 = ap[0] * gs, a1 = ap[1] * gs; u32x4 p;
                    p.x = pk_bf16_c(a0[0], a0[1]); p.y = pk_bf16_c(a0[2], a0[3]); p.z = pk_bf16_c(a1[0], a1[1]); p.w = pk_bf16_c(a1[2], a1[3]); const bf16x8 aq = __builtin_bit_cast(bf16x8, p);
                    accq[mt][0] = MFMA16(aq, bq[0], accq[mt][0]); accq[mt][1] = MFMA16(aq, bq[1], accq[mt][1]); } }
#pragma unroll
            for (int mt = 0; mt < 4; ++mt)
#pragma unroll
                for (int nt = 0; nt < 2; ++nt) { u32x2 o; o.x = cvt_pk_bf16(accq[mt][nt][0], accq[mt][nt][1]); o.y = cvt_pk_bf16(accq[mt][nt][2], accq[mt][nt][3]);
                    *(u32x2*)(WT + (size_t)(row + 16 * nt + cc) * DM + k0 + 16 * mt + 4 * qq) = o; }
            continue; }
        r -= I_Q;
        if (r < I_IN) { const int kb = r / 72, j = r % 72, sb = 64 * (j < 40 ? j : j + 8); int isB, row; win_map(sb, isB, row);
            bf16_t* dst = isB ? (bf16_t*)(ws + WS_WB) + (size_t)l * WB_ROWS * DM : (bf16_t*)(ws + WS_WA) + (size_t)l * WA_ROWS * DM;
            p0_transpose64(w_in + (size_t)l * DM * INC, DM, INC, norm_g + l * DM, dst, kb, sb, row, scr, F.lane); continue; }
        r -= I_IN;
        if (r < I_OUT) { const int kb = r >> 5, nb = r & 31;
            p0_transpose64(w_out + (size_t)l * DM * DM, DM, DM, nullptr, (bf16_t*)(ws + WS_WOUT) + (size_t)l * DM * DM, kb, 64 * nb, 64 * nb, scr, F.lane); continue; }
        r -= I_OUT;
        { const int kb = r >> 3, nb = r & 7;
            p0_transpose64(w_glu + (size_t)l * 512 * 512, 512, 512, nullptr, (bf16_t*)(ws + WS_WGLU) + (size_t)l * 512 * 512, kb, 64 * nb, 64 * nb, scr, F.lane); }
    }
    { bf16_t* XB = (bf16_t*)(ws + WS_XB); u64* ssq0 = (u64*)(ws + WS_SSQ);
      for (int m = F.gw; m < MTOK; m += F.NGW) {
          const f32x4* xr = (const f32x4*)(x + (size_t)m * DM) + F.lane; u32x2* o = (u32x2*)(XB + (size_t)m * DM) + F.lane; float s = 0.f;
#pragma unroll
          for (int j = 0; j < 8; ++j) { const f32x4 v = xr[64 * j]; s += (v[0] * v[0] + v[1] * v[1]) + (v[2] * v[2] + v[3] * v[3]);
              u32x2 w; w.x = cvt_pk_bf16(v[0], v[1]); w.y = cvt_pk_bf16(v[2], v[3]); o[64 * j] = w; }
          s = wave_sum(s);
          if (F.lane == 0) ssq0[m] = (u64)(s * SSQ_SCALE);
      } }
    const int gt = F.vcu * NTHR + F.tid, NGT = F.G * NTHR;
    { u64* ssq = (u64*)(ws + WS_SSQ) + MTOK; for (int i = gt; i < 2 * MTOK; i += NGT) ssq[i] = 0ull; }
    { float* PAR = (float*)(ws + WS_PAR);
      for (int i = gt; i < PAR_N; i += NGT) { float v;
          if (i < PAR_LNG) v = a.in[12][i - PAR_BGLU]; else if (i < PAR_LNB) v = a.in[13][i - PAR_LNG]; else if (i < PAR_BS) v = a.in[14][i - PAR_LNB];
          else if (i < PAR_PSC) v = a.in[16][i - PAR_BS]; else if (i < PAR_FG) v = a.in[18][i - PAR_PSC]; else v = a.in[20][i - PAR_FG];
          PAR[i] = v; } }
    { bf16_t* WSG = (bf16_t*)(ws + WS_WSG);
      for (int i = gt; i < 2 * 8 * 128 * 128; i += NGT) { const int s = i & 127, t = (i >> 7) & 127; WSG[i] = (bf16_t)(cvt_pk_bf16(s <= t ? w_s[i] : 0.f, 0.f) & 0xffffu); }
    }
    { f32x2* POW = (f32x2*)(ws + WS_POW); f32x2* BBAR = (f32x2*)(ws + WS_BBAR);
      for (int e = gt; e < 2 * S5G * S5P * 17; e += NGT) { const int i = e / 17, n = e - 17 * i; const double dt = exp((double)log_dt[i >> 6]);
          const double mg = exp((double)lam_re[i] * dt * n), th = (double)lam_im[i] * dt * n; POW[e] = (f32x2){(float)(mg * cos(th)), (float)(mg * sin(th))}; }
      for (int i = gt; i < 2 * S5G * S5P; i += NGT) { const int lg = i >> 6;
          const double dt = exp((double)log_dt[lg]), lr = (double)lam_re[i], li = (double)lam_im[i];
          const double mg = exp(lr * dt), th = li * dt, nr = mg * cos(th) - 1.0, ni = mg * sin(th), den = lr * lr + li * li;
          const double qr = (nr * lr + ni * li) / den, qi = (ni * lr - nr * li) / den;
          for (int h = 0; h < 16; ++h) { const double br = (double)b_re[(size_t)i * 16 + h], bi = (double)b_im[(size_t)i * 16 + h];
              BBAR[(size_t)i * 16 + h] = (f32x2){(float)(qr * br - qi * bi), (float)(qr * bi + qi * br)}; } } }
}
__device__ __forceinline__ void s5_tables_a(const Frame& F, const Args& a) {
    const float *c_re = a.in[7], *c_im = a.in[8], *d_skip = a.in[9];
    unsigned char* ws = F.ws; const f32x2* POW = (const f32x2*)(ws + WS_POW); const f32x2* BBAR = (const f32x2*)(ws + WS_BBAR);
    const int gt = F.vcu * NTHR + F.tid, NGT = F.G * NTHR;
    float* KT = (float*)(ws + WS_KT);
    for (int i = gt; i < 2 * S5G * 16 * 256; i += NGT) {
        const int h2 = i & 15, h = (i >> 4) & 15, d = (i >> 8) & 15, lg = i >> 12; float s = 0.f;
        for (int p = 0; p < 64; ++p) { const f32x2 pw = POW[((size_t)lg * 64 + p) * 17 + d], bb = BBAR[((size_t)lg * 64 + p) * 16 + h2];
            const float cr = c_re[((size_t)lg * 16 + h) * 64 + p], ci = c_im[((size_t)lg * 16 + h) * 64 + p];
            const float zr = pw.x * bb.x - pw.y * bb.y, zi = pw.x * bb.y + pw.y * bb.x; s += cr * zr - ci * zi; }
        if (d == 0 && h == h2) s += d_skip[lg * 16 + h];
        KT[i] = s; }
    bf16_t* WEND = (bf16_t*)(ws + WS_WEND);
    for (int i = gt; i < 2 * S5G * 128 * 256; i += NGT) {
        const int t = i & 15, h = (i >> 4) & 15, p2 = (i >> 8) & 127, lg = i >> 15, p = p2 & 63;
        const f32x2 pw = POW[((size_t)lg * 64 + p) * 17 + (15 - t)], bb = BBAR[((size_t)lg * 64 + p) * 16 + h];
        const float v = p2 < 64 ? pw.x * bb.x - pw.y * bb.y : pw.x * bb.y + pw.y * bb.x;
        WEND[i] = (bf16_t)(cvt_pk_bf16(v, 0.f) & 0xffffu); }
    bf16_t* WS5 = (bf16_t*)(ws + WS_WS5);
    for (int i = gt; i < 2 * S5G * 256 * 128; i += NGT) {
        const int p2 = i & 127, row = (i >> 7) & 255, lg = i >> 15, p = p2 & 63, rr = row >> 4, t = 4 * (rr >> 2) + ((row >> 2) & 3), h = 4 * (rr & 3) + (row & 3);
        const f32x2 pw = POW[((size_t)lg * 64 + p) * 17 + (t + 1)];
        const float cr = c_re[((size_t)lg * 16 + h) * 64 + p], ci = c_im[((size_t)lg * 16 + h) * 64 + p];
        const float v = p2 < 64 ? cr * pw.x - ci * pw.y : -(cr * pw.y + ci * pw.x);
        WS5[((size_t)lg * 256 + row) * 384 + 256 + p2] = (bf16_t)(cvt_pk_bf16(v, 0.f) & 0xffffu); }
}
__device__ __forceinline__ void s5_tables_b(const Frame& F) {
    unsigned char* ws = F.ws; const float* KT = (const float*)(ws + WS_KT); bf16_t* WS5 = (bf16_t*)(ws + WS_WS5);
    const int gt = F.vcu * NTHR + F.tid, NGT = F.G * NTHR;
    for (int i = gt; i < 2 * S5G * 256 * 256; i += NGT) {
        const int k = i & 255, row = (i >> 8) & 255, lg = i >> 16, rr = row >> 4, t = 4 * (rr >> 2) + ((row >> 2) & 3), h = 4 * (rr & 3) + (row & 3), h2 = k >> 4, t2 = k & 15;
        const float v = t2 <= t ? KT[(((size_t)lg * 16 + (t - t2)) * 16 + h) * 16 + h2] : 0.f;
        WS5[((size_t)lg * 256 + row) * 384 + k] = (bf16_t)(cvt_pk_bf16(v, 0.f) & 0xffffu); }
}

__device__ __forceinline__ void p2_ln(const Frame& F, const float* ln_g, const float* ln_b, bf16_t* DST) {
    bf16_t* GVT = (bf16_t*)(F.ws + WS_GVT);
    LAS float* red = (LAS float*)F.lds;
    LAS float* stat = (LAS float*)(F.lds + 32768);
    const int o = F.tid & 15, r0 = F.tid >> 4;
    for (int c = F.vcu; c < MTOK / 128; c += F.G) {
        bf16_t* gp = GVT + (size_t)r0 * MTOK + c * 128 + 8 * o; bf16_t* dp = DST + (size_t)r0 * MTOK + c * 128 + 8 * o;
        float s[8], q[8];
#pragma unroll
        for (int j = 0; j < 8; ++j) { s[j] = 0.f; q[j] = 0.f; }
#pragma unroll 4
        for (int i = 0; i < 32; ++i) { const u32x4 v = *(const u32x4*)(gp + (size_t)(32 * i) * MTOK);
            const float e0 = bf_lo(v.x), e1 = bf_hi(v.x), e2 = bf_lo(v.y), e3 = bf_hi(v.y), e4 = bf_lo(v.z), e5 = bf_hi(v.z), e6 = bf_lo(v.w), e7 = bf_hi(v.w);
            s[0] += e0; q[0] += e0 * e0; s[1] += e1; q[1] += e1 * e1; s[2] += e2; q[2] += e2 * e2; s[3] += e3; q[3] += e3 * e3;
            s[4] += e4; q[4] += e4 * e4; s[5] += e5; q[5] += e5 * e5; s[6] += e6; q[6] += e6 * e6; s[7] += e7; q[7] += e7 * e7; }
#pragma unroll
        for (int j = 0; j < 8; ++j) { red[(r0 * 128 + 8 * o + j) * 2] = s[j]; red[(r0 * 128 + 8 * o + j) * 2 + 1] = q[j]; }
        __syncthreads();
        if (F.tid < 128) { float ss = 0.f, qq = 0.f;
            for (int r = 0; r < 32; ++r) { ss += red[(r * 128 + F.tid) * 2]; qq += red[(r * 128 + F.tid) * 2 + 1]; }
            const float mean = ss * (1.0f / 1024.0f), var = fmaxf(qq * (1.0f / 1024.0f) - mean * mean, 0.f);
            stat[F.tid * 2] = mean; stat[F.tid * 2 + 1] = rsqrtf(var + LN_EPS); }
        __syncthreads();
        float mu[8], rs[8];
#pragma unroll
        for (int j = 0; j < 8; ++j) { mu[j] = stat[(8 * o + j) * 2]; rs[j] = stat[(8 * o + j) * 2 + 1]; }
#pragma unroll 4
        for (int i = 0; i < 32; ++i) { const int ch = 32 * i + r0; const float g = ln_g[ch], b = ln_b[ch]; const u32x4 v = *(const u32x4*)(gp + (size_t)(32 * i) * MTOK); u32x4 w;
            w.x = cvt_pk_bf16((bf_lo(v.x) - mu[0]) * rs[0] * g + b, (bf_hi(v.x) - mu[1]) * rs[1] * g + b);
            w.y = cvt_pk_bf16((bf_lo(v.y) - mu[2]) * rs[2] * g + b, (bf_hi(v.y) - mu[3]) * rs[3] * g + b);
            w.z = cvt_pk_bf16((bf_lo(v.z) - mu[4]) * rs[4] * g + b, (bf_hi(v.z) - mu[5]) * rs[5] * g + b);
            w.w = cvt_pk_bf16((bf_lo(v.w) - mu[6]) * rs[6] * g + b, (bf_hi(v.w) - mu[7]) * rs[7] * g + b);
            *(u32x4*)(dp + (size_t)(32 * i) * MTOK) = w; }
        __syncthreads();
    }
}
constexpr int SGU_ROWB = 272;
constexpr int SGU_TILE = 128 * SGU_ROWB;
__device__ __forceinline__ void m1_sgu(const Frame& F, int layer) {
    const bf16_t* GVT = (const bf16_t*)(F.ws + WS_GVT); const bf16_t* UG = (const bf16_t*)(F.ws + WS_UG); bf16_t* Y = (bf16_t*)(F.ws + WS_Y);
    const bf16_t* WSG = (const bf16_t*)(F.ws + WS_WSG) + (size_t)layer * 8 * 128 * 128;
    const float* PAR = (const float*)(F.ws + WS_PAR);
    const float* ln_g = PAR + PAR_LNG + layer * SGUW; const float* ln_b = PAR + PAR_LNB + layer * SGUW; const float* b_s = PAR + PAR_BS + layer * 1024;
    LAS float* red = (LAS float*)F.lds;
    LAS float* stat = (LAS float*)(F.lds + 32768);
    LAS unsigned char* tiles = F.lds + 36864;
    const int o = F.tid & 15, r0 = F.tid >> 4, c = F.lane & 15, q = F.lane >> 4, w = F.wave;
    for (int ch = F.vcu; ch < MTOK / 128; ch += F.G) {
        const bf16_t* gp = GVT + (size_t)r0 * MTOK + ch * 128 + 8 * o;
        { float s[8], qq[8];
#pragma unroll
          for (int j = 0; j < 8; ++j) { s[j] = 0.f; qq[j] = 0.f; }
#pragma unroll 8
          for (int i = 0; i < 32; ++i) { const u32x4 v = *(const u32x4*)(gp + (size_t)(32 * i) * MTOK);
              const float e0 = bf_lo(v.x), e1 = bf_hi(v.x), e2 = bf_lo(v.y), e3 = bf_hi(v.y), e4 = bf_lo(v.z), e5 = bf_hi(v.z), e6 = bf_lo(v.w), e7 = bf_hi(v.w);
              s[0] += e0; qq[0] += e0 * e0; s[1] += e1; qq[1] += e1 * e1; s[2] += e2; qq[2] += e2 * e2; s[3] += e3; qq[3] += e3 * e3;
              s[4] += e4; qq[4] += e4 * e4; s[5] += e5; qq[5] += e5 * e5; s[6] += e6; qq[6] += e6 * e6; s[7] += e7; qq[7] += e7 * e7; }
#pragma unroll
          for (int j = 0; j < 8; ++j) { red[(r0 * 128 + 8 * o + j) * 2] = s[j]; red[(r0 * 128 + 8 * o + j) * 2 + 1] = qq[j]; } }
        __syncthreads();
        if (F.tid < 128) { float ss = 0.f, q2 = 0.f;
            for (int r = 0; r < 32; ++r) { ss += red[(r * 128 + F.tid) * 2]; q2 += red[(r * 128 + F.tid) * 2 + 1]; }
            const float mean = ss * (1.0f / 1024.0f), var = fmaxf(q2 * (1.0f / 1024.0f) - mean * mean, 0.f);
            stat[F.tid * 2] = mean; stat[F.tid * 2 + 1] = rsqrtf(var + LN_EPS); }
        __syncthreads();
        float mu[8], rs[8];
#pragma unroll
        for (int j = 0; j < 8; ++j) { mu[j] = stat[(8 * o + j) * 2]; rs[j] = stat[(8 * o + j) * 2 + 1]; }
        u32x4 stg[4]; bf16x8 wnx[4];
#pragma unroll
        for (int i = 0; i < 4; ++i) stg[i] = *(const u32x4*)(gp + (size_t)(32 * i) * MTOK);
        { const int t0n = 16 * (w & 7);
#pragma unroll
          for (int ks = 0; ks < 4; ++ks) wnx[ks] = *(const bf16x8*)(WSG + ((size_t)0 * 128 + t0n + c) * 128 + 8 * q + 32 * ks); }
#pragma unroll 1
        for (int h = 0; h < 8; ++h) {
            LAS unsigned char* tile = tiles + (h & 1) * SGU_TILE;
#pragma unroll
            for (int i = 0; i < 4; ++i) { const int d = r0 + 32 * i, chn = h * 128 + d, rho = 16 * ((d >> 2) & 7) + 4 * (d >> 5) + (d & 3); const float g = ln_g[chn], b = ln_b[chn]; u32x4 wv;
                wv.x = cvt_pk_bf16((bf_lo(stg[i].x) - mu[0]) * rs[0] * g + b, (bf_hi(stg[i].x) - mu[1]) * rs[1] * g + b);
                wv.y = cvt_pk_bf16((bf_lo(stg[i].y) - mu[2]) * rs[2] * g + b, (bf_hi(stg[i].y) - mu[3]) * rs[3] * g + b);
                wv.z = cvt_pk_bf16((bf_lo(stg[i].z) - mu[4]) * rs[4] * g + b, (bf_hi(stg[i].z) - mu[5]) * rs[5] * g + b);
                wv.w = cvt_pk_bf16((bf_lo(stg[i].w) - mu[6]) * rs[6] * g + b, (bf_hi(stg[i].w) - mu[7]) * rs[7] * g + b);
                *(LAS u32x4*)(tile + rho * SGU_ROWB + 16 * o) = wv; }
            const int tt = (w + h) & 7, t0 = 16 * tt, nks = (tt >> 1) + 1;
            const int m = ch * 128 + t0 + c;
            bf16x8 wcur[4];
#pragma unroll
            for (int ks = 0; ks < 4; ++ks) wcur[ks] = wnx[ks];
            u32x4 ugv[4];
#pragma unroll
            for (int j = 0; j < 4; ++j) ugv[j] = *(const u32x4*)(UG + (size_t)m * 1024 + h * 128 + 32 * q + 8 * j);
            if (h < 7) { const int t0n = 16 * ((w + h + 1) & 7);
#pragma unroll
                for (int i = 0; i < 4; ++i) stg[i] = *(const u32x4*)(gp + (size_t)((h + 1) * 128 + 32 * i) * MTOK);
#pragma unroll
                for (int ks = 0; ks < 4; ++ks) wnx[ks] = *(const bf16x8*)(WSG + ((size_t)(h + 1) * 128 + t0n + c) * 128 + 8 * q + 32 * ks); }
            __syncthreads();
            f32x4 acc[8];
#pragma unroll
            for (int r = 0; r < 8; ++r) acc[r] = (f32x4){0.f, 0.f, 0.f, 0.f};
            const LAS unsigned char* ab = tile + c * SGU_ROWB + 16 * q;
#pragma unroll
            for (int ks = 0; ks < 4; ++ks) { if (ks < nks) {
#pragma unroll
                for (int r = 0; r < 8; ++r) { const bf16x8 av = *(const LAS bf16x8*)(ab + (16 * r) * SGU_ROWB + 64 * ks); acc[r] = MFMA16(av, wcur[ks], acc[r]); } } }
            const float bs = b_s[h * 128 + t0 + c];
#pragma unroll
            for (int j = 0; j < 4; ++j) { const int col = h * 128 + 32 * q + 8 * j; const u32x4 ug = ugv[j]; u32x4 wv;
                wv.x = cvt_pk_bf16((acc[2 * j][0] + bs) * bf_lo(ug.x), (acc[2 * j][1] + bs) * bf_hi(ug.x)); wv.y = cvt_pk_bf16((acc[2 * j][2] + bs) * bf_lo(ug.y), (acc[2 * j][3] + bs) * bf_hi(ug.y));
                wv.z = cvt_pk_bf16((acc[2 * j + 1][0] + bs) * bf_lo(ug.z), (acc[2 * j + 1][1] + bs) * bf_hi(ug.z)); wv.w = cvt_pk_bf16((acc[2 * j + 1][2] + bs) * bf_lo(ug.w), (acc[2 * j + 1][3] + bs) * bf_hi(ug.w));
                *(u32x4*)(Y + (size_t)m * DM + 512 + col) = wv; }
        }
        __syncthreads();
    }
}
constexpr int WE_ROWB = 528;
__device__ __forceinline__ void m1_send(const Frame& F, int layer) {
    const bf16_t* WEND = (const bf16_t*)(F.ws + WS_WEND) + (size_t)layer * S5G * 128 * 256;
    const bf16_t* XAT = (const bf16_t*)(F.ws + WS_XA); float* SE = (float*)(F.ws + WS_SE);
    const int c = F.lane & 15, q = F.lane >> 4, w = F.wave;
    for (int it = F.vcu; it < S5G * 8; it += F.G) {
        const int g = it & 31, rg = it >> 5;
        const bf16_t* xb = XAT + (size_t)(16 * g + (q >> 1)) * MTOK + 8 * (q & 1);
        bf16x8 bx[2][8];
#pragma unroll
        for (int s = 0; s < 2; ++s)
#pragma unroll
            for (int ks = 0; ks < 8; ++ks) bx[s][ks] = *(const bf16x8*)(xb + (size_t)(2 * ks) * MTOK + (size_t)((16 * rg + 2 * w + s) * 16 + c) * 16);
#pragma unroll
        for (int i = 0; i < 8; ++i) { const int e = F.tid + 512 * i, row = e >> 5, ch = e & 31;
            *(LAS u32x4*)(F.lds + row * WE_ROWB + 16 * ch) = *(const u32x4*)(WEND + ((size_t)g * 128 + row) * 256 + 8 * ch); }
        __syncthreads();
#pragma unroll
        for (int s = 0; s < 2; ++s) { const int seg = (16 * rg + 2 * w + s) * 16 + c;
#pragma unroll
            for (int r = 0; r < 8; ++r) { f32x4 acc = (f32x4){0.f, 0.f, 0.f, 0.f};
#pragma unroll
                for (int ks = 0; ks < 8; ++ks) { const bf16x8 aw = *(const LAS bf16x8*)(F.lds + (16 * r + c) * WE_ROWB + 64 * ks + 16 * q); acc = MFMA16(aw, bx[s][ks], acc); }
                *(f32x4*)(SE + ((size_t)seg * 32 + g) * 128 + 16 * r + 4 * q) = acc; } }
        __syncthreads();
    }
}
template <int W> __device__ __forceinline__ void pool_item(const Frame& F, int layer, int r4, int g) {
    constexpr int R = 8;
    const bf16_t* Q = (const bf16_t*)(F.ws + WS_XC); const bf16_t* SG = (const bf16_t*)(F.ws + WS_SG); bf16_t* Y = (bf16_t*)(F.ws + WS_Y);
    const float* psc = (const float*)(F.ws + WS_PAR) + PAR_PSC + layer * POOLW;
    const int o16 = F.lane & 15, sub = F.lane >> 4, m0 = (r4 * 4 + sub) * R, tl0 = m0 & (SEQ - 1), col = g * 128 + 8 * o16;
    u32x4 xs[W - 1 + R];
#pragma unroll
    for (int k = 0; k < W - 1 + R; ++k) { const int tl = tl0 - (W - 1) + k;
        xs[k] = tl >= 0 ? *(const u32x4*)(Q + (size_t)(m0 - (W - 1) + k) * 512 + col) : (u32x4){0u, 0u, 0u, 0u}; }
    const f32x4 p0 = *(const f32x4*)(psc + col), p1 = *(const f32x4*)(psc + col + 4);
    float S[8];
#pragma unroll
    for (int e = 0; e < 8; ++e) S[e] = 0.f;
#pragma unroll
    for (int k = 0; k < W - 1; ++k) { S[0] += bf_lo(xs[k].x); S[1] += bf_hi(xs[k].x); S[2] += bf_lo(xs[k].y); S[3] += bf_hi(xs[k].y); S[4] += bf_lo(xs[k].z); S[5] += bf_hi(xs[k].z); S[6] += bf_lo(xs[k].w); S[7] += bf_hi(xs[k].w); }
#pragma unroll
    for (int i = 0; i < R; ++i) { const u32x4 xv = xs[i + W - 1];
        const float xe[8] = {bf_lo(xv.x), bf_hi(xv.x), bf_lo(xv.y), bf_hi(xv.y), bf_lo(xv.z), bf_hi(xv.z), bf_lo(xv.w), bf_hi(xv.w)};
#pragma unroll
        for (int e = 0; e < 8; ++e) S[e] += xe[e];
        const int cnt = tl0 + i + 1 < W ? tl0 + i + 1 : W; const float inv = 1.0f / (float)cnt;
        const u32x4 sg = *(const u32x4*)(SG + (size_t)(m0 + i) * 1024 + 512 + col); u32x4 wv;
        wv.x = cvt_pk_bf16((S[0] * inv - xe[0]) * p0[0] * bf_lo(sg.x), (S[1] * inv - xe[1]) * p0[1] * bf_hi(sg.x));
        wv.y = cvt_pk_bf16((S[2] * inv - xe[2]) * p0[2] * bf_lo(sg.y), (S[3] * inv - xe[3]) * p0[3] * bf_hi(sg.y));
        wv.z = cvt_pk_bf16((S[4] * inv - xe[4]) * p1[0] * bf_lo(sg.z), (S[5] * inv - xe[5]) * p1[1] * bf_hi(sg.z));
        wv.w = cvt_pk_bf16((S[6] * inv - xe[6]) * p1[2] * bf_lo(sg.w), (S[7] * inv - xe[7]) * p1[3] * bf_hi(sg.w));
        *(u32x4*)(Y + (size_t)(m0 + i) * DM + 1536 + col) = wv;
        const u32x4 ov = xs[i];
        S[0] -= bf_lo(ov.x); S[1] -= bf_hi(ov.x); S[2] -= bf_lo(ov.y); S[3] -= bf_hi(ov.y); S[4] -= bf_lo(ov.z); S[5] -= bf_hi(ov.z); S[6] -= bf_lo(ov.w); S[7] -= bf_hi(ov.w); }
}
__device__ __forceinline__ void p2_pool(const Frame& F, int layer) {
    for (int it = F.gw; it < (MTOK / 32) * 4; it += F.NGW) { const int g = it & 3, r4 = it >> 2;
        if (g == 0) pool_item<2>(F, layer, r4, 0); else if (g == 1) pool_item<4>(F, layer, r4, 1); else if (g == 2) pool_item<8>(F, layer, r4, 2); else pool_item<16>(F, layer, r4, 3); }
}

constexpr int CAR_ROWB = 272;
__device__ __forceinline__ void m3_s5(const Frame& F, int layer) {
    const f32x2* POW = (const f32x2*)(F.ws + WS_POW); const float* SE = (const float*)(F.ws + WS_SE);
    const bf16_t* WS5 = (const bf16_t*)(F.ws + WS_WS5) + (size_t)layer * S5G * 256 * 384;
    const bf16_t* XAT = (const bf16_t*)(F.ws + WS_XA); bf16_t* YG = (bf16_t*)(F.ws + WS_YG);
    LAS unsigned char* car = F.lds;
    LAS f32x2* ends = (LAS f32x2*)(F.lds + 256 * CAR_ROWB);
    const int c = F.lane & 15, q = F.lane >> 4, w = F.wave, p = F.lane, sc = F.wave;
    for (int it = F.vcu; it < NB * S5G * 2; it += F.G) {
        const int b = it >> 6, g = (it >> 1) & 31, half = it & 1;
        { const f32x2 l16 = POW[(((size_t)layer * S5G + g) * 64 + p) * 17 + 16];
          const float* e0 = SE + ((size_t)(b * SEGB + sc * 64) * 32 + g) * 128 + p;
          float er[64], ei[64];
          const bool need = sc < 4 * (half + 1);
          if (need) {
#pragma unroll
              for (int j = 0; j < 64; ++j) { er[j] = e0[(size_t)j * 4096]; ei[j] = e0[(size_t)j * 4096 + 64]; } }
          else {
#pragma unroll
              for (int j = 0; j < 64; ++j) { er[j] = 0.f; ei[j] = 0.f; } }
          float sr = 0.f, si = 0.f;
#pragma unroll
          for (int j = 0; j < 64; ++j) { const float nr = l16.x * sr - l16.y * si + er[j], ni = l16.x * si + l16.y * sr + ei[j]; sr = nr; si = ni; }
          ends[sc * 64 + p] = (f32x2){sr, si};
          float mr = l16.x, mi = l16.y;
#pragma unroll
          for (int k = 0; k < 6; ++k) { const float tr = mr * mr - mi * mi, ti = 2.f * mr * mi; mr = tr; mi = ti; }
          __syncthreads();
          float cr = 0.f, ci = 0.f;
          for (int k = 0; k < sc; ++k) { const f32x2 e = ends[k * 64 + p]; const float nr = mr * cr - mi * ci + e.x, ni = mr * ci + mi * cr + e.y; cr = nr; ci = ni; }
          if ((sc >> 2) == half) { sr = cr; si = ci; LAS unsigned char* rowp = car + ((sc & 3) * 64) * CAR_ROWB + 2 * p;
#pragma unroll
              for (int j = 0; j < 64; ++j) { *(LAS bf16_t*)(rowp + j * CAR_ROWB) = (bf16_t)f2bf_rne(sr); *(LAS bf16_t*)(rowp + j * CAR_ROWB + 128) = (bf16_t)f2bf_rne(si);
                  const float nr = l16.x * sr - l16.y * si + er[j], ni = l16.x * si + l16.y * sr + ei[j]; sr = nr; si = ni; } }
          __syncthreads(); }
        bf16x8 aw[2][12];
#pragma unroll
        for (int rr = 0; rr < 2; ++rr)
#pragma unroll
            for (int ks = 0; ks < 12; ++ks) aw[rr][ks] = *(const bf16x8*)(WS5 + ((size_t)g * 256 + 16 * (2 * w + rr) + c) * 384 + 32 * ks + 8 * q);
        const bf16_t* xw = XAT + (size_t)(16 * g + 2 * w + (q >> 1)) * MTOK + 8 * (q & 1);
        const int segbase = b * SEGB + half * 256;
        LAS unsigned char* xfr = F.lds + 256 * CAR_ROWB + 4096;
        u32x4 pre[4];
#pragma unroll
        for (int s = 0; s < 4; ++s) pre[s] = *(const u32x4*)(xw + (size_t)(segbase + s * 16 + c) * 16);
#pragma unroll 1
        for (int sg4 = 0; sg4 < 4; ++sg4) {
#pragma unroll
            for (int s = 0; s < 4; ++s) *(LAS u32x4*)(xfr + ((s * 8 + w) * 64 + F.lane) * 16) = pre[s];
            if (sg4 < 3) {
#pragma unroll
                for (int s = 0; s < 4; ++s) pre[s] = *(const u32x4*)(xw + (size_t)(segbase + (4 * (sg4 + 1) + s) * 16 + c) * 16); }
            __syncthreads();
#pragma unroll
            for (int s = 0; s < 4; ++s) { const int st = 4 * sg4 + s, seg = segbase + st * 16 + c;
                f32x4 a0 = (f32x4){0.f, 0.f, 0.f, 0.f}, a1 = (f32x4){0.f, 0.f, 0.f, 0.f};
#pragma unroll
                for (int ks = 0; ks < 4; ++ks) { const bf16x8 bc = *(const LAS bf16x8*)(car + (st * 16 + c) * CAR_ROWB + 64 * ks + 16 * q); a0 = MFMA16(aw[0][8 + ks], bc, a0); a1 = MFMA16(aw[1][8 + ks], bc, a1); }
#pragma unroll
                for (int ks = 0; ks < 8; ++ks) { const bf16x8 bx = *(const LAS bf16x8*)(xfr + ((s * 8 + ks) * 64 + F.lane) * 16); a0 = MFMA16(aw[0][ks], bx, a0); a1 = MFMA16(aw[1][ks], bx, a1); }
                const int m = seg * 16 + 4 * (w >> 1) + q; u32x4 o;
                o.x = cvt_pk_bf16(gelu_f(a0[0]), gelu_f(a0[1])); o.y = cvt_pk_bf16(gelu_f(a0[2]), gelu_f(a0[3])); o.z = cvt_pk_bf16(gelu_f(a1[0]), gelu_f(a1[1])); o.w = cvt_pk_bf16(gelu_f(a1[2]), gelu_f(a1[3]));
                *(u32x4*)(YG + (size_t)m * 512 + 16 * g + 8 * (w & 1)) = o; }
            __syncthreads();
        }
        __syncthreads();
    }
}

__device__ __forceinline__ void p_final(const Frame& F, float* out, const float* final_g) {
    const u64* ssq = (const u64*)(F.ws + WS_SSQ) + 2 * (size_t)MTOK; const bf16_t* XB = (const bf16_t*)(F.ws + WS_XB);
    for (int m = F.gw; m < MTOK; m += F.NGW) {
        const float rs = rsqrtf((float)ssq[m] * (1.0f / (SSQ_SCALE * (float)DM)) + RMS_EPS);
        const u32x4* xr = (const u32x4*)(XB + (size_t)m * DM) + F.lane; f32x4* orow = (f32x4*)(out + (size_t)m * DM) + 2 * F.lane; const f32x4* gr = (const f32x4*)final_g + 2 * F.lane;
#pragma unroll
        for (int j = 0; j < 4; ++j) { const u32x4 v = xr[64 * j]; const f32x4 g0 = gr[128 * j], g1 = gr[128 * j + 1];
            orow[128 * j] = (f32x4){bf_lo(v.x) * rs * g0[0], bf_hi(v.x) * rs * g0[1], bf_lo(v.y) * rs * g0[2], bf_hi(v.y) * rs * g0[3]};
            orow[128 * j + 1] = (f32x4){bf_lo(v.z) * rs * g1[0], bf_hi(v.z) * rs * g1[1], bf_lo(v.w) * rs * g1[2], bf_hi(v.w) * rs * g1[3]}; }
    }
}

constexpr int N_PHASES = 12;
#ifndef PROBE_PHASE
#define PROBE_PHASE (-1)
#endif
#ifndef PROBE_REPS
#define PROBE_REPS 1
#endif
#ifndef PROBE_SUB
#define PROBE_SUB 0
#endif
__global__ void __launch_bounds__(NTHR, 2) hybrid_fwd(Args args) {
    extern __shared__ __attribute__((aligned(16))) unsigned char lds_raw[];
    LAS unsigned char* lds = (LAS unsigned char*)lds_raw;
    volatile LAS unsigned* MISC = (volatile LAS unsigned*)(lds + LDSCTL_OFF);
    if (threadIdx.x < 64) MISC[threadIdx.x] = 0u;
    const int wave_s = __builtin_amdgcn_readfirstlane(threadIdx.x >> 6);
    __syncthreads();
    unsigned char* ws0 = args.ws;
    XcdBarrier bar; bar.bar = (unsigned*)(ws0 + WS_CTL) + 1024; bar.x = 0; bar.st = nullptr;
#if !MK_MULTI
    bar = xcd_barrier_post((unsigned*)(ws0 + WS_CTL) + 1024, MISC + 8);
#endif
#pragma unroll 1
    for (int ph = args.ph_lo; ph < args.ph_hi; ++ph) {
        const int l = ph == 0 ? 0 : (ph - 1) / 5, sub = ph == 0 ? 0 : (ph == N_PHASES - 1 ? 6 : 1 + (ph - 1) % 5);
        const int nrep = (ph == PROBE_PHASE) ? PROBE_REPS : 1;
#pragma unroll 1
        for (int rep = 0; rep < nrep; ++rep) {
            unsigned char* ws = ws0; asm volatile("" : "+s"(ws));
            int bx = blockIdx.x, gx = gridDim.x; asm volatile("" : "+s"(bx), "+s"(gx));
            if (sub == 0) { const Frame F = mkframe(ws, lds, wave_s); p0_prologue(F, args); }
            else if (sub == 1) {
                if (l == 0 && rep == 0) { const Frame F = mkframe(ws, lds, wave_s); s5_tables_a(F, args); }
                SchedIn S{gx, bx, l, (const char*)ws};
                EpiIn E{ws, l};
                pg8::gemm_phase<EpiIn, SchedIn, true, true>(lds, wave_s, DM, DM, DM, S, E);
            } else if (sub == 2) {
                const Frame F = mkframe(ws, lds, wave_s);
                if (l == 0 && rep == 0) s5_tables_b(F);
                if (PROBE_SUB == 0 || PROBE_SUB == 1 || rep == 0) m1_sgu(F, l);
                if (PROBE_SUB == 0 || PROBE_SUB == 2 || rep == 0) m1_send(F, l);
                if (PROBE_SUB == 0 || PROBE_SUB == 3 || rep == 0) p2_pool(F, l);
            } else if (sub == 3) { const Frame F = mkframe(ws, lds, wave_s); m3_s5(F, l); }
            else if (sub == 4) {
                SchedMix S{gx, bx, l, (const char*)ws};
                EpiMix E{ws, l};
                pg8::gemm_phase<EpiMix, SchedMix, true, true>(lds, wave_s, 512, 512, 512, S, E);
            } else if (sub == 5) {
                SchedOut S{gx, bx, l, (const char*)ws};
                EpiOut E{ws, l, rep == 0 ? 1 : 0};
                pg8::gemm_phase<EpiOut, SchedOut, true, true>(lds, wave_s, DM, DM, DM, S, E);
            } else { const Frame F = mkframe(ws, lds, wave_s); p_final(F, args.out, (const float*)(ws + WS_PAR) + PAR_FG); }
#if !MK_MULTI
            if (rep + 1 < nrep) xcd_barrier(bar);
#endif
        }
#if !MK_MULTI
        if (ph + 1 < args.ph_hi) xcd_barrier(bar);
#endif
    }
}

extern "C" void kernel_launch(void* const* d_in, const int* in_sizes, int n_in, void* d_out, int out_size, void* d_ws, size_t ws_size, hipStream_t stream) {
    static int grid = 0;
    if (grid == 0) {
        if (n_in != 21 || in_sizes[0] != MTOK * DM || out_size != MTOK * DM || ws_size < WS_END) { fprintf(stderr, "kernel_launch: unexpected shapes (n_in %d, in0 %d, out %d, ws %zu)\n", n_in, n_in > 0 ? in_sizes[0] : -1, out_size, ws_size); grid = -1; return; }
        int dev = 0, cus = 0, per_cu = 0;
        if (hipGetDevice(&dev) != hipSuccess || hipDeviceGetAttribute(&cus, hipDeviceAttributeMultiprocessorCount, dev) != hipSuccess) { grid = -1; return; }
        if (hipFuncSetAttribute((const void*)hybrid_fwd, hipFuncAttributeMaxDynamicSharedMemorySize, LDS_BYTES) != hipSuccess) { fprintf(stderr, "kernel_launch: hipFuncSetAttribute failed\n"); grid = -1; return; }
        if (hipOccupancyMaxActiveBlocksPerMultiprocessor(&per_cu, (const void*)hybrid_fwd, NTHR, LDS_BYTES) != hipSuccess || per_cu < 1) { fprintf(stderr, "kernel_launch: occupancy query says %d blocks per CU\n", per_cu); per_cu = 1; }
        (void)hipGetLastError();
        grid = cus;
    }
    if (grid < 0) return;
    (void)hipMemsetAsync((char*)d_ws + WS_CTL, 0, CTL_ZERO_BYTES, stream);
    Args a{};
    for (int i = 0; i < 21; ++i) a.in[i] = (const float*)d_in[i];
    a.out = (float*)d_out; a.ws = (unsigned char*)d_ws;
#if MK_MULTI
    for (int ph = 0; ph < N_PHASES; ++ph) { a.ph_lo = ph; a.ph_hi = ph + 1; hipLaunchKernelGGL(hybrid_fwd, dim3(grid), dim3(NTHR), LDS_BYTES, stream, a); }
#else
    a.ph_lo = 0; a.ph_hi = N_PHASES;
    void* kargs[] = {&a};
    hipError_t e = hipLaunchCooperativeKernel((const void*)hybrid_fwd, dim3(grid), dim3(NTHR), kargs, LDS_BYTES, stream);
    if (e != hipSuccess) fprintf(stderr, "kernel_launch: cooperative launch failed: %s (grid %d)\n", hipGetErrorString(e), grid);
#endif
}
```

```cpp
#include <hip/hip_runtime.h>
#include <cstdio>
#include <cstdint>

#ifndef MK_MULTI
#define MK_MULTI 0
#endif

#define LAS __attribute__((address_space(3)))
#define GAS __attribute__((address_space(1)))
typedef unsigned short bf16_t;
typedef short bf16x8 __attribute__((ext_vector_type(8)));
typedef float f32x4 __attribute__((ext_vector_type(4)));
typedef float f32x2 __attribute__((ext_vector_type(2)));
typedef unsigned u32x4 __attribute__((ext_vector_type(4)));
typedef unsigned u32x2 __attribute__((ext_vector_type(2)));
typedef unsigned long long u64;

constexpr int DM = 2048, NB = 4, SEQ = 8192, DEPTH = 2, MTOK = NB * SEQ;
constexpr int S5W = 512, SGUW = 1024, POOLW = 512, INC = 5120;
constexpr int S5G = 32, S5H = 16, S5P = 64;
constexpr int NSEG = MTOK / 16, SEGB = SEQ / 16; constexpr int WA_ROWS = 3584, WB_ROWS = 1536;
constexpr float RMS_EPS = 1e-6f, LN_EPS = 1e-5f;
constexpr float SSQ_SCALE = 16777216.0f;

constexpr size_t MiB = 1u << 20;
constexpr size_t WS_CTL = 0, CTL_ZERO_BYTES = 64 * 1024;
constexpr size_t WS_SSQ = 1 * MiB;
constexpr size_t WS_POW = 2 * MiB;
constexpr size_t WS_BBAR = WS_POW + 640 * 1024;
constexpr size_t WS_PAR = 3 * MiB + 256 * 1024;
constexpr int PAR_BGLU = 0, PAR_LNG = 1024, PAR_LNB = 3072, PAR_BS = 5120, PAR_PSC = 7168, PAR_FG = 8192, PAR_N = 10240;
constexpr size_t WS_KT = 4 * MiB;
constexpr size_t WS_WEND = 5 * MiB;
constexpr size_t WS_WS5 = 9 * MiB;
constexpr size_t WS_WSG = 21 * MiB;
constexpr size_t WS_WGLU = 22 * MiB;
constexpr size_t WS_WPD = 23 * MiB;
constexpr size_t WS_WA = 24 * MiB;
constexpr size_t WS_WB = 52 * MiB;
constexpr size_t WS_WOUT = 64 * MiB;
constexpr size_t WS_XB = 80 * MiB;
constexpr size_t WS_XA = 208 * MiB;
constexpr size_t WS_GVT = 240 * MiB;
constexpr size_t WS_UG = 304 * MiB;
constexpr size_t WS_XC = 368 * MiB;
constexpr size_t WS_SG = 400 * MiB;
constexpr size_t WS_PF = 464 * MiB;
constexpr size_t WS_YG = 496 * MiB;
constexpr size_t WS_Y = 528 * MiB;
constexpr size_t WS_SE = 656 * MiB;
constexpr size_t WS_CARRY = 688 * MiB;
constexpr size_t WS_LNS = 704 * MiB;
constexpr size_t WS_END = 706 * MiB;
constexpr float LNS_SCALE = 1073741824.0f;

__device__ __forceinline__ unsigned cvt_pk_bf16(float lo, float hi) { unsigned r; asm volatile("v_cvt_pk_bf16_f32 %0, %1, %2" : "=v"(r) : "v"(lo), "v"(hi)); return r; }
__device__ __forceinline__ unsigned f2bf_rne(float f) { unsigned u = __float_as_uint(f); return (u + 0x7fffu + ((u >> 16) & 1u)) >> 16; }
__device__ __forceinline__ unsigned pk_bf16_c(float lo, float hi) { return f2bf_rne(lo) | (f2bf_rne(hi) << 16); }
__device__ __forceinline__ float bf_lo(unsigned w) { return __uint_as_float(w << 16); }
__device__ __forceinline__ float bf_hi(unsigned w) { return __uint_as_float(w & 0xffff0000u); }
__device__ __forceinline__ float bf2f(bf16_t b) { return __uint_as_float(((unsigned)b) << 16); }
__device__ __forceinline__ float sigmoid_f(float x) { return __builtin_amdgcn_rcpf(1.0f + __builtin_amdgcn_exp2f(-1.4426950408889634f * x)); }
__device__ __forceinline__ float silu_f(float x) { return x * sigmoid_f(x); }
__device__ __forceinline__ float gelu_f(float x) {
    const float u = x * (1.0f + 0.044715f * x * x);
    return x * __builtin_amdgcn_rcpf(1.0f + __builtin_amdgcn_exp2f(-2.302208198f * u));
}
__device__ __forceinline__ float gelu_silu_f(float a, float g) {
    const float u = a * (1.0f + 0.044715f * a * a);
    const float ea = __builtin_amdgcn_exp2f(-2.302208198f * u), eg = __builtin_amdgcn_exp2f(-1.4426950408889634f * g);
    return a * g * __builtin_amdgcn_rcpf((1.0f + ea) * (1.0f + eg));
}
template <int CTRL> __device__ __forceinline__ float dpp_f(float v) { return __int_as_float(__builtin_amdgcn_update_dpp(0, __float_as_int(v), CTRL, 0xf, 0xf, false)); }
__device__ __forceinline__ float row16_sum(float v) { v += dpp_f<0x128>(v); v += dpp_f<0x124>(v); v += dpp_f<0x122>(v); v += dpp_f<0x121>(v); return v; }
__device__ __forceinline__ float xor16_add(float v) { return v + __int_as_float(__builtin_amdgcn_ds_swizzle(__float_as_int(v), 0x401F)); }
__device__ __forceinline__ float xor32_add(float v) { const auto r = __builtin_amdgcn_permlane32_swap(__float_as_uint(v), __float_as_uint(v), false, false); return __uint_as_float(r[0]) + __uint_as_float(r[1]); }
__device__ __forceinline__ float wave_sum(float v) { return xor32_add(xor16_add(row16_sum(v))); }

namespace pg8 {
constexpr int BM = 256, BK = 64, HALF = 128, HTB = HALF * BK * 2, STAGE_BYTES = 8 * HTB, NXCD = 8, WGM = 8;
__host__ __device__ __forceinline__ int lds_byte(int r, int c) { const int st = (r >> 4) * 2 + (c >> 5), rr = r & 15, cc = c & 31, ob = rr * 64 + cc * 2; return st * 1024 + (ob ^ (((ob >> 9) & 1) << 5)); }
__host__ __device__ __forceinline__ void stage_rc(int b, int& R, int& C) { const int st = b / 1024, sb = b % 1024, swz = sb ^ (((sb >> 9) & 1) << 5); R = (st >> 1) * 16 + swz / 64; C = (st & 1) * 32 + (swz % 64) / 2; }
__host__ __device__ __forceinline__ int perm32(int rho) { const int n = rho >> 4, i = rho & 15; return 8 * (i >> 2) + 4 * n + (i & 3); }

struct Unit { int pm, pn, type, cb; const char* A; const char* B; };
__device__ __forceinline__ void tile_of(int L, int nM, int nN, int& pm, int& pn) {
    const int nwg = nM * nN; int wgid = L; { const int q = nwg / NXCD, r = nwg % NXCD, xcd = wgid % NXCD, off = wgid / NXCD; wgid = (xcd < r ? xcd * (q + 1) : r * (q + 1) + (xcd - r) * q) + off; }
    const int nig = WGM * nN, gid = wgid / nig, fm = gid * WGM, gsz = (nM - fm) < WGM ? (nM - fm) : WGM;
    pm = fm + ((wgid % nig) % gsz); pn = (wgid % nig) / gsz;
}

template <class Epi, class Sched, bool ALIGN_EPI, bool SP2>
__device__ __forceinline__ void gemm_phase(LAS unsigned char* lds, const int wave_s, const int K, const int ldA, const int ldB, const Sched& S, const Epi& E) {
    int tid_; asm volatile("v_mbcnt_lo_u32_b32 %0, -1, 0\n\tv_mbcnt_hi_u32_b32 %0, -1, %0" : "=v"(tid_)); tid_ |= wave_s << 6;
    const int tid = tid_, wid = __builtin_amdgcn_readfirstlane(tid >> 6), lane = tid & 63, wr = wid >> 2, wc = wid & 3, fr = lane & 15, fq = lane >> 4;
    const int nt = K / BK;
    unsigned voffA[2], voffB[2];
#pragma unroll
    for (int i = 0; i < 2; ++i) { int R, C; stage_rc(tid * 16 + i * 8192, R, C); const int Rb = (R & ~31) + perm32(R & 31);
        voffA[i] = (unsigned)(R * ldA + C) * 2u; voffB[i] = (unsigned)(Rb * ldB + C) * 2u; }
    const size_t kstep = (size_t)(BK * 2);
    const size_t hstepA = (size_t)HALF * ldA * 2, hstepB = (size_t)HALF * ldB * 2;
    const unsigned ldsw = (unsigned)wid * 1024u;
    const int aoff = lds_byte(wr * 64 + fr, fq * 8), boff = lds_byte(wc * 32 + fr, fq * 8);
#define PG8_SA(b, h) (((b) * 2 + (h)) * HTB)
#define PG8_SB(b, h) ((4 + (b) * 2 + (h)) * HTB)
#define PG8_STAGE(bufoff, gbase, voff) do { _Pragma("unroll") for (int _i = 0; _i < 2; ++_i) \
        __builtin_amdgcn_global_load_lds((const unsigned*)((const char*)(gbase) + (voff)[_i]), (LAS unsigned*)(lds + (bufoff) + ldsw + _i * 8192), 16, 0, 0); } while (0)
#define PG8_LDA(dst, b, h) do { _Pragma("unroll") for (int m = 0; m < 4; ++m) _Pragma("unroll") for (int k = 0; k < 2; ++k) dst[m][k] = *(const LAS bf16x8*)(lds + PG8_SA(b, h) + aoff + m * 2048 + k * 1024); } while (0)
#define PG8_LDB(dst, b, h) do { _Pragma("unroll") for (int n = 0; n < 2; ++n) _Pragma("unroll") for (int k = 0; k < 2; ++k) dst[n][k] = *(const LAS bf16x8*)(lds + PG8_SB(b, h) + boff + n * 2048 + k * 1024); } while (0)
#define PG8_MMA(ai, bj, At, Bt) do { __builtin_amdgcn_s_setprio(1); _Pragma("unroll") for (int m = 0; m < 4; ++m) _Pragma("unroll") for (int n = 0; n < 2; ++n) _Pragma("unroll") for (int k = 0; k < 2; ++k) \
        acc[ai][bj][m][n] = __builtin_amdgcn_mfma_f32_16x16x32_bf16(Bt[n][k], At[m][k], acc[ai][bj][m][n], 0, 0, 0); __builtin_amdgcn_s_setprio(0); } while (0)
#define PG8_WAIT_V(n) asm volatile("s_waitcnt vmcnt(" #n ")" ::: "memory")
#define PG8_WAIT_L(n) asm volatile("s_waitcnt lgkmcnt(" #n ")" ::: "memory")
#define PG8_BAR __builtin_amdgcn_s_barrier()
#define PG8_SCHED __builtin_amdgcn_sched_barrier(0)
    Unit cur, nxt; int ui = 0;
    if (!S.next(0, cur)) return;
    f32x4 acc[2][2][4][2];
#pragma unroll
    for (int a = 0; a < 2; ++a)
#pragma unroll
        for (int b = 0; b < 2; ++b)
#pragma unroll
            for (int m = 0; m < 4; ++m)
#pragma unroll
                for (int n = 0; n < 2; ++n) acc[a][b][m][n] = (f32x4){0.f, 0.f, 0.f, 0.f};
    bf16x8 At[4][2], B0[2][2], B1[2][2];
    const char* cA = cur.A; const char* cB = cur.B;
    if constexpr (SP2) {
        PG8_STAGE(PG8_SB(0, 0), cB, voffB); PG8_STAGE(PG8_SB(0, 1), cB + hstepB, voffB); PG8_STAGE(PG8_SA(0, 0), cA, voffA); PG8_STAGE(PG8_SA(0, 1), cA + hstepA, voffA);
        if (wr == 1) PG8_BAR;
        PG8_WAIT_V(2); PG8_BAR;
        PG8_STAGE(PG8_SB(1, 0), cB + kstep, voffB); PG8_STAGE(PG8_SA(1, 0), cA + kstep, voffA); PG8_STAGE(PG8_SB(1, 1), cB + hstepB + kstep, voffB);
        PG8_WAIT_V(6); PG8_BAR;
    } else {
        PG8_STAGE(PG8_SB(0, 0), cB, voffB); PG8_STAGE(PG8_SA(0, 0), cA, voffA); PG8_STAGE(PG8_SB(0, 1), cB + hstepB, voffB); PG8_STAGE(PG8_SA(0, 1), cA + hstepA, voffA);
        if (wr == 1) PG8_BAR;
        PG8_WAIT_V(4); PG8_BAR;
        PG8_STAGE(PG8_SB(1, 0), cB + kstep, voffB); PG8_STAGE(PG8_SA(1, 0), cA + kstep, voffA); PG8_STAGE(PG8_SB(1, 1), cB + hstepB + kstep, voffB);
        PG8_WAIT_V(6); PG8_BAR;
    }
    for (;;) {
        const bool has_next = S.next(ui + 1, nxt);
        const char* nA = has_next ? nxt.A : cA; const char* nB = has_next ? nxt.B : cB;
        for (int t = 0; t < nt; t += 2) {
            const bool last = (t == nt - 2);
            const char* a1 = cA + (size_t)(t + 1) * kstep;
            const char* a2 = last ? nA : cA + (size_t)(t + 2) * kstep; const char* b2 = last ? nB : cB + (size_t)(t + 2) * kstep;
            const char* a3 = a2 + kstep; const char* b3 = b2 + kstep;
            if constexpr (SP2) {
            PG8_LDB(B0, 0, 0); PG8_LDB(B1, 0, 1); PG8_SCHED; PG8_LDA(At, 0, 0); PG8_STAGE(PG8_SA(1, 1), a1 + hstepA, voffA);
            PG8_WAIT_V(8); PG8_WAIT_L(0); PG8_BAR; PG8_MMA(0, 0, At, B0); PG8_MMA(0, 1, At, B1); PG8_BAR; PG8_SCHED;
            PG8_LDA(At, 0, 1); PG8_STAGE(PG8_SB(0, 0), b2, voffB); PG8_STAGE(PG8_SB(0, 1), b2 + hstepB, voffB); PG8_STAGE(PG8_SA(0, 0), a2, voffA);
            PG8_WAIT_V(8); PG8_WAIT_L(0); PG8_BAR; PG8_MMA(1, 0, At, B0); PG8_MMA(1, 1, At, B1); PG8_BAR; PG8_SCHED;
            PG8_LDB(B0, 1, 0); PG8_LDB(B1, 1, 1); PG8_SCHED; PG8_LDA(At, 1, 0); PG8_STAGE(PG8_SA(0, 1), a2 + hstepA, voffA);
            PG8_WAIT_V(8); PG8_WAIT_L(0); PG8_BAR; PG8_MMA(0, 0, At, B0); PG8_MMA(0, 1, At, B1); PG8_BAR; PG8_SCHED;
            PG8_LDA(At, 1, 1); PG8_STAGE(PG8_SB(1, 0), b3, voffB); PG8_STAGE(PG8_SB(1, 1), b3 + hstepB, voffB); PG8_STAGE(PG8_SA(1, 0), a3, voffA);
            PG8_WAIT_V(8); PG8_WAIT_L(0); PG8_BAR; PG8_MMA(1, 0, At, B0); PG8_MMA(1, 1, At, B1); PG8_BAR; PG8_SCHED;
            } else {
            PG8_LDB(B0, 0, 0); PG8_SCHED; PG8_LDA(At, 0, 0); PG8_STAGE(PG8_SA(1, 1), a1 + hstepA, voffA);
            PG8_WAIT_L(8); PG8_BAR; PG8_WAIT_L(0); PG8_MMA(0, 0, At, B0); PG8_BAR; PG8_SCHED;
            PG8_LDB(B1, 0, 1); PG8_STAGE(PG8_SB(0, 0), b2, voffB);
            PG8_BAR; PG8_WAIT_L(0); PG8_MMA(0, 1, At, B1); PG8_BAR;
            PG8_LDA(At, 0, 1); PG8_STAGE(PG8_SA(0, 0), a2, voffA);
            PG8_BAR; PG8_WAIT_L(0); PG8_MMA(1, 0, At, B0); PG8_BAR; PG8_SCHED;
            PG8_STAGE(PG8_SB(0, 1), b2 + hstepB, voffB);
            PG8_WAIT_V(6); PG8_BAR; PG8_MMA(1, 1, At, B1); PG8_BAR;
            PG8_LDB(B0, 1, 0); PG8_SCHED; PG8_LDA(At, 1, 0); PG8_STAGE(PG8_SA(0, 1), a2 + hstepA, voffA);
            PG8_WAIT_L(8); PG8_BAR; PG8_WAIT_L(0); PG8_MMA(0, 0, At, B0); PG8_BAR; PG8_SCHED;
            PG8_LDB(B1, 1, 1); PG8_STAGE(PG8_SB(1, 0), b3, voffB);
            PG8_BAR; PG8_WAIT_L(0); PG8_MMA(0, 1, At, B1); PG8_BAR;
            PG8_LDA(At, 1, 1); PG8_STAGE(PG8_SA(1, 0), a3, voffA);
            PG8_BAR; PG8_WAIT_L(0); PG8_MMA(1, 0, At, B0); PG8_BAR; PG8_SCHED;
            PG8_STAGE(PG8_SB(1, 1), b3 + hstepB, voffB);
            PG8_WAIT_V(6); PG8_BAR; PG8_MMA(1, 1, At, B1); PG8_BAR;
            }
        }
        if constexpr (ALIGN_EPI) { if (wr == 0) PG8_BAR; }
        E(acc, cur, wr, wc, fr, fq);
        if (!has_next) break;
#pragma unroll
        for (int a = 0; a < 2; ++a)
#pragma unroll
            for (int b = 0; b < 2; ++b)
#pragma unroll
                for (int m = 0; m < 4; ++m)
#pragma unroll
                    for (int n = 0; n < 2; ++n) acc[a][b][m][n] = (f32x4){0.f, 0.f, 0.f, 0.f};
        cur = nxt; cA = nA; cB = nB; ++ui;
        if constexpr (ALIGN_EPI) { if (wr == 1) PG8_BAR; }
    }
    PG8_WAIT_V(0);
    if constexpr (!ALIGN_EPI) { if (wr == 0) PG8_BAR; }
    PG8_BAR;
#undef PG8_SA
#undef PG8_SB
#undef PG8_STAGE
#undef PG8_LDA
#undef PG8_LDB
#undef PG8_MMA
#undef PG8_WAIT_V
#undef PG8_WAIT_L
#undef PG8_BAR
#undef PG8_SCHED
}
}
using pg8::Unit;

struct SchedIn {
    int G, c, l; const char* ws;
    __device__ __forceinline__ bool next(int i, Unit& u) const {
        const int L = i * G + c; const char* XB = ws + WS_XB;
        if (L < 1792) { pg8::tile_of(L, 128, 14, u.pm, u.pn);
            u.A = XB + (size_t)u.pm * 256 * DM * 2; u.B = ws + WS_WA + ((size_t)l * WA_ROWS + (size_t)u.pn * 256) * DM * 2;
            const int pn = u.pn;
            if (pn < 8) { u.type = 1; u.cb = 128 * pn; }
            else if (pn < 10) { u.type = 2; u.cb = 256 * (pn - 8); }
            else { u.type = 3; u.cb = 256 * (pn - 10); }
            return true; }
        const int L2 = L - 1792; if (L2 >= 768) return false;
        pg8::tile_of(L2, 6, 128, u.pm, u.pn);
        u.A = ws + WS_WB + ((size_t)l * WB_ROWS + (size_t)u.pm * 256) * DM * 2; u.B = XB + (size_t)u.pn * 256 * DM * 2;
        if (u.pm < 2) { u.type = 5; u.cb = 256 * u.pm; } else { u.type = 4; u.cb = 256 * (u.pm - 2); }
        return true;
    }
};
struct SchedMix {
    int G, c, l; const char* ws;
    __device__ __forceinline__ bool next(int i, Unit& u) const {
        const int L = i * G + c; if (L >= 256) return false;
        pg8::tile_of(L, 128, 2, u.pm, u.pn);
        u.type = 0; u.cb = 256 * u.pn; u.A = ws + WS_YG + (size_t)u.pm * 256 * 512 * 2; u.B = ws + WS_WGLU + ((size_t)l * 512 + (size_t)u.pn * 256) * 512 * 2;
        return true;
    }
};
struct SchedOut {
    int G, c, l; const char* ws;
    __device__ __forceinline__ bool next(int i, Unit& u) const {
        const int L = i * G + c; if (L >= 1024) return false;
        pg8::tile_of(L, 128, 8, u.pm, u.pn); u.type = 0; u.cb = 256 * u.pn;
        u.A = ws + WS_Y + (size_t)u.pm * 256 * DM * 2; u.B = ws + WS_WOUT + ((size_t)l * DM + (size_t)u.pn * 256) * DM * 2; return true;
    }
};

struct EpiIn {
    unsigned char* ws; int l; const LAS float* rtab; int rbase;
    __device__ __forceinline__ float rstd_of(int row) const { if (rbase < 0) { const u64* ssq = (const u64*)(ws + WS_SSQ) + (size_t)l * MTOK; return rsqrtf((float)ssq[row] * (1.0f / (SSQ_SCALE * (float)DM)) + RMS_EPS); } return rtab[row - rbase]; }
    __device__ __forceinline__ void operator()(const f32x4 (&acc)[2][2][4][2], const Unit& u, int wr, int wc, int fr, int fq) const {
        const int type = u.type;
        if (type >= 4) {
            const int col0 = u.pn * 256 + wc * 32 + 8 * fq;
            bf16_t* dstb = (bf16_t*)(ws + (type == 4 ? WS_GVT : WS_XA));
            unsigned long long* lns = (unsigned long long*)(ws + WS_LNS) + (size_t)l * MTOK * 2;
#pragma unroll
            for (int bj = 0; bj < 2; ++bj) {
                float cs[8], sm[8], sq[8];
#pragma unroll
                for (int e = 0; e < 8; ++e) { cs[e] = rstd_of(col0 + bj * 128 + e); sm[e] = 0.f; sq[e] = 0.f; }
#pragma unroll
                for (int ai = 0; ai < 2; ++ai)
#pragma unroll
                    for (int m = 0; m < 4; ++m) {
                        const int r = u.cb + ai * 128 + wr * 64 + m * 16 + fr; bf16_t* rowp = dstb + (size_t)r * MTOK + col0 + bj * 128;
                        const f32x4 v0 = acc[ai][bj][m][0], v1 = acc[ai][bj][m][1]; u32x4 w;
                        float e[8] = {v0[0] * cs[0], v0[1] * cs[1], v0[2] * cs[2], v0[3] * cs[3], v1[0] * cs[4], v1[1] * cs[5], v1[2] * cs[6], v1[3] * cs[7]};
                        if (type == 4) {
#pragma unroll
                            for (int k = 0; k < 8; ++k) { e[k] = gelu_f(e[k]); sm[k] += e[k]; sq[k] += e[k] * e[k]; } }
                        w.x = cvt_pk_bf16(e[0], e[1]); w.y = cvt_pk_bf16(e[2], e[3]); w.z = cvt_pk_bf16(e[4], e[5]); w.w = cvt_pk_bf16(e[6], e[7]);
                        *(u32x4*)rowp = w; __builtin_amdgcn_sched_barrier(0); }
                if (type == 4) {
#pragma unroll
                    for (int k = 0; k < 8; ++k) {
                        { sm[k] = row16_sum(sm[k]); sq[k] = row16_sum(sq[k]); } }
                    { float pick = 0.f;
#pragma unroll
                      for (int k = 0; k < 8; ++k) { pick = (fr == k) ? sm[k] : pick; pick = (fr == 8 + k) ? sq[k] : pick; }
                      atomicAdd(lns + (size_t)(col0 + bj * 128 + (fr & 7)) * 2 + (fr >> 3), (unsigned long long)(long long)(pick * LNS_SCALE)); } }
            }
            return;
        }
        const int row0 = u.pm * 256 + wr * 64 + fr, cw = wc * 32 + 8 * fq;
        if (type == 1) {
#pragma unroll
            for (int ai = 0; ai < 2; ++ai)
#pragma unroll
                for (int m = 0; m < 4; ++m) { const int row = row0 + ai * 128 + m * 16; const float rs = rstd_of(row);
                    const f32x4 a0 = acc[ai][0][m][0] * rs, a1 = acc[ai][0][m][1] * rs, g0 = acc[ai][1][m][0] * rs, g1 = acc[ai][1][m][1] * rs; u32x4 w;
                    w.x = cvt_pk_bf16(gelu_silu_f(a0[0], g0[0]), gelu_silu_f(a0[1], g0[1])); w.y = cvt_pk_bf16(gelu_silu_f(a0[2], g0[2]), gelu_silu_f(a0[3], g0[3]));
                    w.z = cvt_pk_bf16(gelu_silu_f(a1[0], g1[0]), gelu_silu_f(a1[1], g1[1])); w.w = cvt_pk_bf16(gelu_silu_f(a1[2], g1[2]), gelu_silu_f(a1[3], g1[3]));
                    *(u32x4*)((bf16_t*)(ws + WS_UG) + (size_t)row * 1024 + u.cb + cw) = w; }
            return;
        }
        bf16_t* base = (bf16_t*)(ws + (type == 2 ? WS_XC : WS_SG)); const int ld = type == 3 ? 1024 : 512;
#pragma unroll
        for (int ai = 0; ai < 2; ++ai)
#pragma unroll
            for (int m = 0; m < 4; ++m) { const int row = row0 + ai * 128 + m * 16; const float rs = rstd_of(row); bf16_t* rowp = base + (size_t)row * ld + u.cb + cw;
#pragma unroll
                for (int bj = 0; bj < 2; ++bj) { f32x4 v0 = acc[ai][bj][m][0] * rs, v1 = acc[ai][bj][m][1] * rs;
                    if (type == 3) {
#pragma unroll
                        for (int e = 0; e < 4; ++e) { v0[e] = silu_f(v0[e]); v1[e] = silu_f(v1[e]); } }
                    u32x4 w; w.x = cvt_pk_bf16(v0[0], v0[1]); w.y = cvt_pk_bf16(v0[2], v0[3]); w.z = cvt_pk_bf16(v1[0], v1[1]); w.w = cvt_pk_bf16(v1[2], v1[3]);
                    *(u32x4*)(rowp + bj * 128) = w; } }
    }
};
struct EpiMix {
    unsigned char* ws; int l;
    __device__ __forceinline__ void operator()(const f32x4 (&acc)[2][2][4][2], const Unit& u, int wr, int wc, int fr, int fq) const {
        const int row0 = u.pm * 256 + wr * 64 + fr, cw = u.cb + wc * 32 + 8 * fq;
        const bf16_t* YG = (const bf16_t*)(ws + WS_YG); const bf16_t* SG = (const bf16_t*)(ws + WS_SG); bf16_t* Y = (bf16_t*)(ws + WS_Y);
        const float* bglu = (const float*)(ws + WS_PAR) + PAR_BGLU + l * S5W; const float* pscale = (const float*)(ws + WS_PAR) + PAR_PSC + l * POOLW;
        f32x4 cv[2][2];
#pragma unroll
        for (int bj = 0; bj < 2; ++bj)
#pragma unroll
            for (int n = 0; n < 2; ++n) cv[bj][n] = *(const f32x4*)((u.type == 0 ? bglu : pscale) + cw + bj * 128 + 4 * n);
#pragma unroll
        for (int ai = 0; ai < 2; ++ai)
#pragma unroll
            for (int m = 0; m < 4; ++m) { const int row = row0 + ai * 128 + m * 16;
#pragma unroll
                for (int bj = 0; bj < 2; ++bj) { const int col = cw + bj * 128; const f32x4 a0 = acc[ai][bj][m][0], a1 = acc[ai][bj][m][1]; float o[8];
                    if (u.type == 0) {
                        const u32x4 yg = *(const u32x4*)(YG + (size_t)row * 512 + col), sg = *(const u32x4*)(SG + (size_t)row * 1024 + col);
                        o[0] = bf_lo(yg.x) * sigmoid_f(a0[0] + cv[bj][0][0]) * bf_lo(sg.x); o[1] = bf_hi(yg.x) * sigmoid_f(a0[1] + cv[bj][0][1]) * bf_hi(sg.x);
                        o[2] = bf_lo(yg.y) * sigmoid_f(a0[2] + cv[bj][0][2]) * bf_lo(sg.y); o[3] = bf_hi(yg.y) * sigmoid_f(a0[3] + cv[bj][0][3]) * bf_hi(sg.y);
                        o[4] = bf_lo(yg.z) * sigmoid_f(a1[0] + cv[bj][1][0]) * bf_lo(sg.z); o[5] = bf_hi(yg.z) * sigmoid_f(a1[1] + cv[bj][1][1]) * bf_hi(sg.z);
                        o[6] = bf_lo(yg.w) * sigmoid_f(a1[2] + cv[bj][1][2]) * bf_lo(sg.w); o[7] = bf_hi(yg.w) * sigmoid_f(a1[3] + cv[bj][1][3]) * bf_hi(sg.w);
                        u32x4 w; w.x = cvt_pk_bf16(o[0], o[1]); w.y = cvt_pk_bf16(o[2], o[3]); w.z = cvt_pk_bf16(o[4], o[5]); w.w = cvt_pk_bf16(o[6], o[7]);
                        *(u32x4*)(Y + (size_t)row * DM + col) = w;
                    } else {
                        const u32x4 sg = *(const u32x4*)(SG + (size_t)row * 1024 + 512 + col);
                        o[0] = a0[0] * cv[bj][0][0] * bf_lo(sg.x); o[1] = a0[1] * cv[bj][0][1] * bf_hi(sg.x); o[2] = a0[2] * cv[bj][0][2] * bf_lo(sg.y); o[3] = a0[3] * cv[bj][0][3] * bf_hi(sg.y);
                        o[4] = a1[0] * cv[bj][1][0] * bf_lo(sg.z); o[5] = a1[1] * cv[bj][1][1] * bf_hi(sg.z); o[6] = a1[2] * cv[bj][1][2] * bf_lo(sg.w); o[7] = a1[3] * cv[bj][1][3] * bf_hi(sg.w);
                        u32x4 w; w.x = cvt_pk_bf16(o[0], o[1]); w.y = cvt_pk_bf16(o[2], o[3]); w.z = cvt_pk_bf16(o[4], o[5]); w.w = cvt_pk_bf16(o[6], o[7]);
                        *(u32x4*)(Y + (size_t)row * DM + 1536 + col) = w;
                    } } }
    }
};
struct EpiOut {
    unsigned char* ws; int l; int do_ssq;
    __device__ __forceinline__ void operator()(const f32x4 (&acc)[2][2][4][2], const Unit& u, int wr, int wc, int fr, int fq) const {
        const int row0 = u.pm * 256 + wr * 64 + fr, cw = u.cb + wc * 32 + 8 * fq;
        bf16_t* XB = (bf16_t*)(ws + WS_XB); u64* ssq_next = (u64*)(ws + WS_SSQ) + (size_t)(l + 1) * MTOK;
        float pick[2] = {0.f, 0.f};
#pragma unroll
        for (int ai = 0; ai < 2; ++ai)
#pragma unroll
            for (int m = 0; m < 4; ++m) { const int row = row0 + ai * 128 + m * 16; float s = 0.f;
#pragma unroll
                for (int bj = 0; bj < 2; ++bj) { const size_t off = (size_t)row * DM + cw + bj * 128; const u32x4 xb = *(const u32x4*)(XB + off);
                    const f32x4 a0 = acc[ai][bj][m][0], a1 = acc[ai][bj][m][1];
                    const float v0 = bf_lo(xb.x) + a0[0], v1 = bf_hi(xb.x) + a0[1], v2 = bf_lo(xb.y) + a0[2], v3 = bf_hi(xb.y) + a0[3];
                    const float v4 = bf_lo(xb.z) + a1[0], v5 = bf_hi(xb.z) + a1[1], v6 = bf_lo(xb.w) + a1[2], v7 = bf_hi(xb.w) + a1[3];
                    u32x4 w; w.x = cvt_pk_bf16(v0, v1); w.y = cvt_pk_bf16(v2, v3); w.z = cvt_pk_bf16(v4, v5); w.w = cvt_pk_bf16(v6, v7);
                    *(u32x4*)(XB + off) = w;
                    s += (v0 * v0 + v1 * v1) + (v2 * v2 + v3 * v3) + (v4 * v4 + v5 * v5) + (v6 * v6 + v7 * v7); }
                s = xor32_add(xor16_add(s));
                pick[ai] = (fq == m) ? s : pick[ai]; }
        if (do_ssq) {
#pragma unroll
            for (int ai = 0; ai < 2; ++ai) atomicAdd(ssq_next + row0 + ai * 128 + fq * 16, (u64)(pick[ai] * SSQ_SCALE)); }
    }
};

#define XB_TMO      128
#define XB_XCNT(j)  (256  + 64 * (j))
#define XB_XSUB(j)  (1280 + 64 * (j))
#define XB_XGEN(j)  (2304 + 64 * (j))
#define XB_TOP      3328
#define XB_TOPGEN   3392
#define XCD_BAR_WORDS 3456
#define XB_SPIN_CAP (1u << 18)
__device__ __forceinline__ unsigned xb_ld(unsigned* p)              { return __hip_atomic_load(p, __ATOMIC_RELAXED, __HIP_MEMORY_SCOPE_AGENT); }
__device__ __forceinline__ unsigned xb_add(unsigned* p, unsigned v) { return __hip_atomic_fetch_add(p, v, __ATOMIC_RELAXED, __HIP_MEMORY_SCOPE_AGENT); }
__device__ __forceinline__ unsigned xb_xcc_id() { return (unsigned)__builtin_amdgcn_s_getreg((3 << 11) | 20) & 0xFu; }
#define XB_SPIN(cond, bar) do { unsigned _sp = 0; while (cond) { __builtin_amdgcn_s_sleep(1); \
    if ((++_sp & 255u) == 0u) { if (xb_ld(&(bar)[XB_TMO])) break; if (_sp > XB_SPIN_CAP) { atomicAdd(&(bar)[XB_TMO], 1u); break; } } } } while (0)
struct XcdBarrier { unsigned* bar; unsigned x; volatile LAS unsigned* st; };
__device__ __forceinline__ XcdBarrier xcd_barrier_post(unsigned* bar, volatile LAS unsigned* st) {
    XcdBarrier b; b.bar = bar; b.x = xb_xcc_id(); b.st = st;
    if (threadIdx.x == 0) (void)xb_add(&bar[XB_XCNT(b.x)], 1u);
    return b;
}
__device__ __forceinline__ void xcd_barrier_complete(unsigned* bar, unsigned x, unsigned& nloc, unsigned& nx) {
    const unsigned G = gridDim.x * gridDim.y * gridDim.z;
    unsigned sum, cnt, mine, sp = 0u;
    for (;;) {
        sum = 0u; cnt = 0u; mine = 0u;
#pragma unroll
        for (unsigned j = 0; j < 16; ++j) { const unsigned c = xb_ld(&bar[XB_XCNT(j)]); sum += c; cnt += (c > 0u) ? 1u : 0u; mine = (j == x) ? c : mine; }
        if (sum == G) break;
        __builtin_amdgcn_s_sleep(1);
        if ((++sp & 255u) == 0u) { if (xb_ld(&bar[XB_TMO])) break; if (sp > XB_SPIN_CAP) { atomicAdd(&bar[XB_TMO], 1u); break; } }
    }
    nloc = mine > 0u ? mine : 1u; nx = cnt > 0u ? cnt : 1u;
}
__device__ __forceinline__ void xcd_barrier(const XcdBarrier& b) {
    asm volatile("s_waitcnt vmcnt(0)" ::: "memory");
    __syncthreads();
    if (threadIdx.x == 0) {
        unsigned* bar = b.bar;
        __builtin_amdgcn_s_waitcnt(0);
        unsigned nloc = b.st[0], nx = b.st[1];
        if (nloc == 0u) { xcd_barrier_complete(bar, b.x, nloc, nx); b.st[0] = nloc; b.st[1] = nx; }
        const unsigned old = xb_add(&bar[XB_XSUB(b.x)], 1u);
        const unsigned gen = old / nloc;
        if (old + 1u == (gen + 1u) * nloc) {
            __builtin_amdgcn_fence(__ATOMIC_RELEASE, "agent");
            asm volatile("s_waitcnt vmcnt(0)" ::: "memory");
            const unsigned og = xb_add(&bar[XB_TOP], 1u);
            const unsigned tg = og / nx;
            if (og + 1u == (tg + 1u) * nx) xb_add(&bar[XB_TOPGEN], 1u);
            else XB_SPIN(xb_ld(&bar[XB_TOPGEN]) == tg, bar);
            __builtin_amdgcn_fence(__ATOMIC_ACQUIRE, "agent");
            xb_add(&bar[XB_XGEN(b.x)], 1u);
            asm volatile("s_waitcnt vmcnt(0)" ::: "memory");
        } else {
            XB_SPIN(xb_ld(&bar[XB_XGEN(b.x)]) == gen, bar);
            __builtin_amdgcn_fence(__ATOMIC_ACQUIRE, "agent");
            asm volatile("s_waitcnt vmcnt(0)" ::: "memory");
        }
    }
    __syncthreads();
}

constexpr int NWAVES = 8, NTHR = 512;
constexpr int RING_BYTES = 131072, LDS_BYTES = 163840, LDSCTL_OFF = LDS_BYTES - 512;
struct Args { const float* in[21]; float* out; unsigned char* ws; int ph_lo, ph_hi; };
struct Frame {
    LAS unsigned char* lds; int tid, lane, wave, vcu, G, gw, NGW; unsigned char* ws;
};
__device__ __forceinline__ Frame mkframe(unsigned char* ws, LAS unsigned char* lds, int wave_s) {
    Frame F; int tid; asm volatile("v_mbcnt_lo_u32_b32 %0, -1, 0\n\tv_mbcnt_hi_u32_b32 %0, -1, %0" : "=v"(tid)); tid |= wave_s << 6; int bx = blockIdx.x, G = gridDim.x; asm volatile("" : "+s"(bx), "+s"(G));
    F.lds = lds; F.tid = tid; F.lane = tid & 63; F.wave = __builtin_amdgcn_readfirstlane(tid >> 6);
    F.G = G; F.vcu = (G % 8 == 0) ? (bx % 8) * (G / 8) + bx / 8 : bx;
    F.gw = F.vcu * 8 + F.wave; F.NGW = G * 8; F.ws = ws; return F;
}
#define MFMA16(a, b, c) __builtin_amdgcn_mfma_f32_16x16x32_bf16((a), (b), (c), 0, 0, 0)

constexpr int P0_SCR = 64 * 65 * 4;
struct TItem { const float* W; const float* gk; bf16_t* WT; int K, N, k0, n0src, rowdst; };
__device__ __forceinline__ void t_load(const TItem& d, int lane, f32x4 (&vv)[16]) {
    const int c4 = lane & 15, rsub = lane >> 4;
#pragma unroll
    for (int i = 0; i < 16; ++i) vv[i] = *(const f32x4*)(d.W + (size_t)(d.k0 + 4 * i + rsub) * d.N + d.n0src + 4 * c4);
}
__device__ __forceinline__ void t_finish(const TItem& d, const f32x4 (&vv)[16], LAS float* scr, int lane) {
    const int c4 = lane & 15, rsub = lane >> 4;
#pragma unroll
    for (int i = 0; i < 16; ++i) { const int kk = 4 * i + rsub; f32x4 v = vv[i]; if (d.gk) v = v * d.gk[d.k0 + kk];
        scr[(4 * c4 + 0) * 65 + kk] = v[0]; scr[(4 * c4 + 1) * 65 + kk] = v[1]; scr[(4 * c4 + 2) * 65 + kk] = v[2]; scr[(4 * c4 + 3) * 65 + kk] = v[3]; }
    asm volatile("s_waitcnt lgkmcnt(0)" ::: "memory");
    const int ck = lane & 7;
#pragma unroll
    for (int j = 0; j < 8; ++j) { const int n = 8 * j + (lane >> 3); const LAS float* s = scr + n * 65 + 8 * ck;
        u32x4 o; o.x = cvt_pk_bf16(s[0], s[1]); o.y = cvt_pk_bf16(s[2], s[3]); o.z = cvt_pk_bf16(s[4], s[5]); o.w = cvt_pk_bf16(s[6], s[7]);
        *(u32x4*)(d.WT + (size_t)(d.rowdst + n) * d.K + d.k0 + 8 * ck) = o; }
    asm volatile("s_waitcnt lgkmcnt(0)" ::: "memory");
}
__device__ __forceinline__ void win_map(int s, int& isB, int& row) {
    isB = 0;
    if (s < 512) { isB = 1; row = s; }
    else if (s < 1536) { const int j = (s - 512) >> 7, i = (s - 512) & 127; row = 256 * j + i; }
    else if (s < 2560) { isB = 1; row = 512 + (s - 1536); }
    else if (s < 3072) row = 2048 + (s - 2560);
    else if (s < 3584) row = 2560 + (s - 3072);
    else if (s < 4608) { const int j = (s - 3584) >> 7, i = (s - 3584) & 127; row = 256 * j + 128 + i; }
    else row = 3072 + (s - 4608);
}
__device__ __forceinline__ void p0_prologue(const Frame& F, const Args& a) {
    const float* x = a.in[0]; const float* norm_g = a.in[1]; const float* w_in = a.in[2];
    const float *lam_re = a.in[3], *lam_im = a.in[4], *b_re = a.in[5], *b_im = a.in[6], *log_dt = a.in[10];
    const float *w_glu = a.in[11], *w_s = a.in[15], *w_pool = a.in[17], *w_out = a.in[19];
    unsigned char* ws = F.ws;
    LAS float* scr = (LAS float*)(F.lds + F.wave * P0_SCR);
    constexpr int I_IN = 32 * 72, I_Q = 32 * 16, I_OUT = 32 * 32, I_GLU = 8 * 8, I_T = I_IN + I_OUT + I_GLU;
    for (int it = F.gw; it < 2 * I_Q; it += F.NGW) {
        const int l = it / I_Q, r = it - l * I_Q;
        const int kb = r >> 4, nb = r & 15, dq = 32 * nb, g = dq >> 7, k0 = 64 * kb, cc = F.lane & 15, qq = F.lane >> 4, row = 2048 + dq;
        bf16_t* WT = (bf16_t*)(ws + WS_WA) + (size_t)l * WA_ROWS * DM;
        f32x4 accq[4][2];
#pragma unroll
        for (int mt = 0; mt < 4; ++mt) { accq[mt][0] = (f32x4){0.f, 0.f, 0.f, 0.f}; accq[mt][1] = (f32x4){0.f, 0.f, 0.f, 0.f}; }
#pragma unroll
        for (int ks = 0; ks < 4; ++ks) {
            bf16x8 bq[2];
#pragma unroll
            for (int nt = 0; nt < 2; ++nt) { const float* wp = w_pool + (((size_t)l * 4 + g) * 128 + 32 * ks + 8 * qq) * 128 + (dq & 127) + 16 * nt + cc; u32x4 p;
                p.x = pk_bf16_c(wp[0], wp[128]); p.y = pk_bf16_c(wp[256], wp[384]); p.z = pk_bf16_c(wp[512], wp[640]); p.w = pk_bf16_c(wp[768], wp[896]); bq[nt] = __builtin_bit_cast(bf16x8, p); }
#pragma unroll
            for (int mt = 0; mt < 4; ++mt) { const int k = k0 + 16 * mt + cc; const float gs = norm_g[l * DM + k];
                const f32x4* ap = (const f32x4*)(w_in + ((size_t)l * DM + k) * INC + 2560 + 128 * g + 32 * ks + 8 * qq); const f32x4 a0 = ap[0] * gs, a1 = ap[1] * gs; u32x4 p;
                p.x = pk_bf16_c(a0[0], a0[1]); p.y = pk_bf16_c(a0[2], a0[3]); p.z = pk_bf16_c(a1[0], a1[1]); p.w = pk_bf16_c(a1[2], a1[3]); const bf16x8 aq = __builtin_bit_cast(bf16x8, p);
                accq[mt][0] = MFMA16(aq, bq[0], accq[mt][0]); accq[mt][1] = MFMA16(aq, bq[1], accq[mt][1]); } }
#pragma unroll
        for (int mt = 0; mt < 4; ++mt)
#pragma unroll
            for (int nt = 0; nt < 2; ++nt) { u32x2 o; o.x = pk_bf16_c(accq[mt][nt][0], accq[mt][nt][1]); o.y = pk_bf16_c(accq[mt][nt][2], accq[mt][nt][3]);
                *(u32x2*)(WT + (size_t)(row + 16 * nt + cc) * DM + k0 + 16 * mt + 4 * qq) = o; }
    }
    {
#define T_DECODE(t_, d_) do { int r_ = (t_); const int l_ = r_ / I_T; r_ -= l_ * I_T; \
        if (r_ < I_IN) { const int kb_ = r_ / 72, j_ = r_ % 72, sb_ = 64 * (j_ < 40 ? j_ : j_ + 8); int isB_, row_; win_map(sb_, isB_, row_); \
            d_.W = w_in + (size_t)l_ * DM * INC; d_.gk = norm_g + l_ * DM; d_.WT = isB_ ? (bf16_t*)(ws + WS_WB) + (size_t)l_ * WB_ROWS * DM : (bf16_t*)(ws + WS_WA) + (size_t)l_ * WA_ROWS * DM; \
            d_.K = DM; d_.N = INC; d_.k0 = 64 * kb_; d_.n0src = sb_; d_.rowdst = row_; } \
        else if (r_ < I_IN + I_OUT) { r_ -= I_IN; d_.W = w_out + (size_t)l_ * DM * DM; d_.gk = nullptr; d_.WT = (bf16_t*)(ws + WS_WOUT) + (size_t)l_ * DM * DM; d_.K = DM; d_.N = DM; d_.k0 = 64 * (r_ >> 5); d_.n0src = 64 * (r_ & 31); d_.rowdst = d_.n0src; } \
        else { r_ -= I_IN + I_OUT; d_.W = w_glu + (size_t)l_ * 512 * 512; d_.gk = nullptr; d_.WT = (bf16_t*)(ws + WS_WGLU) + (size_t)l_ * 512 * 512; d_.K = 512; d_.N = 512; d_.k0 = 64 * (r_ >> 3); d_.n0src = 64 * (r_ & 7); d_.rowdst = d_.n0src; } } while (0)
        constexpr int NT = 2 * I_T;
        int t = (F.gw + F.NGW / 2) % F.NGW; TItem dA, dB; f32x4 vA[16], vB[16];
        bool hasA = t < NT; if (hasA) { T_DECODE(t, dA); t_load(dA, F.lane, vA); }
        while (hasA) {
            const int t2 = t + F.NGW; const bool hasB = t2 < NT; if (hasB) { T_DECODE(t2, dB); t_load(dB, F.lane, vB); }
            t_finish(dA, vA, scr, F.lane);
            if (!hasB) break;
            const int t3 = t2 + F.NGW; hasA = t3 < NT; if (hasA) { T_DECODE(t3, dA); t_load(dA, F.lane, vA); }
            t_finish(dB, vB, scr, F.lane);
            t = t3;
        }
#undef T_DECODE
    }
    { bf16_t* XB = (bf16_t*)(ws + WS_XB); u64* ssq0 = (u64*)(ws + WS_SSQ);
      for (int m2 = F.gw; m2 < MTOK / 2; m2 += F.NGW) {
          f32x4 v[2][4][2];
#pragma unroll
          for (int rr = 0; rr < 2; ++rr) { const f32x4* xr = (const f32x4*)(x + (size_t)(2 * m2 + rr) * DM) + 2 * F.lane;
#pragma unroll
              for (int j = 0; j < 4; ++j) { v[rr][j][0] = xr[128 * j]; v[rr][j][1] = xr[128 * j + 1]; } }
#pragma unroll
          for (int rr = 0; rr < 2; ++rr) { u32x4* o = (u32x4*)(XB + (size_t)(2 * m2 + rr) * DM) + F.lane; float s = 0.f;
#pragma unroll
              for (int j = 0; j < 4; ++j) { const f32x4 a = v[rr][j][0], b = v[rr][j][1];
                  s += (a[0] * a[0] + a[1] * a[1]) + (a[2] * a[2] + a[3] * a[3]) + (b[0] * b[0] + b[1] * b[1]) + (b[2] * b[2] + b[3] * b[3]);
                  u32x4 w; w.x = cvt_pk_bf16(a[0], a[1]); w.y = cvt_pk_bf16(a[2], a[3]); w.z = cvt_pk_bf16(b[0], b[1]); w.w = cvt_pk_bf16(b[2], b[3]); o[64 * j] = w; }
              s = wave_sum(s);
              if (F.lane == 0) ssq0[2 * m2 + rr] = (u64)(s * SSQ_SCALE); }
      } }
    const int gt = F.vcu * NTHR + F.tid, NGT = F.G * NTHR;
    { u64* ssq = (u64*)(ws + WS_SSQ) + MTOK; for (int i = gt; i < 2 * MTOK; i += NGT) ssq[i] = 0ull;
      u64* lns = (u64*)(ws + WS_LNS); for (int i = gt; i < 2 * MTOK * 2; i += NGT) lns[i] = 0ull; }
    { float* PAR = (float*)(ws + WS_PAR);
      for (int i = gt; i < PAR_N; i += NGT) { float v;
          if (i < PAR_LNG) v = a.in[12][i - PAR_BGLU]; else if (i < PAR_LNB) v = a.in[13][i - PAR_LNG]; else if (i < PAR_BS) v = a.in[14][i - PAR_LNB];
          else if (i < PAR_PSC) v = a.in[16][i - PAR_BS]; else if (i < PAR_FG) v = a.in[18][i - PAR_PSC]; else v = a.in[20][i - PAR_FG];
          PAR[i] = v; } }
    { bf16_t* WSG = (bf16_t*)(ws + WS_WSG);
      for (int i = gt; i < 2 * 8 * 128 * 128; i += NGT) { const int s = i & 127, t = (i >> 7) & 127; WSG[i] = (bf16_t)(cvt_pk_bf16(s <= t ? w_s[i] : 0.f, 0.f) & 0xffffu); }
    }
    { f32x2* POW = (f32x2*)(ws + WS_POW); f32x2* BBAR = (f32x2*)(ws + WS_BBAR);
      for (int e = gt; e < 2 * S5G * S5P * 17; e += NGT) { const int i = e / 17, n = e - 17 * i; const double dt = exp((double)log_dt[i >> 6]);
          const double mg = exp((double)lam_re[i] * dt * n), th = (double)lam_im[i] * dt * n; POW[e] = (f32x2){(float)(mg * cos(th)), (float)(mg * sin(th))}; }
      for (int i = gt; i < 2 * S5G * S5P; i += NGT) { const int lg = i >> 6;
          const double dt = exp((double)log_dt[lg]), lr = (double)lam_re[i], li = (double)lam_im[i];
          const double mg = exp(lr * dt), th = li * dt, nr = mg * cos(th) - 1.0, ni = mg * sin(th), den = lr * lr + li * li;
          const double qr = (nr * lr + ni * li) / den, qi = (ni * lr - nr * li) / den;
          for (int h = 0; h < 16; ++h) { const double br = (double)b_re[(size_t)i * 16 + h], bi = (double)b_im[(size_t)i * 16 + h];
              BBAR[(size_t)i * 16 + h] = (f32x2){(float)(qr * br - qi * bi), (float)(qr * bi + qi * br)}; } } }
}
__device__ __forceinline__ void s5_tables_a(const Frame& F, const Args& a) {
    const float *c_re = a.in[7], *c_im = a.in[8], *d_skip = a.in[9];
    unsigned char* ws = F.ws; const f32x2* POW = (const f32x2*)(ws + WS_POW); const f32x2* BBAR = (const f32x2*)(ws + WS_BBAR);
    const int gt = F.vcu * NTHR + F.tid, NGT = F.G * NTHR;
    float* KT = (float*)(ws + WS_KT);
    for (int i = gt; i < 2 * S5G * 16 * 256; i += NGT) {
        const int h2 = i & 15, h = (i >> 4) & 15, d = (i >> 8) & 15, lg = i >> 12; float s = 0.f;
        for (int p = 0; p < 64; ++p) { const f32x2 pw = POW[((size_t)lg * 64 + p) * 17 + d], bb = BBAR[((size_t)lg * 64 + p) * 16 + h2];
            const float cr = c_re[((size_t)lg * 16 + h) * 64 + p], ci = c_im[((size_t)lg * 16 + h) * 64 + p];
            const float zr = pw.x * bb.x - pw.y * bb.y, zi = pw.x * bb.y + pw.y * bb.x; s += cr * zr - ci * zi; }
        if (d == 0 && h == h2) s += d_skip[lg * 16 + h];
        KT[i] = s; }
    bf16_t* WEND = (bf16_t*)(ws + WS_WEND);
    for (int i = gt; i < 2 * S5G * 128 * 256; i += NGT) {
        const int t = i & 15, h = (i >> 4) & 15, p2 = (i >> 8) & 127, lg = i >> 15, p = p2 & 63;
        const f32x2 pw = POW[((size_t)lg * 64 + p) * 17 + (15 - t)], bb = BBAR[((size_t)lg * 64 + p) * 16 + h];
        const float v = p2 < 64 ? pw.x * bb.x - pw.y * bb.y : pw.x * bb.y + pw.y * bb.x;
        WEND[i] = (bf16_t)(cvt_pk_bf16(v, 0.f) & 0xffffu); }
    bf16_t* WS5 = (bf16_t*)(ws + WS_WS5);
    for (int i = gt; i < 2 * S5G * 256 * 128; i += NGT) {
        const int p2 = i & 127, row = (i >> 7) & 255, lg = i >> 15, p = p2 & 63, rr = row >> 4, t = 4 * (rr >> 2) + ((row >> 2) & 3), h = 4 * (rr & 3) + (row & 3);
        const f32x2 pw = POW[((size_t)lg * 64 + p) * 17 + (t + 1)];
        const float cr = c_re[((size_t)lg * 16 + h) * 64 + p], ci = c_im[((size_t)lg * 16 + h) * 64 + p];
        const float v = p2 < 64 ? cr * pw.x - ci * pw.y : -(cr * pw.y + ci * pw.x);
        WS5[((size_t)lg * 256 + row) * 384 + 256 + p2] = (bf16_t)(cvt_pk_bf16(v, 0.f) & 0xffffu); }
}
__device__ __forceinline__ void s5_tables_b(const Frame& F) {
    unsigned char* ws = F.ws; const float* KT = (const float*)(ws + WS_KT); bf16_t* WS5 = (bf16_t*)(ws + WS_WS5);
    const int gt = F.vcu * NTHR + F.tid, NGT = F.G * NTHR;
    for (int i = gt; i < 2 * S5G * 256 * 256; i += NGT) {
        const int k = i & 255, row = (i >> 8) & 255, lg = i >> 16, rr = row >> 4, t = 4 * (rr >> 2) + ((row >> 2) & 3), h = 4 * (rr & 3) + (row & 3), h2 = k >> 4, t2 = k & 15;
        const float v = t2 <= t ? KT[(((size_t)lg * 16 + (t - t2)) * 16 + h) * 16 + h2] : 0.f;
        WS5[((size_t)lg * 256 + row) * 384 + k] = (bf16_t)(cvt_pk_bf16(v, 0.f) & 0xffffu); }
}

__device__ __forceinline__ void p2_ln(const Frame& F, const float* ln_g, const float* ln_b, bf16_t* DST) {
    bf16_t* GVT = (bf16_t*)(F.ws + WS_GVT);
    LAS float* red = (LAS float*)F.lds;
    LAS float* stat = (LAS float*)(F.lds + 32768);
    const int o = F.tid & 15, r0 = F.tid >> 4;
    for (int c = F.vcu; c < MTOK / 128; c += F.G) {
        bf16_t* gp = GVT + (size_t)r0 * MTOK + c * 128 + 8 * o; bf16_t* dp = DST + (size_t)r0 * MTOK + c * 128 + 8 * o;
        float s[8], q[8];
#pragma unroll
        for (int j = 0; j < 8; ++j) { s[j] = 0.f; q[j] = 0.f; }
#pragma unroll 4
        for (int i = 0; i < 32; ++i) { const u32x4 v = *(const u32x4*)(gp + (size_t)(32 * i) * MTOK);
            const float e0 = bf_lo(v.x), e1 = bf_hi(v.x), e2 = bf_lo(v.y), e3 = bf_hi(v.y), e4 = bf_lo(v.z), e5 = bf_hi(v.z), e6 = bf_lo(v.w), e7 = bf_hi(v.w);
            s[0] += e0; q[0] += e0 * e0; s[1] += e1; q[1] += e1 * e1; s[2] += e2; q[2] += e2 * e2; s[3] += e3; q[3] += e3 * e3;
            s[4] += e4; q[4] += e4 * e4; s[5] += e5; q[5] += e5 * e5; s[6] += e6; q[6] += e6 * e6; s[7] += e7; q[7] += e7 * e7; }
#pragma unroll
        for (int j = 0; j < 8; ++j) { red[(r0 * 128 + 8 * o + j) * 2] = s[j]; red[(r0 * 128 + 8 * o + j) * 2 + 1] = q[j]; }
        __syncthreads();
        if (F.tid < 128) { float ss = 0.f, qq = 0.f;
            for (int r = 0; r < 32; ++r) { ss += red[(r * 128 + F.tid) * 2]; qq += red[(r * 128 + F.tid) * 2 + 1]; }
            const float mean = ss * (1.0f / 1024.0f), var = fmaxf(qq * (1.0f / 1024.0f) - mean * mean, 0.f);
            stat[F.tid * 2] = mean; stat[F.tid * 2 + 1] = rsqrtf(var + LN_EPS); }
        __syncthreads();
        float mu[8], rs[8];
#pragma unroll
        for (int j = 0; j < 8; ++j) { mu[j] = stat[(8 * o + j) * 2]; rs[j] = stat[(8 * o + j) * 2 + 1]; }
#pragma unroll 4
        for (int i = 0; i < 32; ++i) { const int ch = 32 * i + r0; const float g = ln_g[ch], b = ln_b[ch]; const u32x4 v = *(const u32x4*)(gp + (size_t)(32 * i) * MTOK); u32x4 w;
            w.x = cvt_pk_bf16((bf_lo(v.x) - mu[0]) * rs[0] * g + b, (bf_hi(v.x) - mu[1]) * rs[1] * g + b);
            w.y = cvt_pk_bf16((bf_lo(v.y) - mu[2]) * rs[2] * g + b, (bf_hi(v.y) - mu[3]) * rs[3] * g + b);
            w.z = cvt_pk_bf16((bf_lo(v.z) - mu[4]) * rs[4] * g + b, (bf_hi(v.z) - mu[5]) * rs[5] * g + b);
            w.w = cvt_pk_bf16((bf_lo(v.w) - mu[6]) * rs[6] * g + b, (bf_hi(v.w) - mu[7]) * rs[7] * g + b);
            *(u32x4*)(dp + (size_t)(32 * i) * MTOK) = w; }
        __syncthreads();
    }
}
constexpr int SGU_ROWB = 272;
constexpr int SGU_TILE = 128 * SGU_ROWB;
__device__ __forceinline__ void m1_sgu(const Frame& F, int layer) {
    const bf16_t* GVT = (const bf16_t*)(F.ws + WS_GVT); const bf16_t* UG = (const bf16_t*)(F.ws + WS_UG); bf16_t* Y = (bf16_t*)(F.ws + WS_Y);
    const bf16_t* WSG = (const bf16_t*)(F.ws + WS_WSG) + (size_t)layer * 8 * 128 * 128;
    const float* PAR = (const float*)(F.ws + WS_PAR);
    const float* ln_g = PAR + PAR_LNG + layer * SGUW; const float* ln_b = PAR + PAR_LNB + layer * SGUW; const float* b_s = PAR + PAR_BS + layer * 1024;
    const long long* lns = (const long long*)(F.ws + WS_LNS) + (size_t)layer * MTOK * 2;
    LAS unsigned char* tiles = F.lds;
    const int o = F.tid & 15, r0 = F.tid >> 4, c = F.lane & 15, q = F.lane >> 4, w = F.wave;
    for (int ch = F.vcu; ch < MTOK / 128; ch += F.G) {
        const bf16_t* gp = GVT + (size_t)r0 * MTOK + ch * 128 + 8 * o;
        float mu[8], rs[8];
#pragma unroll
        for (int j = 0; j < 8; ++j) { const long long* sp = lns + (size_t)(ch * 128 + 8 * o + j) * 2; const float mean = (float)sp[0] * (1.0f / (LNS_SCALE * 1024.0f)), ex2 = (float)sp[1] * (1.0f / (LNS_SCALE * 1024.0f));
            mu[j] = mean; rs[j] = rsqrtf(fmaxf(ex2 - mean * mean, 0.f) + LN_EPS); }
        u32x4 stg[2][4]; bf16x8 wcur[2][4];
#pragma unroll
        for (int hh = 0; hh < 2; ++hh) { const int t0n = 16 * ((w + hh) & 7);
#pragma unroll
            for (int i = 0; i < 4; ++i) stg[hh][i] = *(const u32x4*)(gp + (size_t)(hh * 128 + 32 * i) * MTOK);
#pragma unroll
            for (int ks = 0; ks < 4; ++ks) wcur[hh][ks] = *(const bf16x8*)(WSG + ((size_t)hh * 128 + t0n + c) * 128 + 8 * q + 32 * ks); }
#pragma unroll 1
        for (int hp = 0; hp < 4; ++hp) {
#pragma unroll
            for (int hh = 0; hh < 2; ++hh) { LAS unsigned char* tile = tiles + ((hp & 1) * 2 + hh) * SGU_TILE; const int h = 2 * hp + hh;
#pragma unroll
                for (int i = 0; i < 4; ++i) { const int d = r0 + 32 * i, chn = h * 128 + d, rho = 16 * (2 * (d >> 5) + ((d >> 2) & 1)) + 4 * ((d >> 3) & 3) + (d & 3); const float g = ln_g[chn], b = ln_b[chn]; const u32x4 sv = stg[hh][i]; u32x4 wv;
                    wv.x = cvt_pk_bf16((bf_lo(sv.x) - mu[0]) * rs[0] * g + b, (bf_hi(sv.x) - mu[1]) * rs[1] * g + b);
                    wv.y = cvt_pk_bf16((bf_lo(sv.y) - mu[2]) * rs[2] * g + b, (bf_hi(sv.y) - mu[3]) * rs[3] * g + b);
                    wv.z = cvt_pk_bf16((bf_lo(sv.z) - mu[4]) * rs[4] * g + b, (bf_hi(sv.z) - mu[5]) * rs[5] * g + b);
                    wv.w = cvt_pk_bf16((bf_lo(sv.w) - mu[6]) * rs[6] * g + b, (bf_hi(sv.w) - mu[7]) * rs[7] * g + b);
                    *(LAS u32x4*)(tile + rho * SGU_ROWB + 16 * o) = wv; } }
            u32x4 ugv[2][4];
#pragma unroll
            for (int hh = 0; hh < 2; ++hh) { const int h = 2 * hp + hh, m = ch * 128 + 16 * ((w + h) & 7) + c;
#pragma unroll
                for (int j = 0; j < 4; ++j) ugv[hh][j] = *(const u32x4*)(UG + (size_t)m * 1024 + h * 128 + 32 * j + 8 * q); }
            if (hp < 3) {
#pragma unroll
                for (int hh = 0; hh < 2; ++hh) { const int h = 2 * (hp + 1) + hh;
#pragma unroll
                    for (int i = 0; i < 4; ++i) stg[hh][i] = *(const u32x4*)(gp + (size_t)(h * 128 + 32 * i) * MTOK); } }
            __syncthreads();
            f32x4 acc[2][8];
#pragma unroll
            for (int hh = 0; hh < 2; ++hh) { const int h = 2 * hp + hh, tt = (w + h) & 7, nks = (tt >> 1) + 1;
                const LAS unsigned char* ab = tiles + ((hp & 1) * 2 + hh) * SGU_TILE + c * SGU_ROWB + 16 * q;
#pragma unroll
                for (int r = 0; r < 8; ++r) acc[hh][r] = (f32x4){0.f, 0.f, 0.f, 0.f};
#pragma unroll
                for (int ks = 0; ks < 4; ++ks) { if (ks < nks) {
#pragma unroll
                    for (int r = 0; r < 8; ++r) { const bf16x8 av = *(const LAS bf16x8*)(ab + (16 * r) * SGU_ROWB + 64 * ks); acc[hh][r] = MFMA16(av, wcur[hh][ks], acc[hh][r]); } } } }
            if (hp < 3) {
#pragma unroll
                for (int hh = 0; hh < 2; ++hh) { const int h = 2 * (hp + 1) + hh, t0n = 16 * ((w + h) & 7);
#pragma unroll
                    for (int ks = 0; ks < 4; ++ks) wcur[hh][ks] = *(const bf16x8*)(WSG + ((size_t)h * 128 + t0n + c) * 128 + 8 * q + 32 * ks); } }
#pragma unroll
            for (int hh = 0; hh < 2; ++hh) { const int h = 2 * hp + hh, t0 = 16 * ((w + h) & 7), m = ch * 128 + t0 + c;
                const float bs = b_s[h * 128 + t0 + c];
#pragma unroll
                for (int j = 0; j < 4; ++j) { const int col = h * 128 + 32 * j + 8 * q; const u32x4 ug = ugv[hh][j]; u32x4 wv;
                    wv.x = cvt_pk_bf16((acc[hh][2 * j][0] + bs) * bf_lo(ug.x), (acc[hh][2 * j][1] + bs) * bf_hi(ug.x)); wv.y = cvt_pk_bf16((acc[hh][2 * j][2] + bs) * bf_lo(ug.y), (acc[hh][2 * j][3] + bs) * bf_hi(ug.y));
                    wv.z = cvt_pk_bf16((acc[hh][2 * j + 1][0] + bs) * bf_lo(ug.z), (acc[hh][2 * j + 1][1] + bs) * bf_hi(ug.z)); wv.w = cvt_pk_bf16((acc[hh][2 * j + 1][2] + bs) * bf_lo(ug.w), (acc[hh][2 * j + 1][3] + bs) * bf_hi(ug.w));
                    *(u32x4*)(Y + (size_t)m * DM + 512 + col) = wv; } }
        }
        __syncthreads();
    }
}
constexpr int WE_ROWB = 528;
__device__ __forceinline__ void m1_send(const Frame& F, int layer) {
    const bf16_t* WEND = (const bf16_t*)(F.ws + WS_WEND) + (size_t)layer * S5G * 128 * 256;
    const bf16_t* XAT = (const bf16_t*)(F.ws + WS_XA); float* SE = (float*)(F.ws + WS_SE);
    const int c = F.lane & 15, q = F.lane >> 4, w = F.wave;
    for (int it = F.vcu; it < S5G * 8; it += F.G) {
        const int g = it & 31, rg = it >> 5;
        const bf16_t* xb = XAT + (size_t)(16 * g + (q >> 1)) * MTOK + 8 * (q & 1);
        bf16x8 bx[2][8];
#pragma unroll
        for (int s = 0; s < 2; ++s)
#pragma unroll
            for (int ks = 0; ks < 8; ++ks) bx[s][ks] = *(const bf16x8*)(xb + (size_t)(2 * ks) * MTOK + (size_t)((16 * rg + 2 * w + s) * 16 + c) * 16);
#pragma unroll
        for (int i = 0; i < 8; ++i) { const int e = F.tid + 512 * i, row = e >> 5, ch = e & 31;
            *(LAS u32x4*)(F.lds + row * WE_ROWB + 16 * ch) = *(const u32x4*)(WEND + ((size_t)g * 128 + row) * 256 + 8 * ch); }
        __syncthreads();
#pragma unroll
        for (int s = 0; s < 2; ++s) { const int seg = (16 * rg + 2 * w + s) * 16 + c;
#pragma unroll
            for (int r = 0; r < 8; ++r) { f32x4 acc = (f32x4){0.f, 0.f, 0.f, 0.f};
#pragma unroll
                for (int ks = 0; ks < 8; ++ks) { const bf16x8 aw = *(const LAS bf16x8*)(F.lds + (16 * r + c) * WE_ROWB + 64 * ks + 16 * q); acc = MFMA16(aw, bx[s][ks], acc); }
                *(f32x4*)(SE + ((size_t)seg * 32 + g) * 128 + 16 * r + 4 * q) = acc; } }
        __syncthreads();
    }
}
template <int W> __device__ __forceinline__ void pool_item(const Frame& F, int layer, int r4, int g) {
    constexpr int R = 8;
    const bf16_t* Q = (const bf16_t*)(F.ws + WS_XC); const bf16_t* SG = (const bf16_t*)(F.ws + WS_SG); bf16_t* Y = (bf16_t*)(F.ws + WS_Y);
    const float* psc = (const float*)(F.ws + WS_PAR) + PAR_PSC + layer * POOLW;
    const int o16 = F.lane & 15, sub = F.lane >> 4, m0 = (r4 * 4 + sub) * R, tl0 = m0 & (SEQ - 1), col = g * 128 + 8 * o16;
    u32x4 xs[W - 1 + R];
#pragma unroll
    for (int k = 0; k < W - 1 + R; ++k) { const int tl = tl0 - (W - 1) + k;
        xs[k] = tl >= 0 ? *(const u32x4*)(Q + (size_t)(m0 - (W - 1) + k) * 512 + col) : (u32x4){0u, 0u, 0u, 0u}; }
    const f32x4 p0 = *(const f32x4*)(psc + col), p1 = *(const f32x4*)(psc + col + 4);
    float S[8];
#pragma unroll
    for (int e = 0; e < 8; ++e) S[e] = 0.f;
#pragma unroll
    for (int k = 0; k < W - 1; ++k) { S[0] += bf_lo(xs[k].x); S[1] += bf_hi(xs[k].x); S[2] += bf_lo(xs[k].y); S[3] += bf_hi(xs[k].y); S[4] += bf_lo(xs[k].z); S[5] += bf_hi(xs[k].z); S[6] += bf_lo(xs[k].w); S[7] += bf_hi(xs[k].w); }
#pragma unroll
    for (int i = 0; i < R; ++i) { const u32x4 xv = xs[i + W - 1];
        const float xe[8] = {bf_lo(xv.x), bf_hi(xv.x), bf_lo(xv.y), bf_hi(xv.y), bf_lo(xv.z), bf_hi(xv.z), bf_lo(xv.w), bf_hi(xv.w)};
#pragma unroll
        for (int e = 0; e < 8; ++e) S[e] += xe[e];
        const int cnt = tl0 + i + 1 < W ? tl0 + i + 1 : W; const float inv = 1.0f / (float)cnt;
        const u32x4 sg = *(const u32x4*)(SG + (size_t)(m0 + i) * 1024 + 512 + col); u32x4 wv;
        wv.x = cvt_pk_bf16((S[0] * inv - xe[0]) * p0[0] * bf_lo(sg.x), (S[1] * inv - xe[1]) * p0[1] * bf_hi(sg.x));
        wv.y = cvt_pk_bf16((S[2] * inv - xe[2]) * p0[2] * bf_lo(sg.y), (S[3] * inv - xe[3]) * p0[3] * bf_hi(sg.y));
        wv.z = cvt_pk_bf16((S[4] * inv - xe[4]) * p1[0] * bf_lo(sg.z), (S[5] * inv - xe[5]) * p1[1] * bf_hi(sg.z));
        wv.w = cvt_pk_bf16((S[6] * inv - xe[6]) * p1[2] * bf_lo(sg.w), (S[7] * inv - xe[7]) * p1[3] * bf_hi(sg.w));
        *(u32x4*)(Y + (size_t)(m0 + i) * DM + 1536 + col) = wv;
        const u32x4 ov = xs[i];
        S[0] -= bf_lo(ov.x); S[1] -= bf_hi(ov.x); S[2] -= bf_lo(ov.y); S[3] -= bf_hi(ov.y); S[4] -= bf_lo(ov.z); S[5] -= bf_hi(ov.z); S[6] -= bf_lo(ov.w); S[7] -= bf_hi(ov.w); }
}
__device__ __forceinline__ void p2_pool(const Frame& F, int layer) {
    for (int it = F.gw; it < (MTOK / 32) * 4; it += F.NGW) { const int g = it & 3, r4 = it >> 2;
        if (g == 0) pool_item<2>(F, layer, r4, 0); else if (g == 1) pool_item<4>(F, layer, r4, 1); else if (g == 2) pool_item<8>(F, layer, r4, 2); else pool_item<16>(F, layer, r4, 3); }
}

constexpr int CAR_ROWB = 272;
__device__ __forceinline__ void m3_s5(const Frame& F, int layer) {
    const f32x2* POW = (const f32x2*)(F.ws + WS_POW); const float* SE = (const float*)(F.ws + WS_SE);
    const bf16_t* WS5 = (const bf16_t*)(F.ws + WS_WS5) + (size_t)layer * S5G * 256 * 384;
    const bf16_t* XAT = (const bf16_t*)(F.ws + WS_XA); bf16_t* YG = (bf16_t*)(F.ws + WS_YG);
    LAS unsigned char* car = F.lds;
    LAS f32x2* ends = (LAS f32x2*)(F.lds + 256 * CAR_ROWB);
    const int c = F.lane & 15, q = F.lane >> 4, w = F.wave, p = F.lane, sc = F.wave;
    for (int it = F.vcu; it < NB * S5G * 2; it += F.G) {
        const int b = it >> 6, g = (it >> 1) & 31, half = it & 1;
        { const f32x2 l16 = POW[(((size_t)layer * S5G + g) * 64 + p) * 17 + 16];
          const float* e0 = SE + ((size_t)(b * SEGB + sc * 64) * 32 + g) * 128 + p;
          float er[64], ei[64];
          const bool need = sc < 4 * (half + 1);
          if (need) {
#pragma unroll
              for (int j = 0; j < 64; ++j) { er[j] = e0[(size_t)j * 4096]; ei[j] = e0[(size_t)j * 4096 + 64]; } }
          else {
#pragma unroll
              for (int j = 0; j < 64; ++j) { er[j] = 0.f; ei[j] = 0.f; } }
          float sr = 0.f, si = 0.f;
#pragma unroll
          for (int j = 0; j < 64; ++j) { const float nr = l16.x * sr - l16.y * si + er[j], ni = l16.x * si + l16.y * sr + ei[j]; sr = nr; si = ni; }
          ends[sc * 64 + p] = (f32x2){sr, si};
          float mr = l16.x, mi = l16.y;
#pragma unroll
          for (int k = 0; k < 6; ++k) { const float tr = mr * mr - mi * mi, ti = 2.f * mr * mi; mr = tr; mi = ti; }
          __syncthreads();
          float cr = 0.f, ci = 0.f;
          for (int k = 0; k < sc; ++k) { const f32x2 e = ends[k * 64 + p]; const float nr = mr * cr - mi * ci + e.x, ni = mr * ci + mi * cr + e.y; cr = nr; ci = ni; }
          if ((sc >> 2) == half) { sr = cr; si = ci; LAS unsigned char* rowp = car + ((sc & 3) * 64) * CAR_ROWB + 2 * p;
#pragma unroll
              for (int j = 0; j < 64; ++j) { *(LAS bf16_t*)(rowp + j * CAR_ROWB) = (bf16_t)f2bf_rne(sr); *(LAS bf16_t*)(rowp + j * CAR_ROWB + 128) = (bf16_t)f2bf_rne(si);
                  const float nr = l16.x * sr - l16.y * si + er[j], ni = l16.x * si + l16.y * sr + ei[j]; sr = nr; si = ni; } }
          __syncthreads(); }
        bf16x8 aw[2][12];
#pragma unroll
        for (int rr = 0; rr < 2; ++rr)
#pragma unroll
            for (int ks = 0; ks < 12; ++ks) aw[rr][ks] = *(const bf16x8*)(WS5 + ((size_t)g * 256 + 16 * (2 * w + rr) + c) * 384 + 32 * ks + 8 * q);
        const bf16_t* xw = XAT + (size_t)(16 * g + 2 * w + (q >> 1)) * MTOK + 8 * (q & 1);
        const int segbase = b * SEGB + half * 256;
        LAS unsigned char* xfr = F.lds + 256 * CAR_ROWB + 4096;
        u32x4 pre[4];
#pragma unroll
        for (int s = 0; s < 4; ++s) pre[s] = *(const u32x4*)(xw + (size_t)(segbase + s * 16 + c) * 16);
#pragma unroll 1
        for (int sg4 = 0; sg4 < 4; ++sg4) {
#pragma unroll
            for (int s = 0; s < 4; ++s) *(LAS u32x4*)(xfr + ((s * 8 + w) * 64 + F.lane) * 16) = pre[s];
            if (sg4 < 3) {
#pragma unroll
                for (int s = 0; s < 4; ++s) pre[s] = *(const u32x4*)(xw + (size_t)(segbase + (4 * (sg4 + 1) + s) * 16 + c) * 16); }
            __syncthreads();
#pragma unroll
            for (int s = 0; s < 4; ++s) { const int st = 4 * sg4 + s, seg = segbase + st * 16 + c;
                f32x4 a0 = (f32x4){0.f, 0.f, 0.f, 0.f}, a1 = (f32x4){0.f, 0.f, 0.f, 0.f};
#pragma unroll
                for (int ks = 0; ks < 4; ++ks) { const bf16x8 bc = *(const LAS bf16x8*)(car + (st * 16 + c) * CAR_ROWB + 64 * ks + 16 * q); a0 = MFMA16(aw[0][8 + ks], bc, a0); a1 = MFMA16(aw[1][8 + ks], bc, a1); }
#pragma unroll
                for (int ks = 0; ks < 8; ++ks) { const bf16x8 bx = *(const LAS bf16x8*)(xfr + ((s * 8 + ks) * 64 + F.lane) * 16); a0 = MFMA16(aw[0][ks], bx, a0); a1 = MFMA16(aw[1][ks], bx, a1); }
                const int m = seg * 16 + 4 * (w >> 1) + q; u32x4 o;
                o.x = cvt_pk_bf16(gelu_f(a0[0]), gelu_f(a0[1])); o.y = cvt_pk_bf16(gelu_f(a0[2]), gelu_f(a0[3])); o.z = cvt_pk_bf16(gelu_f(a1[0]), gelu_f(a1[1])); o.w = cvt_pk_bf16(gelu_f(a1[2]), gelu_f(a1[3]));
                *(u32x4*)(YG + (size_t)m * 512 + 16 * g + 8 * (w & 1)) = o; }
            __syncthreads();
        }
        __syncthreads();
    }
}

__device__ __forceinline__ void p_final(const Frame& F, float* out, const float* final_g) {
    const u64* ssq = (const u64*)(F.ws + WS_SSQ) + 2 * (size_t)MTOK; const bf16_t* XB = (const bf16_t*)(F.ws + WS_XB);
    for (int m = F.gw; m < MTOK; m += F.NGW) {
        const float rs = rsqrtf((float)ssq[m] * (1.0f / (SSQ_SCALE * (float)DM)) + RMS_EPS);
        const u32x4* xr = (const u32x4*)(XB + (size_t)m * DM) + F.lane; f32x4* orow = (f32x4*)(out + (size_t)m * DM) + 2 * F.lane; const f32x4* gr = (const f32x4*)final_g + 2 * F.lane;
#pragma unroll
        for (int j = 0; j < 4; ++j) { const u32x4 v = xr[64 * j]; const f32x4 g0 = gr[128 * j], g1 = gr[128 * j + 1];
            orow[128 * j] = (f32x4){bf_lo(v.x) * rs * g0[0], bf_hi(v.x) * rs * g0[1], bf_lo(v.y) * rs * g0[2], bf_hi(v.y) * rs * g0[3]};
            orow[128 * j + 1] = (f32x4){bf_lo(v.z) * rs * g1[0], bf_hi(v.z) * rs * g1[1], bf_lo(v.w) * rs * g1[2], bf_hi(v.w) * rs * g1[3]}; }
    }
}

constexpr int N_PHASES = 12;
#ifndef PROBE_PHASE
#define PROBE_PHASE (-1)
#endif
#ifndef PROBE_REPS
#define PROBE_REPS 1
#endif
#ifndef PROBE_SUB
#define PROBE_SUB 0
#endif
__global__ void __launch_bounds__(NTHR, 2) hybrid_fwd(Args args) {
    extern __shared__ __attribute__((aligned(16))) unsigned char lds_raw[];
    LAS unsigned char* lds = (LAS unsigned char*)lds_raw;
    volatile LAS unsigned* MISC = (volatile LAS unsigned*)(lds + LDSCTL_OFF);
    if (threadIdx.x < 64) MISC[threadIdx.x] = 0u;
    const int wave_s = __builtin_amdgcn_readfirstlane(threadIdx.x >> 6);
    __syncthreads();
    unsigned char* ws0 = args.ws;
    XcdBarrier bar; bar.bar = (unsigned*)(ws0 + WS_CTL) + 1024; bar.x = 0; bar.st = nullptr;
#if !MK_MULTI
    bar = xcd_barrier_post((unsigned*)(ws0 + WS_CTL) + 1024, MISC + 8);
#endif
#pragma unroll 1
    for (int ph = args.ph_lo; ph < args.ph_hi; ++ph) {
        const int l = ph == 0 ? 0 : (ph - 1) / 5, sub = ph == 0 ? 0 : (ph == N_PHASES - 1 ? 6 : 1 + (ph - 1) % 5);
        const int nrep = (ph == PROBE_PHASE) ? PROBE_REPS : 1;
#pragma unroll 1
        for (int rep = 0; rep < nrep; ++rep) {
            unsigned char* ws = ws0; asm volatile("" : "+s"(ws));
            int bx = blockIdx.x, gx = gridDim.x; asm volatile("" : "+s"(bx), "+s"(gx));
            if (sub == 0) { const Frame F = mkframe(ws, lds, wave_s); p0_prologue(F, args); }
            else if (sub == 1) {
                if (l == 0 && rep == 0) { const Frame F = mkframe(ws, lds, wave_s); s5_tables_a(F, args); }
                const int rbase = (gx % 8 == 0 && gx == 256) ? 4096 * (bx & 7) : -1;
                LAS float* rtab = (LAS float*)(lds + RING_BYTES);
                { const Frame F = mkframe(ws, lds, wave_s); const u64* ssq = (const u64*)(ws + WS_SSQ) + (size_t)l * MTOK;
                  if (rbase >= 0) { for (int i = F.tid; i < 4096; i += NTHR) rtab[i] = rsqrtf((float)ssq[rbase + i] * (1.0f / (SSQ_SCALE * (float)DM)) + RMS_EPS); }
                  __syncthreads(); }
                SchedIn S{gx, bx, l, (const char*)ws};
                EpiIn E{ws, l, rtab, rbase};
                pg8::gemm_phase<EpiIn, SchedIn, true, true>(lds, wave_s, DM, DM, DM, S, E);
            } else if (sub == 2) {
                if (l == 0 && rep == 0) { const Frame F = mkframe(ws, lds, wave_s); s5_tables_b(F); }
                if (PROBE_SUB == 0 || PROBE_SUB == 1 || rep == 0) { const Frame F = mkframe(ws, lds, wave_s); m1_sgu(F, l); }
                if (PROBE_SUB == 0 || PROBE_SUB == 2 || rep == 0) { const Frame F = mkframe(ws, lds, wave_s); m1_send(F, l); }
                if (PROBE_SUB == 0 || PROBE_SUB == 3 || rep == 0) { const Frame F = mkframe(ws, lds, wave_s); p2_pool(F, l); }
            } else if (sub == 3) { const Frame F = mkframe(ws, lds, wave_s); m3_s5(F, l); }
            else if (sub == 4) {
                SchedMix S{gx, bx, l, (const char*)ws};
                EpiMix E{ws, l};
                pg8::gemm_phase<EpiMix, SchedMix, true, true>(lds, wave_s, 512, 512, 512, S, E);
            } else if (sub == 5) {
                SchedOut S{gx, bx, l, (const char*)ws};
                EpiOut E{ws, l, rep == 0 ? 1 : 0};
                pg8::gemm_phase<EpiOut, SchedOut, true, true>(lds, wave_s, DM, DM, DM, S, E);
            } else { const Frame F = mkframe(ws, lds, wave_s); p_final(F, args.out, (const float*)(ws + WS_PAR) + PAR_FG); }
#if !MK_MULTI
            if (rep + 1 < nrep) xcd_barrier(bar);
#endif
        }
#if !MK_MULTI
        if (ph + 1 < args.ph_hi) xcd_barrier(bar);
#endif
    }
}

extern "C" void kernel_launch(void* const* d_in, const int* in_sizes, int n_in, void* d_out, int out_size, void* d_ws, size_t ws_size, hipStream_t stream) {
    static int grid = 0;
    if (grid == 0) {
        if (n_in != 21 || in_sizes[0] != MTOK * DM || out_size != MTOK * DM || ws_size < WS_END) { fprintf(stderr, "kernel_launch: unexpected shapes (n_in %d, in0 %d, out %d, ws %zu)\n", n_in, n_in > 0 ? in_sizes[0] : -1, out_size, ws_size); grid = -1; return; }
        int dev = 0, cus = 0, per_cu = 0;
        if (hipGetDevice(&dev) != hipSuccess || hipDeviceGetAttribute(&cus, hipDeviceAttributeMultiprocessorCount, dev) != hipSuccess) { grid = -1; return; }
        if (hipFuncSetAttribute((const void*)hybrid_fwd, hipFuncAttributeMaxDynamicSharedMemorySize, LDS_BYTES) != hipSuccess) { fprintf(stderr, "kernel_launch: hipFuncSetAttribute failed\n"); grid = -1; return; }
        if (hipOccupancyMaxActiveBlocksPerMultiprocessor(&per_cu, (const void*)hybrid_fwd, NTHR, LDS_BYTES) != hipSuccess || per_cu < 1) { fprintf(stderr, "kernel_launch: occupancy query says %d blocks per CU\n", per_cu); per_cu = 1; }
        (void)hipGetLastError();
        grid = cus;
    }
    if (grid < 0) return;
    (void)hipMemsetAsync((char*)d_ws + WS_CTL, 0, CTL_ZERO_BYTES, stream);
    Args a{};
    for (int i = 0; i < 21; ++i) a.in[i] = (const float*)d_in[i];
    a.out = (float*)d_out; a.ws = (unsigned char*)d_ws;
#if MK_MULTI
    for (int ph = 0; ph < N_PHASES; ++ph) { a.ph_lo = ph; a.ph_hi = ph + 1; hipLaunchKernelGGL(hybrid_fwd, dim3(grid), dim3(NTHR), LDS_BYTES, stream, a); }
#else
    a.ph_lo = 0; a.ph_hi = N_PHASES;
    void* kargs[] = {&a};
    hipError_t e = hipLaunchCooperativeKernel((const void*)hybrid_fwd, dim3(grid), dim3(NTHR), kargs, LDS_BYTES, stream);
    if (e != hipSuccess) fprintf(stderr, "kernel_launch: cooperative launch failed: %s (grid %d)\n", hipGetErrorString(e), grid);
#endif
}
```

```cpp
#include <hip/hip_runtime.h>
#include <cstdio>
#include <cstdint>

#ifndef MK_MULTI
#define MK_MULTI 0
#endif

#define LAS __attribute__((address_space(3)))
#define GAS __attribute__((address_space(1)))
typedef unsigned short bf16_t;
typedef short bf16x8 __attribute__((ext_vector_type(8)));
typedef float f32x4 __attribute__((ext_vector_type(4)));
typedef float f32x2 __attribute__((ext_vector_type(2)));
typedef unsigned u32x4 __attribute__((ext_vector_type(4)));
typedef unsigned u32x2 __attribute__((ext_vector_type(2)));
typedef unsigned long long u64;

constexpr int DM = 2048, NB = 4, SEQ = 8192, DEPTH = 2, MTOK = NB * SEQ;
constexpr int S5W = 512, SGUW = 1024, POOLW = 512, INC = 5120;
constexpr int S5G = 32, S5H = 16, S5P = 64;
constexpr int NSEG = MTOK / 16, SEGB = SEQ / 16; constexpr int WA_ROWS = 3584, WB_ROWS = 1536;
constexpr float RMS_EPS = 1e-6f, LN_EPS = 1e-5f;
constexpr float SSQ_SCALE = 16777216.0f;

constexpr size_t MiB = 1u << 20;
constexpr size_t WS_CTL = 0, CTL_ZERO_BYTES = 64 * 1024;
constexpr size_t WS_SSQ = 1 * MiB;
constexpr size_t WS_POW = 2 * MiB;
constexpr size_t WS_BBAR = WS_POW + 640 * 1024;
constexpr size_t WS_PAR = 3 * MiB + 256 * 1024;
constexpr int PAR_BGLU = 0, PAR_LNG = 1024, PAR_LNB = 3072, PAR_BS = 5120, PAR_PSC = 7168, PAR_FG = 8192, PAR_N = 10240;
constexpr size_t WS_KT = 4 * MiB;
constexpr size_t WS_WEND = 5 * MiB;
constexpr size_t WS_WS5 = 9 * MiB;
constexpr size_t WS_WSG = 21 * MiB;
constexpr size_t WS_WGLU = 22 * MiB;
constexpr size_t WS_WPD = 23 * MiB;
constexpr size_t WS_WA = 24 * MiB;
constexpr size_t WS_WB = 52 * MiB;
constexpr size_t WS_WOUT = 64 * MiB;
constexpr size_t WS_XB = 80 * MiB;
constexpr size_t WS_XA = 208 * MiB;
constexpr size_t WS_GVT = 240 * MiB;
constexpr size_t WS_UG = 304 * MiB;
constexpr size_t WS_XC = 368 * MiB;
constexpr size_t WS_SG = 400 * MiB;
constexpr size_t WS_PF = 464 * MiB;
constexpr size_t WS_YG = 496 * MiB;
constexpr size_t WS_Y = 528 * MiB;
constexpr size_t WS_SE = 656 * MiB;
constexpr size_t WS_CARRY = 688 * MiB;
constexpr size_t WS_LNS = 704 * MiB;
constexpr size_t WS_END = 706 * MiB;
constexpr float LNS_SCALE = 1073741824.0f;

__device__ __forceinline__ unsigned cvt_pk_bf16(float lo, float hi) { unsigned r; asm volatile("v_cvt_pk_bf16_f32 %0, %1, %2" : "=v"(r) : "v"(lo), "v"(hi)); return r; }
__device__ __forceinline__ unsigned f2bf_rne(float f) { unsigned u = __float_as_uint(f); return (u + 0x7fffu + ((u >> 16) & 1u)) >> 16; }
__device__ __forceinline__ unsigned pk_bf16_c(float lo, float hi) { return f2bf_rne(lo) | (f2bf_rne(hi) << 16); }
__device__ __forceinline__ float bf_lo(unsigned w) { return __uint_as_float(w << 16); }
__device__ __forceinline__ float bf_hi(unsigned w) { return __uint_as_float(w & 0xffff0000u); }
__device__ __forceinline__ float bf2f(bf16_t b) { return __uint_as_float(((unsigned)b) << 16); }
__device__ __forceinline__ float sigmoid_f(float x) { return __builtin_amdgcn_rcpf(1.0f + __builtin_amdgcn_exp2f(-1.4426950408889634f * x)); }
__device__ __forceinline__ float silu_f(float x) { return x * sigmoid_f(x); }
__device__ __forceinline__ float gelu_f(float x) {
    const float u = x * (1.0f + 0.044715f * x * x);
    return x * __builtin_amdgcn_rcpf(1.0f + __builtin_amdgcn_exp2f(-2.302208198f * u));
}
__device__ __forceinline__ float gelu_silu_f(float a, float g) {
    const float u = a * (1.0f + 0.044715f * a * a);
    const float ea = __builtin_amdgcn_exp2f(-2.302208198f * u), eg = __builtin_amdgcn_exp2f(-1.4426950408889634f * g);
    return a * g * __builtin_amdgcn_rcpf((1.0f + ea) * (1.0f + eg));
}
template <int CTRL> __device__ __forceinline__ float dpp_f(float v) { return __int_as_float(__builtin_amdgcn_update_dpp(0, __float_as_int(v), CTRL, 0xf, 0xf, false)); }
__device__ __forceinline__ float row16_sum(float v) { v += dpp_f<0x128>(v); v += dpp_f<0x124>(v); v += dpp_f<0x122>(v); v += dpp_f<0x121>(v); return v; }
__device__ __forceinline__ float xor16_add(float v) { return v + __int_as_float(__builtin_amdgcn_ds_swizzle(__float_as_int(v), 0x401F)); }
__device__ __forceinline__ float xor32_add(float v) { const auto r = __builtin_amdgcn_permlane32_swap(__float_as_uint(v), __float_as_uint(v), false, false); return __uint_as_float(r[0]) + __uint_as_float(r[1]); }
__device__ __forceinline__ float wave_sum(float v) { return xor32_add(xor16_add(row16_sum(v))); }

namespace pg8 {
constexpr int BM = 256, BK = 64, HALF = 128, HTB = HALF * BK * 2, STAGE_BYTES = 8 * HTB, NXCD = 8, WGM = 8;
__host__ __device__ __forceinline__ int lds_byte(int r, int c) { const int st = (r >> 4) * 2 + (c >> 5), rr = r & 15, cc = c & 31, ob = rr * 64 + cc * 2; return st * 1024 + (ob ^ (((ob >> 9) & 1) << 5)); }
__host__ __device__ __forceinline__ void stage_rc(int b, int& R, int& C) { const int st = b / 1024, sb = b % 1024, swz = sb ^ (((sb >> 9) & 1) << 5); R = (st >> 1) * 16 + swz / 64; C = (st & 1) * 32 + (swz % 64) / 2; }
__host__ __device__ __forceinline__ int perm32(int rho) { const int n = rho >> 4, i = rho & 15; return 8 * (i >> 2) + 4 * n + (i & 3); }

struct Unit { int pm, pn, type, cb; const char* A; const char* B; };
__device__ __forceinline__ void tile_of(int L, int nM, int nN, int& pm, int& pn) {
    const int nwg = nM * nN; int wgid = L; { const int q = nwg / NXCD, r = nwg % NXCD, xcd = wgid % NXCD, off = wgid / NXCD; wgid = (xcd < r ? xcd * (q + 1) : r * (q + 1) + (xcd - r) * q) + off; }
    const int nig = WGM * nN, gid = wgid / nig, fm = gid * WGM, gsz = (nM - fm) < WGM ? (nM - fm) : WGM;
    pm = fm + ((wgid % nig) % gsz); pn = (wgid % nig) / gsz;
}

template <class Epi, class Sched, bool ALIGN_EPI, bool SP2>
__device__ __forceinline__ void gemm_phase(LAS unsigned char* lds, const int wave_s, const int K, const int ldA, const int ldB, const Sched& S, const Epi& E) {
    int tid_; asm volatile("v_mbcnt_lo_u32_b32 %0, -1, 0\n\tv_mbcnt_hi_u32_b32 %0, -1, %0" : "=v"(tid_)); tid_ |= wave_s << 6;
    const int tid = tid_, wid = __builtin_amdgcn_readfirstlane(tid >> 6), lane = tid & 63, wr = wid >> 2, wc = wid & 3, fr = lane & 15, fq = lane >> 4;
    const int nt = K / BK;
    unsigned voffA[2], voffB[2];
#pragma unroll
    for (int i = 0; i < 2; ++i) { int R, C; stage_rc(tid * 16 + i * 8192, R, C); const int Rb = (R & ~31) + perm32(R & 31);
        voffA[i] = (unsigned)(R * ldA + C) * 2u; voffB[i] = (unsigned)(Rb * ldB + C) * 2u; }
    const size_t kstep = (size_t)(BK * 2);
    const size_t hstepA = (size_t)HALF * ldA * 2, hstepB = (size_t)HALF * ldB * 2;
    const unsigned ldsw = (unsigned)wid * 1024u;
    const int aoff = lds_byte(wr * 64 + fr, fq * 8), boff = lds_byte(wc * 32 + fr, fq * 8);
#define PG8_SA(b, h) (((b) * 2 + (h)) * HTB)
#define PG8_SB(b, h) ((4 + (b) * 2 + (h)) * HTB)
#define PG8_STAGE(bufoff, gbase, voff) do { _Pragma("unroll") for (int _i = 0; _i < 2; ++_i) \
        __builtin_amdgcn_global_load_lds((const unsigned*)((const char*)(gbase) + (voff)[_i]), (LAS unsigned*)(lds + (bufoff) + ldsw + _i * 8192), 16, 0, 0); } while (0)
#define PG8_LDA(dst, b, h) do { _Pragma("unroll") for (int m = 0; m < 4; ++m) _Pragma("unroll") for (int k = 0; k < 2; ++k) dst[m][k] = *(const LAS bf16x8*)(lds + PG8_SA(b, h) + aoff + m * 2048 + k * 1024); } while (0)
#define PG8_LDB(dst, b, h) do { _Pragma("unroll") for (int n = 0; n < 2; ++n) _Pragma("unroll") for (int k = 0; k < 2; ++k) dst[n][k] = *(const LAS bf16x8*)(lds + PG8_SB(b, h) + boff + n * 2048 + k * 1024); } while (0)
#define PG8_MMA(ai, bj, At, Bt) do { __builtin_amdgcn_s_setprio(1); _Pragma("unroll") for (int m = 0; m < 4; ++m) _Pragma("unroll") for (int n = 0; n < 2; ++n) _Pragma("unroll") for (int k = 0; k < 2; ++k) \
        acc[ai][bj][m][n] = __builtin_amdgcn_mfma_f32_16x16x32_bf16(Bt[n][k], At[m][k], acc[ai][bj][m][n], 0, 0, 0); __builtin_amdgcn_s_setprio(0); } while (0)
#define PG8_WAIT_V(n) asm volatile("s_waitcnt vmcnt(" #n ")" ::: "memory")
#define PG8_WAIT_L(n) asm volatile("s_waitcnt lgkmcnt(" #n ")" ::: "memory")
#define PG8_BAR __builtin_amdgcn_s_barrier()
#define PG8_SCHED __builtin_amdgcn_sched_barrier(0)
    Unit cur, nxt; int ui = 0;
    if (!S.next(0, cur)) return;
    f32x4 acc[2][2][4][2];
#pragma unroll
    for (int a = 0; a < 2; ++a)
#pragma unroll
        for (int b = 0; b < 2; ++b)
#pragma unroll
            for (int m = 0; m < 4; ++m)
#pragma unroll
                for (int n = 0; n < 2; ++n) acc[a][b][m][n] = (f32x4){0.f, 0.f, 0.f, 0.f};
    bf16x8 At[4][2], B0[2][2], B1[2][2];
    const char* cA = cur.A; const char* cB = cur.B;
    if constexpr (SP2) {
        PG8_STAGE(PG8_SB(0, 0), cB, voffB); PG8_STAGE(PG8_SB(0, 1), cB + hstepB, voffB); PG8_STAGE(PG8_SA(0, 0), cA, voffA); PG8_STAGE(PG8_SA(0, 1), cA + hstepA, voffA);
        if (wr == 1) PG8_BAR;
        PG8_WAIT_V(2); PG8_BAR;
        PG8_STAGE(PG8_SB(1, 0), cB + kstep, voffB); PG8_STAGE(PG8_SA(1, 0), cA + kstep, voffA); PG8_STAGE(PG8_SB(1, 1), cB + hstepB + kstep, voffB);
        PG8_WAIT_V(6); PG8_BAR;
    } else {
        PG8_STAGE(PG8_SB(0, 0), cB, voffB); PG8_STAGE(PG8_SA(0, 0), cA, voffA); PG8_STAGE(PG8_SB(0, 1), cB + hstepB, voffB); PG8_STAGE(PG8_SA(0, 1), cA + hstepA, voffA);
        if (wr == 1) PG8_BAR;
        PG8_WAIT_V(4); PG8_BAR;
        PG8_STAGE(PG8_SB(1, 0), cB + kstep, voffB); PG8_STAGE(PG8_SA(1, 0), cA + kstep, voffA); PG8_STAGE(PG8_SB(1, 1), cB + hstepB + kstep, voffB);
        PG8_WAIT_V(6); PG8_BAR;
    }
    for (;;) {
        const bool has_next = S.next(ui + 1, nxt);
        const char* nA = has_next ? nxt.A : cA; const char* nB = has_next ? nxt.B : cB;
        for (int t = 0; t < nt; t += 2) {
            const bool last = (t == nt - 2);
            const char* a1 = cA + (size_t)(t + 1) * kstep;
            const char* a2 = last ? nA : cA + (size_t)(t + 2) * kstep; const char* b2 = last ? nB : cB + (size_t)(t + 2) * kstep;
            const char* a3 = a2 + kstep; const char* b3 = b2 + kstep;
            if constexpr (SP2) {
            PG8_LDB(B0, 0, 0); PG8_LDB(B1, 0, 1); PG8_SCHED; PG8_LDA(At, 0, 0); PG8_STAGE(PG8_SA(1, 1), a1 + hstepA, voffA);
            PG8_WAIT_V(8); PG8_WAIT_L(0); PG8_BAR; PG8_MMA(0, 0, At, B0); PG8_MMA(0, 1, At, B1); PG8_BAR; PG8_SCHED;
            PG8_LDA(At, 0, 1); PG8_STAGE(PG8_SB(0, 0), b2, voffB); PG8_STAGE(PG8_SB(0, 1), b2 + hstepB, voffB); PG8_STAGE(PG8_SA(0, 0), a2, voffA);
            PG8_WAIT_V(8); PG8_WAIT_L(0); PG8_BAR; PG8_MMA(1, 0, At, B0); PG8_MMA(1, 1, At, B1); PG8_BAR; PG8_SCHED;
            PG8_LDB(B0, 1, 0); PG8_LDB(B1, 1, 1); PG8_SCHED; PG8_LDA(At, 1, 0); PG8_STAGE(PG8_SA(0, 1), a2 + hstepA, voffA);
            PG8_WAIT_V(8); PG8_WAIT_L(0); PG8_BAR; PG8_MMA(0, 0, At, B0); PG8_MMA(0, 1, At, B1); PG8_BAR; PG8_SCHED;
            PG8_LDA(At, 1, 1); PG8_STAGE(PG8_SB(1, 0), b3, voffB); PG8_STAGE(PG8_SB(1, 1), b3 + hstepB, voffB); PG8_STAGE(PG8_SA(1, 0), a3, voffA);
            PG8_WAIT_V(8); PG8_WAIT_L(0); PG8_BAR; PG8_MMA(1, 0, At, B0); PG8_MMA(1, 1, At, B1); PG8_BAR; PG8_SCHED;
            } else {
            PG8_LDB(B0, 0, 0); PG8_SCHED; PG8_LDA(At, 0, 0); PG8_STAGE(PG8_SA(1, 1), a1 + hstepA, voffA);
            PG8_WAIT_L(8); PG8_BAR; PG8_WAIT_L(0); PG8_MMA(0, 0, At, B0); PG8_BAR; PG8_SCHED;
            PG8_LDB(B1, 0, 1); PG8_STAGE(PG8_SB(0, 0), b2, voffB);
            PG8_BAR; PG8_WAIT_L(0); PG8_MMA(0, 1, At, B1); PG8_BAR;
            PG8_LDA(At, 0, 1); PG8_STAGE(PG8_SA(0, 0), a2, voffA);
            PG8_BAR; PG8_WAIT_L(0); PG8_MMA(1, 0, At, B0); PG8_BAR; PG8_SCHED;
            PG8_STAGE(PG8_SB(0, 1), b2 + hstepB, voffB);
            PG8_WAIT_V(6); PG8_BAR; PG8_MMA(1, 1, At, B1); PG8_BAR;
            PG8_LDB(B0, 1, 0); PG8_SCHED; PG8_LDA(At, 1, 0); PG8_STAGE(PG8_SA(0, 1), a2 + hstepA, voffA);
            PG8_WAIT_L(8); PG8_BAR; PG8_WAIT_L(0); PG8_MMA(0, 0, At, B0); PG8_BAR; PG8_SCHED;
            PG8_LDB(B1, 1, 1); PG8_STAGE(PG8_SB(1, 0), b3, voffB);
            PG8_BAR; PG8_WAIT_L(0); PG8_MMA(0, 1, At, B1); PG8_BAR;
            PG8_LDA(At, 1, 1); PG8_STAGE(PG8_SA(1, 0), a3, voffA);
            PG8_BAR; PG8_WAIT_L(0); PG8_MMA(1, 0, At, B0); PG8_BAR; PG8_SCHED;
            PG8_STAGE(PG8_SB(1, 1), b3 + hstepB, voffB);
            PG8_WAIT_V(6); PG8_BAR; PG8_MMA(1, 1, At, B1); PG8_BAR;
            }
        }
        if constexpr (ALIGN_EPI) { if (wr == 0) PG8_BAR; }
        E(acc, cur, wr, wc, fr, fq);
        if (!has_next) break;
#pragma unroll
        for (int a = 0; a < 2; ++a)
#pragma unroll
            for (int b = 0; b < 2; ++b)
#pragma unroll
                for (int m = 0; m < 4; ++m)
#pragma unroll
                    for (int n = 0; n < 2; ++n) acc[a][b][m][n] = (f32x4){0.f, 0.f, 0.f, 0.f};
        cur = nxt; cA = nA; cB = nB; ++ui;
        if constexpr (ALIGN_EPI) { if (wr == 1) PG8_BAR; }
    }
    PG8_WAIT_V(0);
    if constexpr (!ALIGN_EPI) { if (wr == 0) PG8_BAR; }
    PG8_BAR;
#undef PG8_SA
#undef PG8_SB
#undef PG8_STAGE
#undef PG8_LDA
#undef PG8_LDB
#undef PG8_MMA
#undef PG8_WAIT_V
#undef PG8_WAIT_L
#undef PG8_BAR
#undef PG8_SCHED
}
}
using pg8::Unit;

struct SchedIn {
    int G, c, l; const char* ws;
    __device__ __forceinline__ bool next(int i, Unit& u) const {
        const int L = i * G + c; const char* XB = ws + WS_XB;
        if (L < 1792) { pg8::tile_of(L, 128, 14, u.pm, u.pn);
            u.A = XB + (size_t)u.pm * 256 * DM * 2; u.B = ws + WS_WA + ((size_t)l * WA_ROWS + (size_t)u.pn * 256) * DM * 2;
            const int pn = u.pn;
            if (pn < 8) { u.type = 1; u.cb = 128 * pn; }
            else if (pn < 10) { u.type = 2; u.cb = 256 * (pn - 8); }
            else { u.type = 3; u.cb = 256 * (pn - 10); }
            return true; }
        const int L2 = L - 1792; if (L2 >= 768) return false;
        pg8::tile_of(L2, 6, 128, u.pm, u.pn);
        u.A = ws + WS_WB + ((size_t)l * WB_ROWS + (size_t)u.pm * 256) * DM * 2; u.B = XB + (size_t)u.pn * 256 * DM * 2;
        if (u.pm < 2) { u.type = 5; u.cb = 256 * u.pm; } else { u.type = 4; u.cb = 256 * (u.pm - 2); }
        return true;
    }
};
struct SchedMix {
    int G, c, l; const char* ws;
    __device__ __forceinline__ bool next(int i, Unit& u) const {
        const int L = i * G + c; if (L >= 256) return false;
        pg8::tile_of(L, 128, 2, u.pm, u.pn);
        u.type = 0; u.cb = 256 * u.pn; u.A = ws + WS_YG + (size_t)u.pm * 256 * 512 * 2; u.B = ws + WS_WGLU + ((size_t)l * 512 + (size_t)u.pn * 256) * 512 * 2;
        return true;
    }
};
struct SchedOut {
    int G, c, l; const char* ws;
    __device__ __forceinline__ bool next(int i, Unit& u) const {
        const int L = i * G + c; if (L >= 1024) return false;
        pg8::tile_of(L, 128, 8, u.pm, u.pn); u.type = 0; u.cb = 256 * u.pn;
        u.A = ws + WS_Y + (size_t)u.pm * 256 * DM * 2; u.B = ws + WS_WOUT + ((size_t)l * DM + (size_t)u.pn * 256) * DM * 2; return true;
    }
};

struct EpiIn {
    unsigned char* ws; int l; const LAS float* rtab; int rbase;
    __device__ __forceinline__ float rstd_of(int row) const { if (rbase < 0) { const u64* ssq = (const u64*)(ws + WS_SSQ) + (size_t)l * MTOK; return rsqrtf((float)ssq[row] * (1.0f / (SSQ_SCALE * (float)DM)) + RMS_EPS); } return rtab[row - rbase]; }
    __device__ __forceinline__ void operator()(const f32x4 (&acc)[2][2][4][2], const Unit& u, int wr, int wc, int fr, int fq) const {
        const int type = u.type;
        if (type >= 4) {
            const int col0 = u.pn * 256 + wc * 32 + 8 * fq;
            bf16_t* dstb = (bf16_t*)(ws + (type == 4 ? WS_GVT : WS_XA));
            unsigned long long* lns = (unsigned long long*)(ws + WS_LNS) + (size_t)l * MTOK * 2;
#pragma unroll
            for (int bj = 0; bj < 2; ++bj) {
                float cs[8], sm[8], sq[8];
#pragma unroll
                for (int e = 0; e < 8; ++e) { cs[e] = rstd_of(col0 + bj * 128 + e); sm[e] = 0.f; sq[e] = 0.f; }
#pragma unroll
                for (int ai = 0; ai < 2; ++ai)
#pragma unroll
                    for (int m = 0; m < 4; ++m) {
                        const int r = u.cb + ai * 128 + wr * 64 + m * 16 + fr; bf16_t* rowp = dstb + (size_t)r * MTOK + col0 + bj * 128;
                        const f32x4 v0 = acc[ai][bj][m][0], v1 = acc[ai][bj][m][1]; u32x4 w;
                        float e[8] = {v0[0] * cs[0], v0[1] * cs[1], v0[2] * cs[2], v0[3] * cs[3], v1[0] * cs[4], v1[1] * cs[5], v1[2] * cs[6], v1[3] * cs[7]};
                        if (type == 4) {
#pragma unroll
                            for (int k = 0; k < 8; ++k) { e[k] = gelu_f(e[k]); sm[k] += e[k]; sq[k] += e[k] * e[k]; } }
                        w.x = cvt_pk_bf16(e[0], e[1]); w.y = cvt_pk_bf16(e[2], e[3]); w.z = cvt_pk_bf16(e[4], e[5]); w.w = cvt_pk_bf16(e[6], e[7]);
                        *(u32x4*)rowp = w; __builtin_amdgcn_sched_barrier(0); }
                if (type == 4) {
#pragma unroll
                    for (int k = 0; k < 8; ++k) {
                        { sm[k] = row16_sum(sm[k]); sq[k] = row16_sum(sq[k]); } }
                    { float pick = 0.f;
#pragma unroll
                      for (int k = 0; k < 8; ++k) { pick = (fr == k) ? sm[k] : pick; pick = (fr == 8 + k) ? sq[k] : pick; }
                      atomicAdd(lns + (size_t)(col0 + bj * 128 + (fr & 7)) * 2 + (fr >> 3), (unsigned long long)(long long)(pick * LNS_SCALE)); } }
            }
            return;
        }
        const int row0 = u.pm * 256 + wr * 64 + fr, cw = wc * 32 + 8 * fq;
        if (type == 1) {
#pragma unroll
            for (int ai = 0; ai < 2; ++ai)
#pragma unroll
                for (int m = 0; m < 4; ++m) { const int row = row0 + ai * 128 + m * 16; const float rs = rstd_of(row);
                    const f32x4 a0 = acc[ai][0][m][0] * rs, a1 = acc[ai][0][m][1] * rs, g0 = acc[ai][1][m][0] * rs, g1 = acc[ai][1][m][1] * rs; u32x4 w;
                    w.x = cvt_pk_bf16(gelu_silu_f(a0[0], g0[0]), gelu_silu_f(a0[1], g0[1])); w.y = cvt_pk_bf16(gelu_silu_f(a0[2], g0[2]), gelu_silu_f(a0[3], g0[3]));
                    w.z = cvt_pk_bf16(gelu_silu_f(a1[0], g1[0]), gelu_silu_f(a1[1], g1[1])); w.w = cvt_pk_bf16(gelu_silu_f(a1[2], g1[2]), gelu_silu_f(a1[3], g1[3]));
                    *(u32x4*)((bf16_t*)(ws + WS_UG) + (size_t)row * 1024 + u.cb + cw) = w; }
            return;
        }
        bf16_t* base = (bf16_t*)(ws + (type == 2 ? WS_XC : WS_SG)); const int ld = type == 3 ? 1024 : 512;
#pragma unroll
        for (int ai = 0; ai < 2; ++ai)
#pragma unroll
            for (int m = 0; m < 4; ++m) { const int row = row0 + ai * 128 + m * 16; const float rs = rstd_of(row); bf16_t* rowp = base + (size_t)row * ld + u.cb + cw;
#pragma unroll
                for (int bj = 0; bj < 2; ++bj) { f32x4 v0 = acc[ai][bj][m][0] * rs, v1 = acc[ai][bj][m][1] * rs;
                    if (type == 3) {
#pragma unroll
                        for (int e = 0; e < 4; ++e) { v0[e] = silu_f(v0[e]); v1[e] = silu_f(v1[e]); } }
                    u32x4 w; w.x = cvt_pk_bf16(v0[0], v0[1]); w.y = cvt_pk_bf16(v0[2], v0[3]); w.z = cvt_pk_bf16(v1[0], v1[1]); w.w = cvt_pk_bf16(v1[2], v1[3]);
                    *(u32x4*)(rowp + bj * 128) = w; } }
    }
};
struct EpiMix {
    unsigned char* ws; int l;
    __device__ __forceinline__ void operator()(const f32x4 (&acc)[2][2][4][2], const Unit& u, int wr, int wc, int fr, int fq) const {
        const int row0 = u.pm * 256 + wr * 64 + fr, cw = u.cb + wc * 32 + 8 * fq;
        const bf16_t* YG = (const bf16_t*)(ws + WS_YG); const bf16_t* SG = (const bf16_t*)(ws + WS_SG); bf16_t* Y = (bf16_t*)(ws + WS_Y);
        const float* bglu = (const float*)(ws + WS_PAR) + PAR_BGLU + l * S5W; const float* pscale = (const float*)(ws + WS_PAR) + PAR_PSC + l * POOLW;
        f32x4 cv[2][2];
#pragma unroll
        for (int bj = 0; bj < 2; ++bj)
#pragma unroll
            for (int n = 0; n < 2; ++n) cv[bj][n] = *(const f32x4*)((u.type == 0 ? bglu : pscale) + cw + bj * 128 + 4 * n);
#pragma unroll
        for (int ai = 0; ai < 2; ++ai)
#pragma unroll
            for (int m = 0; m < 4; ++m) { const int row = row0 + ai * 128 + m * 16;
#pragma unroll
                for (int bj = 0; bj < 2; ++bj) { const int col = cw + bj * 128; const f32x4 a0 = acc[ai][bj][m][0], a1 = acc[ai][bj][m][1]; float o[8];
                    if (u.type == 0) {
                        const u32x4 yg = *(const u32x4*)(YG + (size_t)row * 512 + col), sg = *(const u32x4*)(SG + (size_t)row * 1024 + col);
                        o[0] = bf_lo(yg.x) * sigmoid_f(a0[0] + cv[bj][0][0]) * bf_lo(sg.x); o[1] = bf_hi(yg.x) * sigmoid_f(a0[1] + cv[bj][0][1]) * bf_hi(sg.x);
                        o[2] = bf_lo(yg.y) * sigmoid_f(a0[2] + cv[bj][0][2]) * bf_lo(sg.y); o[3] = bf_hi(yg.y) * sigmoid_f(a0[3] + cv[bj][0][3]) * bf_hi(sg.y);
                        o[4] = bf_lo(yg.z) * sigmoid_f(a1[0] + cv[bj][1][0]) * bf_lo(sg.z); o[5] = bf_hi(yg.z) * sigmoid_f(a1[1] + cv[bj][1][1]) * bf_hi(sg.z);
                        o[6] = bf_lo(yg.w) * sigmoid_f(a1[2] + cv[bj][1][2]) * bf_lo(sg.w); o[7] = bf_hi(yg.w) * sigmoid_f(a1[3] + cv[bj][1][3]) * bf_hi(sg.w);
                        u32x4 w; w.x = cvt_pk_bf16(o[0], o[1]); w.y = cvt_pk_bf16(o[2], o[3]); w.z = cvt_pk_bf16(o[4], o[5]); w.w = cvt_pk_bf16(o[6], o[7]);
                        *(u32x4*)(Y + (size_t)row * DM + col) = w;
                    } else {
                        const u32x4 sg = *(const u32x4*)(SG + (size_t)row * 1024 + 512 + col);
                        o[0] = a0[0] * cv[bj][0][0] * bf_lo(sg.x); o[1] = a0[1] * cv[bj][0][1] * bf_hi(sg.x); o[2] = a0[2] * cv[bj][0][2] * bf_lo(sg.y); o[3] = a0[3] * cv[bj][0][3] * bf_hi(sg.y);
                        o[4] = a1[0] * cv[bj][1][0] * bf_lo(sg.z); o[5] = a1[1] * cv[bj][1][1] * bf_hi(sg.z); o[6] = a1[2] * cv[bj][1][2] * bf_lo(sg.w); o[7] = a1[3] * cv[bj][1][3] * bf_hi(sg.w);
                        u32x4 w; w.x = cvt_pk_bf16(o[0], o[1]); w.y = cvt_pk_bf16(o[2], o[3]); w.z = cvt_pk_bf16(o[4], o[5]); w.w = cvt_pk_bf16(o[6], o[7]);
                        *(u32x4*)(Y + (size_t)row * DM + 1536 + col) = w;
                    } } }
    }
};
struct EpiOut {
    unsigned char* ws; int l; int do_ssq;
    __device__ __forceinline__ void operator()(const f32x4 (&acc)[2][2][4][2], const Unit& u, int wr, int wc, int fr, int fq) const {
        const int row0 = u.pm * 256 + wr * 64 + fr, cw = u.cb + wc * 32 + 8 * fq;
        bf16_t* XB = (bf16_t*)(ws + WS_XB); u64* ssq_next = (u64*)(ws + WS_SSQ) + (size_t)(l + 1) * MTOK;
        float pick[2] = {0.f, 0.f};
#pragma unroll
        for (int ai = 0; ai < 2; ++ai)
#pragma unroll
            for (int m = 0; m < 4; ++m) { const int row = row0 + ai * 128 + m * 16; float s = 0.f;
#pragma unroll
                for (int bj = 0; bj < 2; ++bj) { const size_t off = (size_t)row * DM + cw + bj * 128; const u32x4 xb = *(const u32x4*)(XB + off);
                    const f32x4 a0 = acc[ai][bj][m][0], a1 = acc[ai][bj][m][1];
                    const float v0 = bf_lo(xb.x) + a0[0], v1 = bf_hi(xb.x) + a0[1], v2 = bf_lo(xb.y) + a0[2], v3 = bf_hi(xb.y) + a0[3];
                    const float v4 = bf_lo(xb.z) + a1[0], v5 = bf_hi(xb.z) + a1[1], v6 = bf_lo(xb.w) + a1[2], v7 = bf_hi(xb.w) + a1[3];
                    u32x4 w; w.x = cvt_pk_bf16(v0, v1); w.y = cvt_pk_bf16(v2, v3); w.z = cvt_pk_bf16(v4, v5); w.w = cvt_pk_bf16(v6, v7);
                    *(u32x4*)(XB + off) = w;
                    s += (v0 * v0 + v1 * v1) + (v2 * v2 + v3 * v3) + (v4 * v4 + v5 * v5) + (v6 * v6 + v7 * v7); }
                s = xor32_add(xor16_add(s));
                pick[ai] = (fq == m) ? s : pick[ai]; }
        if (do_ssq) {
#pragma unroll
            for (int ai = 0; ai < 2; ++ai) atomicAdd(ssq_next + row0 + ai * 128 + fq * 16, (u64)(pick[ai] * SSQ_SCALE)); }
    }
};

#define XB_TMO      128
#define XB_XCNT(j)  (256  + 64 * (j))
#define XB_XSUB(j)  (1280 + 64 * (j))
#define XB_XGEN(j)  (2304 + 64 * (j))
#define XB_TOP      3328
#define XB_TOPGEN   3392
#define XCD_BAR_WORDS 3456
#define XB_SPIN_CAP (1u << 18)
__device__ __forceinline__ unsigned xb_ld(unsigned* p)              { return __hip_atomic_load(p, __ATOMIC_RELAXED, __HIP_MEMORY_SCOPE_AGENT); }
__device__ __forceinline__ unsigned xb_add(unsigned* p, unsigned v) { return __hip_atomic_fetch_add(p, v, __ATOMIC_RELAXED, __HIP_MEMORY_SCOPE_AGENT); }
__device__ __forceinline__ unsigned xb_xcc_id() { return (unsigned)__builtin_amdgcn_s_getreg((3 << 11) | 20) & 0xFu; }
#define XB_SPIN(cond, bar) do { unsigned _sp = 0; while (cond) { __builtin_amdgcn_s_sleep(1); \
    if ((++_sp & 255u) == 0u) { if (xb_ld(&(bar)[XB_TMO])) break; if (_sp > XB_SPIN_CAP) { atomicAdd(&(bar)[XB_TMO], 1u); break; } } } } while (0)
struct XcdBarrier { unsigned* bar; unsigned x; volatile LAS unsigned* st; };
__device__ __forceinline__ XcdBarrier xcd_barrier_post(unsigned* bar, volatile LAS unsigned* st) {
    XcdBarrier b; b.bar = bar; b.x = xb_xcc_id(); b.st = st;
    if (threadIdx.x == 0) (void)xb_add(&bar[XB_XCNT(b.x)], 1u);
    return b;
}
__device__ __forceinline__ void xcd_barrier_complete(unsigned* bar, unsigned x, unsigned& nloc, unsigned& nx) {
    const unsigned G = gridDim.x * gridDim.y * gridDim.z;
    unsigned sum, cnt, mine, sp = 0u;
    for (;;) {
        sum = 0u; cnt = 0u; mine = 0u;
#pragma unroll
        for (unsigned j = 0; j < 16; ++j) { const unsigned c = xb_ld(&bar[XB_XCNT(j)]); sum += c; cnt += (c > 0u) ? 1u : 0u; mine = (j == x) ? c : mine; }
        if (sum == G) break;
        __builtin_amdgcn_s_sleep(1);
        if ((++sp & 255u) == 0u) { if (xb_ld(&bar[XB_TMO])) break; if (sp > XB_SPIN_CAP) { atomicAdd(&bar[XB_TMO], 1u); break; } }
    }
    nloc = mine > 0u ? mine : 1u; nx = cnt > 0u ? cnt : 1u;
}
__device__ __forceinline__ void xcd_barrier(const XcdBarrier& b) {
    asm volatile("s_waitcnt vmcnt(0)" ::: "memory");
    __syncthreads();
    if (threadIdx.x == 0) {
        unsigned* bar = b.bar;
        __builtin_amdgcn_s_waitcnt(0);
        unsigned nloc = b.st[0], nx = b.st[1];
        if (nloc == 0u) { xcd_barrier_complete(bar, b.x, nloc, nx); b.st[0] = nloc; b.st[1] = nx; }
        const unsigned old = xb_add(&bar[XB_XSUB(b.x)], 1u);
        const unsigned gen = old / nloc;
        if (old + 1u == (gen + 1u) * nloc) {
            __builtin_amdgcn_fence(__ATOMIC_RELEASE, "agent");
            asm volatile("s_waitcnt vmcnt(0)" ::: "memory");
            const unsigned og = xb_add(&bar[XB_TOP], 1u);
            const unsigned tg = og / nx;
            if (og + 1u == (tg + 1u) * nx) xb_add(&bar[XB_TOPGEN], 1u);
            else XB_SPIN(xb_ld(&bar[XB_TOPGEN]) == tg, bar);
            __builtin_amdgcn_fence(__ATOMIC_ACQUIRE, "agent");
            xb_add(&bar[XB_XGEN(b.x)], 1u);
            asm volatile("s_waitcnt vmcnt(0)" ::: "memory");
        } else {
            XB_SPIN(xb_ld(&bar[XB_XGEN(b.x)]) == gen, bar);
            __builtin_amdgcn_fence(__ATOMIC_ACQUIRE, "agent");
            asm volatile("s_waitcnt vmcnt(0)" ::: "memory");
        }
    }
    __syncthreads();
}

constexpr int NWAVES = 8, NTHR = 512;
constexpr int RING_BYTES = 131072, LDS_BYTES = 163840, LDSCTL_OFF = LDS_BYTES - 512;
struct Args { const float* in[21]; float* out; unsigned char* ws; int ph_lo, ph_hi; };
struct Frame {
    LAS unsigned char* lds; int tid, lane, wave, vcu, G, gw, NGW; unsigned char* ws;
};
__device__ __forceinline__ Frame mkframe(unsigned char* ws, LAS unsigned char* lds, int wave_s) {
    Frame F; int tid; asm volatile("v_mbcnt_lo_u32_b32 %0, -1, 0\n\tv_mbcnt_hi_u32_b32 %0, -1, %0" : "=v"(tid)); tid |= wave_s << 6; int bx = blockIdx.x, G = gridDim.x; asm volatile("" : "+s"(bx), "+s"(G));
    F.lds = lds; F.tid = tid; F.lane = tid & 63; F.wave = __builtin_amdgcn_readfirstlane(tid >> 6);
    F.G = G; F.vcu = (G % 8 == 0) ? (bx % 8) * (G / 8) + bx / 8 : bx;
    F.gw = F.vcu * 8 + F.wave; F.NGW = G * 8; F.ws = ws; return F;
}
#define MFMA16(a, b, c) __builtin_amdgcn_mfma_f32_16x16x32_bf16((a), (b), (c), 0, 0, 0)

constexpr int P0_SCR = 64 * 65 * 4;
struct TItem { const float* W; const float* gk; bf16_t* WT; int K, N, k0, n0src, rowdst; };
__device__ __forceinline__ void t_load(const TItem& d, int lane, f32x4 (&vv)[16]) {
    const int c4 = lane & 15, rsub = lane >> 4;
#pragma unroll
    for (int i = 0; i < 16; ++i) vv[i] = __builtin_nontemporal_load((const f32x4*)(d.W + (size_t)(d.k0 + 4 * i + rsub) * d.N + d.n0src + 4 * c4));
}
__device__ __forceinline__ void t_finish(const TItem& d, const f32x4 (&vv)[16], LAS float* scr, int lane) {
    const int c4 = lane & 15, rsub = lane >> 4;
#pragma unroll
    for (int i = 0; i < 16; ++i) { const int kk = 4 * i + rsub; f32x4 v = vv[i]; if (d.gk) v = v * d.gk[d.k0 + kk];
        scr[(4 * c4 + 0) * 65 + kk] = v[0]; scr[(4 * c4 + 1) * 65 + kk] = v[1]; scr[(4 * c4 + 2) * 65 + kk] = v[2]; scr[(4 * c4 + 3) * 65 + kk] = v[3]; }
    asm volatile("s_waitcnt lgkmcnt(0)" ::: "memory");
    const int ck = lane & 7;
#pragma unroll
    for (int j = 0; j < 8; ++j) { const int n = 8 * j + (lane >> 3); const LAS float* s = scr + n * 65 + 8 * ck;
        u32x4 o; o.x = cvt_pk_bf16(s[0], s[1]); o.y = cvt_pk_bf16(s[2], s[3]); o.z = cvt_pk_bf16(s[4], s[5]); o.w = cvt_pk_bf16(s[6], s[7]);
        *(u32x4*)(d.WT + (size_t)(d.rowdst + n) * d.K + d.k0 + 8 * ck) = o; }
    asm volatile("s_waitcnt lgkmcnt(0)" ::: "memory");
}
__device__ __forceinline__ void win_map(int s, int& isB, int& row) {
    isB = 0;
    if (s < 512) { isB = 1; row = s; }
    else if (s < 1536) { const int j = (s - 512) >> 7, i = (s - 512) & 127; row = 256 * j + i; }
    else if (s < 2560) { isB = 1; row = 512 + (s - 1536); }
    else if (s < 3072) row = 2048 + (s - 2560);
    else if (s < 3584) row = 2560 + (s - 3072);
    else if (s < 4608) { const int j = (s - 3584) >> 7, i = (s - 3584) & 127; row = 256 * j + 128 + i; }
    else row = 3072 + (s - 4608);
}
__device__ __forceinline__ void p0_prologue(const Frame& F, const Args& a) {
    const float* x = a.in[0]; const float* norm_g = a.in[1]; const float* w_in = a.in[2];
    const float *lam_re = a.in[3], *lam_im = a.in[4], *b_re = a.in[5], *b_im = a.in[6], *log_dt = a.in[10];
    const float *w_glu = a.in[11], *w_s = a.in[15], *w_pool = a.in[17], *w_out = a.in[19];
    unsigned char* ws = F.ws;
    LAS float* scr = (LAS float*)(F.lds + F.wave * P0_SCR);
    constexpr int I_IN = 32 * 72, I_Q = 32 * 16, I_OUT = 32 * 32, I_GLU = 8 * 8, I_T = I_IN + I_OUT + I_GLU;
    for (int it = F.gw; it < 2 * I_Q; it += F.NGW) {
        const int l = it / I_Q, r = it - l * I_Q;
        const int kb = r >> 4, nb = r & 15, dq = 32 * nb, g = dq >> 7, k0 = 64 * kb, cc = F.lane & 15, qq = F.lane >> 4, row = 2048 + dq;
        bf16_t* WT = (bf16_t*)(ws + WS_WA) + (size_t)l * WA_ROWS * DM;
        f32x4 accq[4][2];
#pragma unroll
        for (int mt = 0; mt < 4; ++mt) { accq[mt][0] = (f32x4){0.f, 0.f, 0.f, 0.f}; accq[mt][1] = (f32x4){0.f, 0.f, 0.f, 0.f}; }
#pragma unroll
        for (int ks = 0; ks < 4; ++ks) {
            bf16x8 bq[2];
#pragma unroll
            for (int nt = 0; nt < 2; ++nt) { const float* wp = w_pool + (((size_t)l * 4 + g) * 128 + 32 * ks + 8 * qq) * 128 + (dq & 127) + 16 * nt + cc; u32x4 p;
                p.x = pk_bf16_c(wp[0], wp[128]); p.y = pk_bf16_c(wp[256], wp[384]); p.z = pk_bf16_c(wp[512], wp[640]); p.w = pk_bf16_c(wp[768], wp[896]); bq[nt] = __builtin_bit_cast(bf16x8, p); }
#pragma unroll
            for (int mt = 0; mt < 4; ++mt) { const int k = k0 + 16 * mt + cc; const float gs = norm_g[l * DM + k];
                const f32x4* ap = (const f32x4*)(w_in + ((size_t)l * DM + k) * INC + 2560 + 128 * g + 32 * ks + 8 * qq); const f32x4 a0 = ap[0] * gs, a1 = ap[1] * gs; u32x4 p;
                p.x = pk_bf16_c(a0[0], a0[1]); p.y = pk_bf16_c(a0[2], a0[3]); p.z = pk_bf16_c(a1[0], a1[1]); p.w = pk_bf16_c(a1[2], a1[3]); const bf16x8 aq = __builtin_bit_cast(bf16x8, p);
                accq[mt][0] = MFMA16(aq, bq[0], accq[mt][0]); accq[mt][1] = MFMA16(aq, bq[1], accq[mt][1]); } }
#pragma unroll
        for (int mt = 0; mt < 4; ++mt)
#pragma unroll
            for (int nt = 0; nt < 2; ++nt) { u32x2 o; o.x = pk_bf16_c(accq[mt][nt][0], accq[mt][nt][1]); o.y = pk_bf16_c(accq[mt][nt][2], accq[mt][nt][3]);
                *(u32x2*)(WT + (size_t)(row + 16 * nt + cc) * DM + k0 + 16 * mt + 4 * qq) = o; }
    }
    {
#define T_DECODE(t_, d_) do { int r_ = (t_); const int l_ = r_ / I_T; r_ -= l_ * I_T; \
        if (r_ < I_IN) { const int kb_ = r_ / 72, j_ = r_ % 72, sb_ = 64 * (j_ < 40 ? j_ : j_ + 8); int isB_, row_; win_map(sb_, isB_, row_); \
            d_.W = w_in + (size_t)l_ * DM * INC; d_.gk = norm_g + l_ * DM; d_.WT = isB_ ? (bf16_t*)(ws + WS_WB) + (size_t)l_ * WB_ROWS * DM : (bf16_t*)(ws + WS_WA) + (size_t)l_ * WA_ROWS * DM; \
            d_.K = DM; d_.N = INC; d_.k0 = 64 * kb_; d_.n0src = sb_; d_.rowdst = row_; } \
        else if (r_ < I_IN + I_OUT) { r_ -= I_IN; d_.W = w_out + (size_t)l_ * DM * DM; d_.gk = nullptr; d_.WT = (bf16_t*)(ws + WS_WOUT) + (size_t)l_ * DM * DM; d_.K = DM; d_.N = DM; d_.k0 = 64 * (r_ >> 5); d_.n0src = 64 * (r_ & 31); d_.rowdst = d_.n0src; } \
        else { r_ -= I_IN + I_OUT; d_.W = w_glu + (size_t)l_ * 512 * 512; d_.gk = nullptr; d_.WT = (bf16_t*)(ws + WS_WGLU) + (size_t)l_ * 512 * 512; d_.K = 512; d_.N = 512; d_.k0 = 64 * (r_ >> 3); d_.n0src = 64 * (r_ & 7); d_.rowdst = d_.n0src; } } while (0)
        constexpr int NT = 2 * I_T;
        int t = (F.gw + F.NGW / 2) % F.NGW; TItem dA, dB; f32x4 vA[16], vB[16];
        bool hasA = t < NT; if (hasA) { T_DECODE(t, dA); t_load(dA, F.lane, vA); }
        while (hasA) {
            const int t2 = t + F.NGW; const bool hasB = t2 < NT; if (hasB) { T_DECODE(t2, dB); t_load(dB, F.lane, vB); }
            t_finish(dA, vA, scr, F.lane);
            if (!hasB) break;
            const int t3 = t2 + F.NGW; hasA = t3 < NT; if (hasA) { T_DECODE(t3, dA); t_load(dA, F.lane, vA); }
            t_finish(dB, vB, scr, F.lane);
            t = t3;
        }
#undef T_DECODE
    }
    { bf16_t* XB = (bf16_t*)(ws + WS_XB); u64* ssq0 = (u64*)(ws + WS_SSQ);
      for (int m2 = F.gw; m2 < MTOK / 2; m2 += F.NGW) {
          f32x4 v[2][4][2];
#pragma unroll
          for (int rr = 0; rr < 2; ++rr) { const f32x4* xr = (const f32x4*)(x + (size_t)(2 * m2 + rr) * DM) + 2 * F.lane;
#pragma unroll
              for (int j = 0; j < 4; ++j) { v[rr][j][0] = __builtin_nontemporal_load(xr + 128 * j); v[rr][j][1] = __builtin_nontemporal_load(xr + 128 * j + 1); } }
#pragma unroll
          for (int rr = 0; rr < 2; ++rr) { u32x4* o = (u32x4*)(XB + (size_t)(2 * m2 + rr) * DM) + F.lane; float s = 0.f;
#pragma unroll
              for (int j = 0; j < 4; ++j) { const f32x4 a = v[rr][j][0], b = v[rr][j][1];
                  s += (a[0] * a[0] + a[1] * a[1]) + (a[2] * a[2] + a[3] * a[3]) + (b[0] * b[0] + b[1] * b[1]) + (b[2] * b[2] + b[3] * b[3]);
                  u32x4 w; w.x = cvt_pk_bf16(a[0], a[1]); w.y = cvt_pk_bf16(a[2], a[3]); w.z = cvt_pk_bf16(b[0], b[1]); w.w = cvt_pk_bf16(b[2], b[3]); o[64 * j] = w; }
              s = wave_sum(s);
              if (F.lane == 0) ssq0[2 * m2 + rr] = (u64)(s * SSQ_SCALE); }
      } }
    const int gt = F.vcu * NTHR + F.tid, NGT = F.G * NTHR;
    { u64* ssq = (u64*)(ws + WS_SSQ) + MTOK; for (int i = gt; i < 2 * MTOK; i += NGT) ssq[i] = 0ull;
      u64* lns = (u64*)(ws + WS_LNS); for (int i = gt; i < 2 * MTOK * 2; i += NGT) lns[i] = 0ull; }
    { float* PAR = (float*)(ws + WS_PAR);
      for (int i = gt; i < PAR_N; i += NGT) { float v;
          if (i < PAR_LNG) v = a.in[12][i - PAR_BGLU]; else if (i < PAR_LNB) v = a.in[13][i - PAR_LNG]; else if (i < PAR_BS) v = a.in[14][i - PAR_LNB];
          else if (i < PAR_PSC) v = a.in[16][i - PAR_BS]; else if (i < PAR_FG) v = a.in[18][i - PAR_PSC]; else v = a.in[20][i - PAR_FG];
          PAR[i] = v; } }
    { bf16_t* WSG = (bf16_t*)(ws + WS_WSG);
      for (int i = gt; i < 2 * 8 * 128 * 128; i += NGT) { const int s = i & 127, t = (i >> 7) & 127; WSG[i] = (bf16_t)(cvt_pk_bf16(s <= t ? w_s[i] : 0.f, 0.f) & 0xffffu); }
    }
    { f32x2* POW = (f32x2*)(ws + WS_POW); f32x2* BBAR = (f32x2*)(ws + WS_BBAR);
      for (int e = gt; e < 2 * S5G * S5P * 17; e += NGT) { const int i = e / 17, n = e - 17 * i; const double dt = exp((double)log_dt[i >> 6]);
          const double mg = exp((double)lam_re[i] * dt * n), th = (double)lam_im[i] * dt * n; POW[e] = (f32x2){(float)(mg * cos(th)), (float)(mg * sin(th))}; }
      for (int i = gt; i < 2 * S5G * S5P; i += NGT) { const int lg = i >> 6;
          const double dt = exp((double)log_dt[lg]), lr = (double)lam_re[i], li = (double)lam_im[i];
          const double mg = exp(lr * dt), th = li * dt, nr = mg * cos(th) - 1.0, ni = mg * sin(th), den = lr * lr + li * li;
          const double qr = (nr * lr + ni * li) / den, qi = (ni * lr - nr * li) / den;
          for (int h = 0; h < 16; ++h) { const double br = (double)b_re[(size_t)i * 16 + h], bi = (double)b_im[(size_t)i * 16 + h];
              BBAR[(size_t)i * 16 + h] = (f32x2){(float)(qr * br - qi * bi), (float)(qr * bi + qi * br)}; } } }
}
__device__ __forceinline__ void s5_tables_a(const Frame& F, const Args& a) {
    const float *c_re = a.in[7], *c_im = a.in[8], *d_skip = a.in[9];
    unsigned char* ws = F.ws; const f32x2* POW = (const f32x2*)(ws + WS_POW); const f32x2* BBAR = (const f32x2*)(ws + WS_BBAR);
    const int gt = F.vcu * NTHR + F.tid, NGT = F.G * NTHR;
    float* KT = (float*)(ws + WS_KT);
    for (int i = gt; i < 2 * S5G * 16 * 256; i += NGT) {
        const int h2 = i & 15, h = (i >> 4) & 15, d = (i >> 8) & 15, lg = i >> 12; float s = 0.f;
        for (int p = 0; p < 64; ++p) { const f32x2 pw = POW[((size_t)lg * 64 + p) * 17 + d], bb = BBAR[((size_t)lg * 64 + p) * 16 + h2];
            const float cr = c_re[((size_t)lg * 16 + h) * 64 + p], ci = c_im[((size_t)lg * 16 + h) * 64 + p];
            const float zr = pw.x * bb.x - pw.y * bb.y, zi = pw.x * bb.y + pw.y * bb.x; s += cr * zr - ci * zi; }
        if (d == 0 && h == h2) s += d_skip[lg * 16 + h];
        KT[i] = s; }
    bf16_t* WEND = (bf16_t*)(ws + WS_WEND);
    for (int i = gt; i < 2 * S5G * 128 * 256; i += NGT) {
        const int t = i & 15, h = (i >> 4) & 15, p2 = (i >> 8) & 127, lg = i >> 15, p = p2 & 63;
        const f32x2 pw = POW[((size_t)lg * 64 + p) * 17 + (15 - t)], bb = BBAR[((size_t)lg * 64 + p) * 16 + h];
        const float v = p2 < 64 ? pw.x * bb.x - pw.y * bb.y : pw.x * bb.y + pw.y * bb.x;
        WEND[i] = (bf16_t)(cvt_pk_bf16(v, 0.f) & 0xffffu); }
    bf16_t* WS5 = (bf16_t*)(ws + WS_WS5);
    for (int i = gt; i < 2 * S5G * 256 * 128; i += NGT) {
        const int p2 = i & 127, row = (i >> 7) & 255, lg = i >> 15, p = p2 & 63, rr = row >> 4, t = 4 * (rr >> 2) + ((row >> 2) & 3), h = 4 * (rr & 3) + (row & 3);
        const f32x2 pw = POW[((size_t)lg * 64 + p) * 17 + (t + 1)];
        const float cr = c_re[((size_t)lg * 16 + h) * 64 + p], ci = c_im[((size_t)lg * 16 + h) * 64 + p];
        const float v = p2 < 64 ? cr * pw.x - ci * pw.y : -(cr * pw.y + ci * pw.x);
        WS5[((size_t)lg * 256 + row) * 384 + 256 + p2] = (bf16_t)(cvt_pk_bf16(v, 0.f) & 0xffffu); }
}
__device__ __forceinline__ void s5_tables_b(const Frame& F) {
    unsigned char* ws = F.ws; const float* KT = (const float*)(ws + WS_KT); bf16_t* WS5 = (bf16_t*)(ws + WS_WS5);
    const int gt = F.vcu * NTHR + F.tid, NGT = F.G * NTHR;
    for (int i = gt; i < 2 * S5G * 256 * 256; i += NGT) {
        const int k = i & 255, row = (i >> 8) & 255, lg = i >> 16, rr = row >> 4, t = 4 * (rr >> 2) + ((row >> 2) & 3), h = 4 * (rr & 3) + (row & 3), h2 = k >> 4, t2 = k & 15;
        const float v = t2 <= t ? KT[(((size_t)lg * 16 + (t - t2)) * 16 + h) * 16 + h2] : 0.f;
        WS5[((size_t)lg * 256 + row) * 384 + k] = (bf16_t)(cvt_pk_bf16(v, 0.f) & 0xffffu); }
}

__device__ __forceinline__ void p2_ln(const Frame& F, const float* ln_g, const float* ln_b, bf16_t* DST) {
    bf16_t* GVT = (bf16_t*)(F.ws + WS_GVT);
    LAS float* red = (LAS float*)F.lds;
    LAS float* stat = (LAS float*)(F.lds + 32768);
    const int o = F.tid & 15, r0 = F.tid >> 4;
    for (int c = F.vcu; c < MTOK / 128; c += F.G) {
        bf16_t* gp = GVT + (size_t)r0 * MTOK + c * 128 + 8 * o; bf16_t* dp = DST + (size_t)r0 * MTOK + c * 128 + 8 * o;
        float s[8], q[8];
#pragma unroll
        for (int j = 0; j < 8; ++j) { s[j] = 0.f; q[j] = 0.f; }
#pragma unroll 4
        for (int i = 0; i < 32; ++i) { const u32x4 v = *(const u32x4*)(gp + (size_t)(32 * i) * MTOK);
            const float e0 = bf_lo(v.x), e1 = bf_hi(v.x), e2 = bf_lo(v.y), e3 = bf_hi(v.y), e4 = bf_lo(v.z), e5 = bf_hi(v.z), e6 = bf_lo(v.w), e7 = bf_hi(v.w);
            s[0] += e0; q[0] += e0 * e0; s[1] += e1; q[1] += e1 * e1; s[2] += e2; q[2] += e2 * e2; s[3] += e3; q[3] += e3 * e3;
            s[4] += e4; q[4] += e4 * e4; s[5] += e5; q[5] += e5 * e5; s[6] += e6; q[6] += e6 * e6; s[7] += e7; q[7] += e7 * e7; }
#pragma unroll
        for (int j = 0; j < 8; ++j) { red[(r0 * 128 + 8 * o + j) * 2] = s[j]; red[(r0 * 128 + 8 * o + j) * 2 + 1] = q[j]; }
        __syncthreads();
        if (F.tid < 128) { float ss = 0.f, qq = 0.f;
            for (int r = 0; r < 32; ++r) { ss += red[(r * 128 + F.tid) * 2]; qq += red[(r * 128 + F.tid) * 2 + 1]; }
            const float mean = ss * (1.0f / 1024.0f), var = fmaxf(qq * (1.0f / 1024.0f) - mean * mean, 0.f);
            stat[F.tid * 2] = mean; stat[F.tid * 2 + 1] = rsqrtf(var + LN_EPS); }
        __syncthreads();
        float mu[8], rs[8];
#pragma unroll
        for (int j = 0; j < 8; ++j) { mu[j] = stat[(8 * o + j) * 2]; rs[j] = stat[(8 * o + j) * 2 + 1]; }
#pragma unroll 4
        for (int i = 0; i < 32; ++i) { const int ch = 32 * i + r0; const float g = ln_g[ch], b = ln_b[ch]; const u32x4 v = *(const u32x4*)(gp + (size_t)(32 * i) * MTOK); u32x4 w;
            w.x = cvt_pk_bf16((bf_lo(v.x) - mu[0]) * rs[0] * g + b, (bf_hi(v.x) - mu[1]) * rs[1] * g + b);
            w.y = cvt_pk_bf16((bf_lo(v.y) - mu[2]) * rs[2] * g + b, (bf_hi(v.y) - mu[3]) * rs[3] * g + b);
            w.z = cvt_pk_bf16((bf_lo(v.z) - mu[4]) * rs[4] * g + b, (bf_hi(v.z) - mu[5]) * rs[5] * g + b);
            w.w = cvt_pk_bf16((bf_lo(v.w) - mu[6]) * rs[6] * g + b, (bf_hi(v.w) - mu[7]) * rs[7] * g + b);
            *(u32x4*)(dp + (size_t)(32 * i) * MTOK) = w; }
        __syncthreads();
    }
}
constexpr int SGU_ROWB = 272;
constexpr int SGU_TILE = 128 * SGU_ROWB;
__device__ __forceinline__ void m1_sgu(const Frame& F, int layer) {
    const bf16_t* GVT = (const bf16_t*)(F.ws + WS_GVT); const bf16_t* UG = (const bf16_t*)(F.ws + WS_UG); bf16_t* Y = (bf16_t*)(F.ws + WS_Y);
    const bf16_t* WSG = (const bf16_t*)(F.ws + WS_WSG) + (size_t)layer * 8 * 128 * 128;
    const float* PAR = (const float*)(F.ws + WS_PAR);
    const float* ln_g = PAR + PAR_LNG + layer * SGUW; const float* ln_b = PAR + PAR_LNB + layer * SGUW; const float* b_s = PAR + PAR_BS + layer * 1024;
    const long long* lns = (const long long*)(F.ws + WS_LNS) + (size_t)layer * MTOK * 2;
    LAS unsigned char* tiles = F.lds;
    const int o = F.tid & 15, r0 = F.tid >> 4, c = F.lane & 15, q = F.lane >> 4, w = F.wave;
    for (int ch = F.vcu; ch < MTOK / 128; ch += F.G) {
        const bf16_t* gp = GVT + (size_t)r0 * MTOK + ch * 128 + 8 * o;
        float mu[8], rs[8];
#pragma unroll
        for (int j = 0; j < 8; ++j) { const long long* sp = lns + (size_t)(ch * 128 + 8 * o + j) * 2; const float mean = (float)sp[0] * (1.0f / (LNS_SCALE * 1024.0f)), ex2 = (float)sp[1] * (1.0f / (LNS_SCALE * 1024.0f));
            mu[j] = mean; rs[j] = rsqrtf(fmaxf(ex2 - mean * mean, 0.f) + LN_EPS); }
        u32x4 stg[2][4]; bf16x8 wcur[2][4];
#pragma unroll
        for (int hh = 0; hh < 2; ++hh) { const int t0n = 16 * ((w + hh) & 7);
#pragma unroll
            for (int i = 0; i < 4; ++i) stg[hh][i] = __builtin_nontemporal_load((const u32x4*)(gp + (size_t)(hh * 128 + 32 * i) * MTOK));
#pragma unroll
            for (int ks = 0; ks < 4; ++ks) wcur[hh][ks] = *(const bf16x8*)(WSG + ((size_t)hh * 128 + t0n + c) * 128 + 8 * q + 32 * ks); }
#pragma unroll 1
        for (int hp = 0; hp < 4; ++hp) {
#pragma unroll
            for (int hh = 0; hh < 2; ++hh) { LAS unsigned char* tile = tiles + ((hp & 1) * 2 + hh) * SGU_TILE; const int h = 2 * hp + hh;
#pragma unroll
                for (int i = 0; i < 4; ++i) { const int d = r0 + 32 * i, chn = h * 128 + d, rho = 16 * (2 * (d >> 5) + ((d >> 2) & 1)) + 4 * ((d >> 3) & 3) + (d & 3); const float g = ln_g[chn], b = ln_b[chn]; const u32x4 sv = stg[hh][i]; u32x4 wv;
                    wv.x = cvt_pk_bf16((bf_lo(sv.x) - mu[0]) * rs[0] * g + b, (bf_hi(sv.x) - mu[1]) * rs[1] * g + b);
                    wv.y = cvt_pk_bf16((bf_lo(sv.y) - mu[2]) * rs[2] * g + b, (bf_hi(sv.y) - mu[3]) * rs[3] * g + b);
                    wv.z = cvt_pk_bf16((bf_lo(sv.z) - mu[4]) * rs[4] * g + b, (bf_hi(sv.z) - mu[5]) * rs[5] * g + b);
                    wv.w = cvt_pk_bf16((bf_lo(sv.w) - mu[6]) * rs[6] * g + b, (bf_hi(sv.w) - mu[7]) * rs[7] * g + b);
                    *(LAS u32x4*)(tile + rho * SGU_ROWB + 16 * o) = wv; } }
            u32x4 ugv[2][4];
#pragma unroll
            for (int hh = 0; hh < 2; ++hh) { const int h = 2 * hp + hh, m = ch * 128 + 16 * ((w + h) & 7) + c;
#pragma unroll
                for (int j = 0; j < 4; ++j) ugv[hh][j] = __builtin_nontemporal_load((const u32x4*)(UG + (size_t)m * 1024 + h * 128 + 32 * j + 8 * q)); }
            if (hp < 3) {
#pragma unroll
                for (int hh = 0; hh < 2; ++hh) { const int h = 2 * (hp + 1) + hh;
#pragma unroll
                    for (int i = 0; i < 4; ++i) stg[hh][i] = __builtin_nontemporal_load((const u32x4*)(gp + (size_t)(h * 128 + 32 * i) * MTOK)); } }
            __syncthreads();
            f32x4 acc[2][8];
#pragma unroll
            for (int hh = 0; hh < 2; ++hh) { const int h = 2 * hp + hh, tt = (w + h) & 7, nks = (tt >> 1) + 1;
                const LAS unsigned char* ab = tiles + ((hp & 1) * 2 + hh) * SGU_TILE + c * SGU_ROWB + 16 * q;
#pragma unroll
                for (int r = 0; r < 8; ++r) acc[hh][r] = (f32x4){0.f, 0.f, 0.f, 0.f};
#pragma unroll
                for (int ks = 0; ks < 4; ++ks) { if (ks < nks) {
#pragma unroll
                    for (int r = 0; r < 8; ++r) { const bf16x8 av = *(const LAS bf16x8*)(ab + (16 * r) * SGU_ROWB + 64 * ks); acc[hh][r] = MFMA16(av, wcur[hh][ks], acc[hh][r]); } } } }
            if (hp < 3) {
#pragma unroll
                for (int hh = 0; hh < 2; ++hh) { const int h = 2 * (hp + 1) + hh, t0n = 16 * ((w + h) & 7);
#pragma unroll
                    for (int ks = 0; ks < 4; ++ks) wcur[hh][ks] = *(const bf16x8*)(WSG + ((size_t)h * 128 + t0n + c) * 128 + 8 * q + 32 * ks); } }
#pragma unroll
            for (int hh = 0; hh < 2; ++hh) { const int h = 2 * hp + hh, t0 = 16 * ((w + h) & 7), m = ch * 128 + t0 + c;
                const float bs = b_s[h * 128 + t0 + c];
#pragma unroll
                for (int j = 0; j < 4; ++j) { const int col = h * 128 + 32 * j + 8 * q; const u32x4 ug = ugv[hh][j]; u32x4 wv;
                    wv.x = cvt_pk_bf16((acc[hh][2 * j][0] + bs) * bf_lo(ug.x), (acc[hh][2 * j][1] + bs) * bf_hi(ug.x)); wv.y = cvt_pk_bf16((acc[hh][2 * j][2] + bs) * bf_lo(ug.y), (acc[hh][2 * j][3] + bs) * bf_hi(ug.y));
                    wv.z = cvt_pk_bf16((acc[hh][2 * j + 1][0] + bs) * bf_lo(ug.z), (acc[hh][2 * j + 1][1] + bs) * bf_hi(ug.z)); wv.w = cvt_pk_bf16((acc[hh][2 * j + 1][2] + bs) * bf_lo(ug.w), (acc[hh][2 * j + 1][3] + bs) * bf_hi(ug.w));
                    *(u32x4*)(Y + (size_t)m * DM + 512 + col) = wv; } }
        }
        __syncthreads();
    }
}
constexpr int WE_ROWB = 528;
__device__ __forceinline__ void m1_send(const Frame& F, int layer) {
    const bf16_t* WEND = (const bf16_t*)(F.ws + WS_WEND) + (size_t)layer * S5G * 128 * 256;
    const bf16_t* XAT = (const bf16_t*)(F.ws + WS_XA); float* SE = (float*)(F.ws + WS_SE);
    const int c = F.lane & 15, q = F.lane >> 4, w = F.wave;
    for (int it = F.vcu; it < S5G * 8; it += F.G) {
        const int g = it & 31, rg = it >> 5;
        const bf16_t* xb = XAT + (size_t)(16 * g + (q >> 1)) * MTOK + 8 * (q & 1);
        bf16x8 bx[2][8];
#pragma unroll
        for (int s = 0; s < 2; ++s)
#pragma unroll
            for (int ks = 0; ks < 8; ++ks) bx[s][ks] = *(const bf16x8*)(xb + (size_t)(2 * ks) * MTOK + (size_t)((16 * rg + 2 * w + s) * 16 + c) * 16);
#pragma unroll
        for (int i = 0; i < 8; ++i) { const int e = F.tid + 512 * i, row = e >> 5, ch = e & 31;
            *(LAS u32x4*)(F.lds + row * WE_ROWB + 16 * ch) = *(const u32x4*)(WEND + ((size_t)g * 128 + row) * 256 + 8 * ch); }
        __syncthreads();
#pragma unroll
        for (int s = 0; s < 2; ++s) { const int seg = (16 * rg + 2 * w + s) * 16 + c;
#pragma unroll
            for (int r = 0; r < 8; ++r) { f32x4 acc = (f32x4){0.f, 0.f, 0.f, 0.f};
#pragma unroll
                for (int ks = 0; ks < 8; ++ks) { const bf16x8 aw = *(const LAS bf16x8*)(F.lds + (16 * r + c) * WE_ROWB + 64 * ks + 16 * q); acc = MFMA16(aw, bx[s][ks], acc); }
                *(f32x4*)(SE + ((size_t)seg * 32 + g) * 128 + 16 * r + 4 * q) = acc; } }
        __syncthreads();
    }
}
template <int W> __device__ __forceinline__ void pool_item(const Frame& F, int layer, int r4, int g) {
    constexpr int R = 8;
    const bf16_t* Q = (const bf16_t*)(F.ws + WS_XC); const bf16_t* SG = (const bf16_t*)(F.ws + WS_SG); bf16_t* Y = (bf16_t*)(F.ws + WS_Y);
    const float* psc = (const float*)(F.ws + WS_PAR) + PAR_PSC + layer * POOLW;
    const int o16 = F.lane & 15, sub = F.lane >> 4, m0 = (r4 * 4 + sub) * R, tl0 = m0 & (SEQ - 1), col = g * 128 + 8 * o16;
    u32x4 xs[W - 1 + R];
#pragma unroll
    for (int k = 0; k < W - 1 + R; ++k) { const int tl = tl0 - (W - 1) + k;
        xs[k] = tl >= 0 ? *(const u32x4*)(Q + (size_t)(m0 - (W - 1) + k) * 512 + col) : (u32x4){0u, 0u, 0u, 0u}; }
    const f32x4 p0 = *(const f32x4*)(psc + col), p1 = *(const f32x4*)(psc + col + 4);
    float S[8];
#pragma unroll
    for (int e = 0; e < 8; ++e) S[e] = 0.f;
#pragma unroll
    for (int k = 0; k < W - 1; ++k) { S[0] += bf_lo(xs[k].x); S[1] += bf_hi(xs[k].x); S[2] += bf_lo(xs[k].y); S[3] += bf_hi(xs[k].y); S[4] += bf_lo(xs[k].z); S[5] += bf_hi(xs[k].z); S[6] += bf_lo(xs[k].w); S[7] += bf_hi(xs[k].w); }
#pragma unroll
    for (int i = 0; i < R; ++i) { const u32x4 xv = xs[i + W - 1];
        const float xe[8] = {bf_lo(xv.x), bf_hi(xv.x), bf_lo(xv.y), bf_hi(xv.y), bf_lo(xv.z), bf_hi(xv.z), bf_lo(xv.w), bf_hi(xv.w)};
#pragma unroll
        for (int e = 0; e < 8; ++e) S[e] += xe[e];
        const int cnt = tl0 + i + 1 < W ? tl0 + i + 1 : W; const float inv = 1.0f / (float)cnt;
        const u32x4 sg = __builtin_nontemporal_load((const u32x4*)(SG + (size_t)(m0 + i) * 1024 + 512 + col)); u32x4 wv;
        wv.x = cvt_pk_bf16((S[0] * inv - xe[0]) * p0[0] * bf_lo(sg.x), (S[1] * inv - xe[1]) * p0[1] * bf_hi(sg.x));
        wv.y = cvt_pk_bf16((S[2] * inv - xe[2]) * p0[2] * bf_lo(sg.y), (S[3] * inv - xe[3]) * p0[3] * bf_hi(sg.y));
        wv.z = cvt_pk_bf16((S[4] * inv - xe[4]) * p1[0] * bf_lo(sg.z), (S[5] * inv - xe[5]) * p1[1] * bf_hi(sg.z));
        wv.w = cvt_pk_bf16((S[6] * inv - xe[6]) * p1[2] * bf_lo(sg.w), (S[7] * inv - xe[7]) * p1[3] * bf_hi(sg.w));
        *(u32x4*)(Y + (size_t)(m0 + i) * DM + 1536 + col) = wv;
        const u32x4 ov = xs[i];
        S[0] -= bf_lo(ov.x); S[1] -= bf_hi(ov.x); S[2] -= bf_lo(ov.y); S[3] -= bf_hi(ov.y); S[4] -= bf_lo(ov.z); S[5] -= bf_hi(ov.z); S[6] -= bf_lo(ov.w); S[7] -= bf_hi(ov.w); }
}
__device__ __forceinline__ void p2_pool(const Frame& F, int layer) {
    for (int it = F.gw; it < (MTOK / 32) * 4; it += F.NGW) { const int g = it & 3, r4 = it >> 2;
        if (g == 0) pool_item<2>(F, layer, r4, 0); else if (g == 1) pool_item<4>(F, layer, r4, 1); else if (g == 2) pool_item<8>(F, layer, r4, 2); else pool_item<16>(F, layer, r4, 3); }
}

constexpr int CAR_ROWB = 272;
__device__ __forceinline__ void m3_s5(const Frame& F, int layer) {
    const f32x2* POW = (const f32x2*)(F.ws + WS_POW); const float* SE = (const float*)(F.ws + WS_SE);
    const bf16_t* WS5 = (const bf16_t*)(F.ws + WS_WS5) + (size_t)layer * S5G * 256 * 384;
    const bf16_t* XAT = (const bf16_t*)(F.ws + WS_XA); bf16_t* YG = (bf16_t*)(F.ws + WS_YG);
    LAS unsigned char* car = F.lds;
    LAS f32x2* ends = (LAS f32x2*)(F.lds + 256 * CAR_ROWB);
    const int c = F.lane & 15, q = F.lane >> 4, w = F.wave, p = F.lane, sc = F.wave;
    for (int it = F.vcu; it < NB * S5G * 2; it += F.G) {
        const int b = it >> 6, g = (it >> 1) & 31, half = it & 1;
        { const f32x2 l16 = POW[(((size_t)layer * S5G + g) * 64 + p) * 17 + 16];
          const float* e0 = SE + ((size_t)(b * SEGB + sc * 64) * 32 + g) * 128 + p;
          float er[64], ei[64];
          const bool need = sc < 4 * (half + 1);
          if (need) {
#pragma unroll
              for (int j = 0; j < 64; ++j) { er[j] = e0[(size_t)j * 4096]; ei[j] = e0[(size_t)j * 4096 + 64]; } }
          else {
#pragma unroll
              for (int j = 0; j < 64; ++j) { er[j] = 0.f; ei[j] = 0.f; } }
          float sr = 0.f, si = 0.f;
#pragma unroll
          for (int j = 0; j < 64; ++j) { const float nr = l16.x * sr - l16.y * si + er[j], ni = l16.x * si + l16.y * sr + ei[j]; sr = nr; si = ni; }
          ends[sc * 64 + p] = (f32x2){sr, si};
          float mr = l16.x, mi = l16.y;
#pragma unroll
          for (int k = 0; k < 6; ++k) { const float tr = mr * mr - mi * mi, ti = 2.f * mr * mi; mr = tr; mi = ti; }
          __syncthreads();
          float cr = 0.f, ci = 0.f;
          for (int k = 0; k < sc; ++k) { const f32x2 e = ends[k * 64 + p]; const float nr = mr * cr - mi * ci + e.x, ni = mr * ci + mi * cr + e.y; cr = nr; ci = ni; }
          if ((sc >> 2) == half) { sr = cr; si = ci; LAS unsigned char* rowp = car + ((sc & 3) * 64) * CAR_ROWB + 2 * p;
#pragma unroll
              for (int j = 0; j < 64; ++j) { *(LAS bf16_t*)(rowp + j * CAR_ROWB) = (bf16_t)f2bf_rne(sr); *(LAS bf16_t*)(rowp + j * CAR_ROWB + 128) = (bf16_t)f2bf_rne(si);
                  const float nr = l16.x * sr - l16.y * si + er[j], ni = l16.x * si + l16.y * sr + ei[j]; sr = nr; si = ni; } }
          __syncthreads(); }
        bf16x8 aw[2][12];
#pragma unroll
        for (int rr = 0; rr < 2; ++rr)
#pragma unroll
            for (int ks = 0; ks < 12; ++ks) aw[rr][ks] = *(const bf16x8*)(WS5 + ((size_t)g * 256 + 16 * (2 * w + rr) + c) * 384 + 32 * ks + 8 * q);
        const bf16_t* xw = XAT + (size_t)(16 * g + 2 * w + (q >> 1)) * MTOK + 8 * (q & 1);
        const int segbase = b * SEGB + half * 256;
        LAS unsigned char* xfr = F.lds + 256 * CAR_ROWB + 4096;
        u32x4 pre[4];
#pragma unroll
        for (int s = 0; s < 4; ++s) pre[s] = *(const u32x4*)(xw + (size_t)(segbase + s * 16 + c) * 16);
#pragma unroll 1
        for (int sg4 = 0; sg4 < 4; ++sg4) {
#pragma unroll
            for (int s = 0; s < 4; ++s) *(LAS u32x4*)(xfr + ((s * 8 + w) * 64 + F.lane) * 16) = pre[s];
            if (sg4 < 3) {
#pragma unroll
                for (int s = 0; s < 4; ++s) pre[s] = *(const u32x4*)(xw + (size_t)(segbase + (4 * (sg4 + 1) + s) * 16 + c) * 16); }
            __syncthreads();
#pragma unroll
            for (int s = 0; s < 4; ++s) { const int st = 4 * sg4 + s, seg = segbase + st * 16 + c;
                f32x4 a0 = (f32x4){0.f, 0.f, 0.f, 0.f}, a1 = (f32x4){0.f, 0.f, 0.f, 0.f};
#pragma unroll
                for (int ks = 0; ks < 4; ++ks) { const bf16x8 bc = *(const LAS bf16x8*)(car + (st * 16 + c) * CAR_ROWB + 64 * ks + 16 * q); a0 = MFMA16(aw[0][8 + ks], bc, a0); a1 = MFMA16(aw[1][8 + ks], bc, a1); }
#pragma unroll
                for (int ks = 0; ks < 8; ++ks) { const bf16x8 bx = *(const LAS bf16x8*)(xfr + ((s * 8 + ks) * 64 + F.lane) * 16); a0 = MFMA16(aw[0][ks], bx, a0); a1 = MFMA16(aw[1][ks], bx, a1); }
                const int m = seg * 16 + 4 * (w >> 1) + q; u32x4 o;
                o.x = cvt_pk_bf16(gelu_f(a0[0]), gelu_f(a0[1])); o.y = cvt_pk_bf16(gelu_f(a0[2]), gelu_f(a0[3])); o.z = cvt_pk_bf16(gelu_f(a1[0]), gelu_f(a1[1])); o.w = cvt_pk_bf16(gelu_f(a1[2]), gelu_f(a1[3]));
                *(u32x4*)(YG + (size_t)m * 512 + 16 * g + 8 * (w & 1)) = o; }
            __syncthreads();
        }
        __syncthreads();
    }
}

__device__ __forceinline__ void p_final(const Frame& F, float* out, const float* final_g) {
    const u64* ssq = (const u64*)(F.ws + WS_SSQ) + 2 * (size_t)MTOK; const bf16_t* XB = (const bf16_t*)(F.ws + WS_XB);
    for (int m = F.gw; m < MTOK; m += F.NGW) {
        const float rs = rsqrtf((float)ssq[m] * (1.0f / (SSQ_SCALE * (float)DM)) + RMS_EPS);
        const u32x4* xr = (const u32x4*)(XB + (size_t)m * DM) + F.lane; f32x4* orow = (f32x4*)(out + (size_t)m * DM) + 2 * F.lane; const f32x4* gr = (const f32x4*)final_g + 2 * F.lane;
#pragma unroll
        for (int j = 0; j < 4; ++j) { const u32x4 v = __builtin_nontemporal_load(xr + 64 * j); const f32x4 g0 = gr[128 * j], g1 = gr[128 * j + 1];
            __builtin_nontemporal_store((f32x4){bf_lo(v.x) * rs * g0[0], bf_hi(v.x) * rs * g0[1], bf_lo(v.y) * rs * g0[2], bf_hi(v.y) * rs * g0[3]}, orow + 128 * j);
            __builtin_nontemporal_store((f32x4){bf_lo(v.z) * rs * g1[0], bf_hi(v.z) * rs * g1[1], bf_lo(v.w) * rs * g1[2], bf_hi(v.w) * rs * g1[3]}, orow + 128 * j + 1); }
    }
}

constexpr int N_PHASES = 12;
#ifndef PROBE_PHASE
#define PROBE_PHASE (-1)
#endif
#ifndef PROBE_REPS
#define PROBE_REPS 1
#endif
#ifndef PROBE_SUB
#define PROBE_SUB 0
#endif
__global__ void __launch_bounds__(NTHR, 2) hybrid_fwd(Args args) {
    extern __shared__ __attribute__((aligned(16))) unsigned char lds_raw[];
    LAS unsigned char* lds = (LAS unsigned char*)lds_raw;
    volatile LAS unsigned* MISC = (volatile LAS unsigned*)(lds + LDSCTL_OFF);
    if (threadIdx.x < 64) MISC[threadIdx.x] = 0u;
    const int wave_s = __builtin_amdgcn_readfirstlane(threadIdx.x >> 6);
    __syncthreads();
    unsigned char* ws0 = args.ws;
    XcdBarrier bar; bar.bar = (unsigned*)(ws0 + WS_CTL) + 1024; bar.x = 0; bar.st = nullptr;
#if !MK_MULTI
    bar = xcd_barrier_post((unsigned*)(ws0 + WS_CTL) + 1024, MISC + 8);
#endif
#pragma unroll 1
    for (int ph = args.ph_lo; ph < args.ph_hi; ++ph) {
        const int l = ph == 0 ? 0 : (ph - 1) / 5, sub = ph == 0 ? 0 : (ph == N_PHASES - 1 ? 6 : 1 + (ph - 1) % 5);
        const int nrep = (ph == PROBE_PHASE) ? PROBE_REPS : 1;
#pragma unroll 1
        for (int rep = 0; rep < nrep; ++rep) {
            unsigned char* ws = ws0; asm volatile("" : "+s"(ws));
            int bx = blockIdx.x, gx = gridDim.x; asm volatile("" : "+s"(bx), "+s"(gx));
            if (sub == 0) { const Frame F = mkframe(ws, lds, wave_s); p0_prologue(F, args); }
            else if (sub == 1) {
                if (l == 0 && rep == 0) { const Frame F = mkframe(ws, lds, wave_s); s5_tables_a(F, args); }
                const int rbase = (gx % 8 == 0 && gx == 256) ? 4096 * (bx & 7) : -1;
                LAS float* rtab = (LAS float*)(lds + RING_BYTES);
                { const Frame F = mkframe(ws, lds, wave_s); const u64* ssq = (const u64*)(ws + WS_SSQ) + (size_t)l * MTOK;
                  if (rbase >= 0) { for (int i = F.tid; i < 4096; i += NTHR) rtab[i] = rsqrtf((float)ssq[rbase + i] * (1.0f / (SSQ_SCALE * (float)DM)) + RMS_EPS); }
                  __syncthreads(); }
                SchedIn S{gx, bx, l, (const char*)ws};
                EpiIn E{ws, l, rtab, rbase};
                pg8::gemm_phase<EpiIn, SchedIn, true, true>(lds, wave_s, DM, DM, DM, S, E);
            } else if (sub == 2) {
                if (l == 0 && rep == 0) { const Frame F = mkframe(ws, lds, wave_s); s5_tables_b(F); }
                if (PROBE_SUB == 0 || PROBE_SUB == 1 || rep == 0) { const Frame F = mkframe(ws, lds, wave_s); m1_sgu(F, l); }
                if (PROBE_SUB == 0 || PROBE_SUB == 2 || rep == 0) { const Frame F = mkframe(ws, lds, wave_s); m1_send(F, l); }
                if (PROBE_SUB == 0 || PROBE_SUB == 3 || rep == 0) { const Frame F = mkframe(ws, lds, wave_s); p2_pool(F, l); }
            } else if (sub == 3) { const Frame F = mkframe(ws, lds, wave_s); m3_s5(F, l); }
            else if (sub == 4) {
                SchedMix S{gx, bx, l, (const char*)ws};
                EpiMix E{ws, l};
                pg8::gemm_phase<EpiMix, SchedMix, true, true>(lds, wave_s, 512, 512, 512, S, E);
            } else if (sub == 5) {
                SchedOut S{gx, bx, l, (const char*)ws};
                EpiOut E{ws, l, rep == 0 ? 1 : 0};
                pg8::gemm_phase<EpiOut, SchedOut, true, true>(lds, wave_s, DM, DM, DM, S, E);
            } else { const Frame F = mkframe(ws, lds, wave_s); p_final(F, args.out, (const float*)(ws + WS_PAR) + PAR_FG); }
#if !MK_MULTI
            if (rep + 1 < nrep) xcd_barrier(bar);
#endif
        }
#if !MK_MULTI
        if (ph + 1 < args.ph_hi) xcd_barrier(bar);
#endif
    }
}

extern "C" void kernel_launch(void* const* d_in, const int* in_sizes, int n_in, void* d_out, int out_size, void* d_ws, size_t ws_size, hipStream_t stream) {
    static int grid = 0;
    if (grid == 0) {
        if (n_in != 21 || in_sizes[0] != MTOK * DM || out_size != MTOK * DM || ws_size < WS_END) { fprintf(stderr, "kernel_launch: unexpected shapes (n_in %d, in0 %d, out %d, ws %zu)\n", n_in, n_in > 0 ? in_sizes[0] : -1, out_size, ws_size); grid = -1; return; }
        int dev = 0, cus = 0, per_cu = 0;
        if (hipGetDevice(&dev) != hipSuccess || hipDeviceGetAttribute(&cus, hipDeviceAttributeMultiprocessorCount, dev) != hipSuccess) { grid = -1; return; }
        if (hipFuncSetAttribute((const void*)hybrid_fwd, hipFuncAttributeMaxDynamicSharedMemorySize, LDS_BYTES) != hipSuccess) { fprintf(stderr, "kernel_launch: hipFuncSetAttribute failed\n"); grid = -1; return; }
        if (hipOccupancyMaxActiveBlocksPerMultiprocessor(&per_cu, (const void*)hybrid_fwd, NTHR, LDS_BYTES) != hipSuccess || per_cu < 1) { fprintf(stderr, "kernel_launch: occupancy query says %d blocks per CU\n", per_cu); per_cu = 1; }
        (void)hipGetLastError();
        grid = cus;
    }
    if (grid < 0) return;
    (void)hipMemsetAsync((char*)d_ws + WS_CTL, 0, CTL_ZERO_BYTES, stream);
    Args a{};
    for (int i = 0; i < 21; ++i) a.in[i] = (const float*)d_in[i];
    a.out = (float*)d_out; a.ws = (unsigned char*)d_ws;
#if MK_MULTI
    for (int ph = 0; ph < N_PHASES; ++ph) { a.ph_lo = ph; a.ph_hi = ph + 1; hipLaunchKernelGGL(hybrid_fwd, dim3(grid), dim3(NTHR), LDS_BYTES, stream, a); }
#else
    a.ph_lo = 0; a.ph_hi = N_PHASES;
    void* kargs[] = {&a};
    hipError_t e = hipLaunchCooperativeKernel((const void*)hybrid_fwd, dim3(grid), dim3(NTHR), kargs, LDS_BYTES, stream);
    if (e != hipSuccess) fprintf(stderr, "kernel_launch: cooperative launch failed: %s (grid %d)\n", hipGetErrorString(e), grid);
#endif
}
```

```cpp
#include <hip/hip_runtime.h>
#include <cstdio>
#include <cstdint>

#ifndef MK_MULTI
#define MK_MULTI 0
#endif

#define LAS __attribute__((address_space(3)))
#define GAS __attribute__((address_space(1)))
typedef unsigned short bf16_t;
typedef short bf16x8 __attribute__((ext_vector_type(8)));
typedef float f32x4 __attribute__((ext_vector_type(4)));
typedef float f32x2 __attribute__((ext_vector_type(2)));
typedef unsigned u32x4 __attribute__((ext_vector_type(4)));
typedef unsigned u32x2 __attribute__((ext_vector_type(2)));
typedef unsigned long long u64;

constexpr int DM = 2048, NB = 4, SEQ = 8192, DEPTH = 2, MTOK = NB * SEQ;
constexpr int S5W = 512, SGUW = 1024, POOLW = 512, INC = 5120;
constexpr int S5G = 32, S5H = 16, S5P = 64;
constexpr int NSEG = MTOK / 16, SEGB = SEQ / 16; constexpr int WA_ROWS = 3584, WB_ROWS = 1536;
constexpr float RMS_EPS = 1e-6f, LN_EPS = 1e-5f;
constexpr float SSQ_SCALE = 16777216.0f;

constexpr size_t MiB = 1u << 20;
constexpr size_t WS_CTL = 0, CTL_ZERO_BYTES = 64 * 1024;
constexpr size_t WS_SSQ = 1 * MiB;
constexpr size_t WS_POW = 2 * MiB;
constexpr size_t WS_BBAR = WS_POW + 640 * 1024;
constexpr size_t WS_PAR = 3 * MiB + 256 * 1024;
constexpr int PAR_BGLU = 0, PAR_LNG = 1024, PAR_LNB = 3072, PAR_BS = 5120, PAR_PSC = 7168, PAR_FG = 8192, PAR_N = 10240;
constexpr size_t WS_KT = 4 * MiB;
constexpr size_t WS_WEND = 5 * MiB;
constexpr size_t WS_WS5 = 9 * MiB;
constexpr size_t WS_WSG = 21 * MiB;
constexpr size_t WS_WGLU = 22 * MiB;
constexpr size_t WS_WPD = 23 * MiB;
constexpr size_t WS_WA = 24 * MiB;
constexpr size_t WS_WB = 52 * MiB;
constexpr size_t WS_WOUT = 64 * MiB;
constexpr size_t WS_XB = 80 * MiB;
constexpr size_t WS_XA = 208 * MiB;
constexpr size_t WS_GVT = 240 * MiB;
constexpr size_t WS_UG = 304 * MiB;
constexpr size_t WS_XC = 368 * MiB;
constexpr size_t WS_SG = 400 * MiB;
constexpr size_t WS_PF = 464 * MiB;
constexpr size_t WS_YG = 496 * MiB;
constexpr size_t WS_Y = 528 * MiB;
constexpr size_t WS_SE = 656 * MiB;
constexpr size_t WS_CARRY = 688 * MiB;
constexpr size_t WS_LNS = 704 * MiB;
constexpr size_t WS_END = 706 * MiB;
constexpr float LNS_SCALE = 1073741824.0f;

__device__ __forceinline__ unsigned cvt_pk_bf16(float lo, float hi) { unsigned r; asm volatile("v_cvt_pk_bf16_f32 %0, %1, %2" : "=v"(r) : "v"(lo), "v"(hi)); return r; }
__device__ __forceinline__ unsigned f2bf_rne(float f) { unsigned u = __float_as_uint(f); return (u + 0x7fffu + ((u >> 16) & 1u)) >> 16; }
__device__ __forceinline__ unsigned pk_bf16_c(float lo, float hi) { return f2bf_rne(lo) | (f2bf_rne(hi) << 16); }
__device__ __forceinline__ float bf_lo(unsigned w) { return __uint_as_float(w << 16); }
__device__ __forceinline__ float bf_hi(unsigned w) { return __uint_as_float(w & 0xffff0000u); }
__device__ __forceinline__ float bf2f(bf16_t b) { return __uint_as_float(((unsigned)b) << 16); }
__device__ __forceinline__ float sigmoid_f(float x) { return __builtin_amdgcn_rcpf(1.0f + __builtin_amdgcn_exp2f(-1.4426950408889634f * x)); }
__device__ __forceinline__ float silu_f(float x) { return x * sigmoid_f(x); }
__device__ __forceinline__ float gelu_f(float x) {
    const float u = x * (1.0f + 0.044715f * x * x);
    return x * __builtin_amdgcn_rcpf(1.0f + __builtin_amdgcn_exp2f(-2.302208198f * u));
}
__device__ __forceinline__ float gelu_silu_f(float a, float g) {
    const float u = a * (1.0f + 0.044715f * a * a);
    const float ea = __builtin_amdgcn_exp2f(-2.302208198f * u), eg = __builtin_amdgcn_exp2f(-1.4426950408889634f * g);
    return a * g * __builtin_amdgcn_rcpf((1.0f + ea) * (1.0f + eg));
}
template <int CTRL> __device__ __forceinline__ float dpp_f(float v) { return __int_as_float(__builtin_amdgcn_update_dpp(0, __float_as_int(v), CTRL, 0xf, 0xf, false)); }
__device__ __forceinline__ float row16_sum(float v) { v += dpp_f<0x128>(v); v += dpp_f<0x124>(v); v += dpp_f<0x122>(v); v += dpp_f<0x121>(v); return v; }
__device__ __forceinline__ float xor16_add(float v) { return v + __int_as_float(__builtin_amdgcn_ds_swizzle(__float_as_int(v), 0x401F)); }
__device__ __forceinline__ float xor32_add(float v) { const auto r = __builtin_amdgcn_permlane32_swap(__float_as_uint(v), __float_as_uint(v), false, false); return __uint_as_float(r[0]) + __uint_as_float(r[1]); }
__device__ __forceinline__ float wave_sum(float v) { return xor32_add(xor16_add(row16_sum(v))); }

namespace pg8 {
constexpr int BM = 256, BK = 64, HALF = 128, HTB = HALF * BK * 2, STAGE_BYTES = 8 * HTB, NXCD = 8, WGM = 8;
__host__ __device__ __forceinline__ int lds_byte(int r, int c) { const int st = (r >> 4) * 2 + (c >> 5), rr = r & 15, cc = c & 31, ob = rr * 64 + cc * 2; return st * 1024 + (ob ^ (((ob >> 9) & 1) << 5)); }
__host__ __device__ __forceinline__ void stage_rc(int b, int& R, int& C) { const int st = b / 1024, sb = b % 1024, swz = sb ^ (((sb >> 9) & 1) << 5); R = (st >> 1) * 16 + swz / 64; C = (st & 1) * 32 + (swz % 64) / 2; }
__host__ __device__ __forceinline__ int perm32(int rho) { const int n = rho >> 4, i = rho & 15; return 8 * (i >> 2) + 4 * n + (i & 3); }

struct Unit { int pm, pn, type, cb; const GAS char* A; const GAS char* B; };
__device__ __forceinline__ void tile_of(int L, int nM, int nN, int& pm, int& pn) {
    const int nwg = nM * nN; int wgid = L; { const int q = nwg / NXCD, r = nwg % NXCD, xcd = wgid % NXCD, off = wgid / NXCD; wgid = (xcd < r ? xcd * (q + 1) : r * (q + 1) + (xcd - r) * q) + off; }
    const int nig = WGM * nN, gid = wgid / nig, fm = gid * WGM, gsz = (nM - fm) < WGM ? (nM - fm) : WGM;
    pm = fm + ((wgid % nig) % gsz); pn = (wgid % nig) / gsz;
}

template <class Epi, class Sched, bool ALIGN_EPI, bool SP2>
__device__ __forceinline__ void gemm_phase(LAS unsigned char* lds, const int wave_s, const int K, const int ldA, const int ldB, const Sched& S, const Epi& E) {
    int tid_; asm volatile("v_mbcnt_lo_u32_b32 %0, -1, 0\n\tv_mbcnt_hi_u32_b32 %0, -1, %0" : "=v"(tid_)); tid_ |= wave_s << 6;
    const int tid = tid_, wid = __builtin_amdgcn_readfirstlane(tid >> 6), lane = tid & 63, wr = wid >> 2, wc = wid & 3, fr = lane & 15, fq = lane >> 4;
    const int nt = K / BK;
    unsigned voffA[2], voffB[2];
#pragma unroll
    for (int i = 0; i < 2; ++i) { int R, C; stage_rc(tid * 16 + i * 8192, R, C); const int Rb = (R & ~31) + perm32(R & 31);
        voffA[i] = (unsigned)(R * ldA + C) * 2u; voffB[i] = (unsigned)(Rb * ldB + C) * 2u; }
    const size_t kstep = (size_t)(BK * 2);
    const size_t hstepA = (size_t)HALF * ldA * 2, hstepB = (size_t)HALF * ldB * 2;
    const unsigned ldsw = (unsigned)wid * 1024u;
    const int aoff = lds_byte(wr * 64 + fr, fq * 8), boff = lds_byte(wc * 32 + fr, fq * 8);
#define PG8_SA(b, h) (((b) * 2 + (h)) * HTB)
#define PG8_SB(b, h) ((4 + (b) * 2 + (h)) * HTB)
#define PG8_STAGE(bufoff, gbase, voff) do { _Pragma("unroll") for (int _i = 0; _i < 2; ++_i) \
        __builtin_amdgcn_global_load_lds((const GAS unsigned*)((const GAS char*)(gbase) + (voff)[_i]), (LAS unsigned*)(lds + (bufoff) + ldsw + _i * 8192), 16, 0, 0); } while (0)
#define PG8_LDA(dst, b, h) do { _Pragma("unroll") for (int m = 0; m < 4; ++m) _Pragma("unroll") for (int k = 0; k < 2; ++k) dst[m][k] = *(const LAS bf16x8*)(lds + PG8_SA(b, h) + aoff + m * 2048 + k * 1024); } while (0)
#define PG8_LDB(dst, b, h) do { _Pragma("unroll") for (int n = 0; n < 2; ++n) _Pragma("unroll") for (int k = 0; k < 2; ++k) dst[n][k] = *(const LAS bf16x8*)(lds + PG8_SB(b, h) + boff + n * 2048 + k * 1024); } while (0)
#define PG8_MMA(ai, bj, At, Bt) do { __builtin_amdgcn_s_setprio(1); _Pragma("unroll") for (int m = 0; m < 4; ++m) _Pragma("unroll") for (int n = 0; n < 2; ++n) _Pragma("unroll") for (int k = 0; k < 2; ++k) \
        acc[ai][bj][m][n] = __builtin_amdgcn_mfma_f32_16x16x32_bf16(Bt[n][k], At[m][k], acc[ai][bj][m][n], 0, 0, 0); __builtin_amdgcn_s_setprio(0); } while (0)
#define PG8_WAIT_V(n) asm volatile("s_waitcnt vmcnt(" #n ")" ::: "memory")
#define PG8_WAIT_L(n) asm volatile("s_waitcnt lgkmcnt(" #n ")" ::: "memory")
#define PG8_BAR __builtin_amdgcn_s_barrier()
#define PG8_SCHED __builtin_amdgcn_sched_barrier(0)
    Unit cur, nxt; int ui = 0;
    if (!S.next(0, cur)) return;
    f32x4 acc[2][2][4][2];
#pragma unroll
    for (int a = 0; a < 2; ++a)
#pragma unroll
        for (int b = 0; b < 2; ++b)
#pragma unroll
            for (int m = 0; m < 4; ++m)
#pragma unroll
                for (int n = 0; n < 2; ++n) acc[a][b][m][n] = (f32x4){0.f, 0.f, 0.f, 0.f};
    bf16x8 At[4][2], B0[2][2], B1[2][2];
    const GAS char* cA = cur.A; const GAS char* cB = cur.B;
    if constexpr (SP2) {
        PG8_STAGE(PG8_SB(0, 0), cB, voffB); PG8_STAGE(PG8_SB(0, 1), cB + hstepB, voffB); PG8_STAGE(PG8_SA(0, 0), cA, voffA); PG8_STAGE(PG8_SA(0, 1), cA + hstepA, voffA);
        if (wr == 1) PG8_BAR;
        PG8_WAIT_V(2); PG8_BAR;
        PG8_STAGE(PG8_SB(1, 0), cB + kstep, voffB); PG8_STAGE(PG8_SA(1, 0), cA + kstep, voffA); PG8_STAGE(PG8_SB(1, 1), cB + hstepB + kstep, voffB);
        PG8_WAIT_V(6); PG8_BAR;
    } else {
        PG8_STAGE(PG8_SB(0, 0), cB, voffB); PG8_STAGE(PG8_SA(0, 0), cA, voffA); PG8_STAGE(PG8_SB(0, 1), cB + hstepB, voffB); PG8_STAGE(PG8_SA(0, 1), cA + hstepA, voffA);
        if (wr == 1) PG8_BAR;
        PG8_WAIT_V(4); PG8_BAR;
        PG8_STAGE(PG8_SB(1, 0), cB + kstep, voffB); PG8_STAGE(PG8_SA(1, 0), cA + kstep, voffA); PG8_STAGE(PG8_SB(1, 1), cB + hstepB + kstep, voffB);
        PG8_WAIT_V(6); PG8_BAR;
    }
    for (;;) {
        const bool has_next = S.next(ui + 1, nxt);
        const GAS char* nA = has_next ? nxt.A : cA; const GAS char* nB = has_next ? nxt.B : cB;
        for (int t = 0; t < nt; t += 2) {
            const bool last = (t == nt - 2);
            const GAS char* a1 = cA + (size_t)(t + 1) * kstep;
            const GAS char* a2 = last ? nA : cA + (size_t)(t + 2) * kstep; const GAS char* b2 = last ? nB : cB + (size_t)(t + 2) * kstep;
            const GAS char* a3 = a2 + kstep; const GAS char* b3 = b2 + kstep;
            if constexpr (SP2) {
            PG8_LDB(B0, 0, 0); PG8_LDB(B1, 0, 1); PG8_SCHED; PG8_LDA(At, 0, 0); PG8_STAGE(PG8_SA(1, 1), a1 + hstepA, voffA);
            PG8_WAIT_V(8); PG8_WAIT_L(0); PG8_BAR; PG8_MMA(0, 0, At, B0); PG8_MMA(0, 1, At, B1); PG8_BAR; PG8_SCHED;
            PG8_LDA(At, 0, 1); PG8_STAGE(PG8_SB(0, 0), b2, voffB); PG8_STAGE(PG8_SB(0, 1), b2 + hstepB, voffB); PG8_STAGE(PG8_SA(0, 0), a2, voffA);
            PG8_WAIT_V(8); PG8_WAIT_L(0); PG8_BAR; PG8_MMA(1, 0, At, B0); PG8_MMA(1, 1, At, B1); PG8_BAR; PG8_SCHED;
            PG8_LDB(B0, 1, 0); PG8_LDB(B1, 1, 1); PG8_SCHED; PG8_LDA(At, 1, 0); PG8_STAGE(PG8_SA(0, 1), a2 + hstepA, voffA);
            PG8_WAIT_V(8); PG8_WAIT_L(0); PG8_BAR; PG8_MMA(0, 0, At, B0); PG8_MMA(0, 1, At, B1); PG8_BAR; PG8_SCHED;
            PG8_LDA(At, 1, 1); PG8_STAGE(PG8_SB(1, 0), b3, voffB); PG8_STAGE(PG8_SB(1, 1), b3 + hstepB, voffB); PG8_STAGE(PG8_SA(1, 0), a3, voffA);
            PG8_WAIT_V(8); PG8_WAIT_L(0); PG8_BAR; PG8_MMA(1, 0, At, B0); PG8_MMA(1, 1, At, B1); PG8_BAR; PG8_SCHED;
            } else {
            PG8_LDB(B0, 0, 0); PG8_SCHED; PG8_LDA(At, 0, 0); PG8_STAGE(PG8_SA(1, 1), a1 + hstepA, voffA);
            PG8_WAIT_L(8); PG8_BAR; PG8_WAIT_L(0); PG8_MMA(0, 0, At, B0); PG8_BAR; PG8_SCHED;
            PG8_LDB(B1, 0, 1); PG8_STAGE(PG8_SB(0, 0), b2, voffB);
            PG8_BAR; PG8_WAIT_L(0); PG8_MMA(0, 1, At, B1); PG8_BAR;
            PG8_LDA(At, 0, 1); PG8_STAGE(PG8_SA(0, 0), a2, voffA);
            PG8_BAR; PG8_WAIT_L(0); PG8_MMA(1, 0, At, B0); PG8_BAR; PG8_SCHED;
            PG8_STAGE(PG8_SB(0, 1), b2 + hstepB, voffB);
            PG8_WAIT_V(6); PG8_BAR; PG8_MMA(1, 1, At, B1); PG8_BAR;
            PG8_LDB(B0, 1, 0); PG8_SCHED; PG8_LDA(At, 1, 0); PG8_STAGE(PG8_SA(0, 1), a2 + hstepA, voffA);
            PG8_WAIT_L(8); PG8_BAR; PG8_WAIT_L(0); PG8_MMA(0, 0, At, B0); PG8_BAR; PG8_SCHED;
            PG8_LDB(B1, 1, 1); PG8_STAGE(PG8_SB(1, 0), b3, voffB);
            PG8_BAR; PG8_WAIT_L(0); PG8_MMA(0, 1, At, B1); PG8_BAR;
            PG8_LDA(At, 1, 1); PG8_STAGE(PG8_SA(1, 0), a3, voffA);
            PG8_BAR; PG8_WAIT_L(0); PG8_MMA(1, 0, At, B0); PG8_BAR; PG8_SCHED;
            PG8_STAGE(PG8_SB(1, 1), b3 + hstepB, voffB);
            PG8_WAIT_V(6); PG8_BAR; PG8_MMA(1, 1, At, B1); PG8_BAR;
            }
        }
        if constexpr (ALIGN_EPI) { if (wr == 0) PG8_BAR; }
        E(acc, cur, wr, wc, fr, fq);
        if (!has_next) break;
#pragma unroll
        for (int a = 0; a < 2; ++a)
#pragma unroll
            for (int b = 0; b < 2; ++b)
#pragma unroll
                for (int m = 0; m < 4; ++m)
#pragma unroll
                    for (int n = 0; n < 2; ++n) acc[a][b][m][n] = (f32x4){0.f, 0.f, 0.f, 0.f};
        cur = nxt; cA = nA; cB = nB; ++ui;
        if constexpr (ALIGN_EPI) { if (wr == 1) PG8_BAR; }
    }
    PG8_WAIT_V(0);
    if constexpr (!ALIGN_EPI) { if (wr == 0) PG8_BAR; }
    PG8_BAR;
#undef PG8_SA
#undef PG8_SB
#undef PG8_STAGE
#undef PG8_LDA
#undef PG8_LDB
#undef PG8_MMA
#undef PG8_WAIT_V
#undef PG8_WAIT_L
#undef PG8_BAR
#undef PG8_SCHED
}
}
using pg8::Unit;

struct SchedIn {
    int G, c, l; const GAS char* ws;
    __device__ __forceinline__ bool next(int i, Unit& u) const {
        const int L = i * G + c; const GAS char* XB = ws + WS_XB;
        if (L < 1792) { pg8::tile_of(L, 128, 14, u.pm, u.pn);
            u.A = XB + (size_t)u.pm * 256 * DM * 2; u.B = ws + WS_WA + ((size_t)l * WA_ROWS + (size_t)u.pn * 256) * DM * 2;
            const int pn = u.pn;
            if (pn < 8) { u.type = 1; u.cb = 128 * pn; }
            else if (pn < 10) { u.type = 2; u.cb = 256 * (pn - 8); }
            else { u.type = 3; u.cb = 256 * (pn - 10); }
            return true; }
        const int L2 = L - 1792; if (L2 >= 768) return false;
        pg8::tile_of(L2, 6, 128, u.pm, u.pn);
        u.A = ws + WS_WB + ((size_t)l * WB_ROWS + (size_t)u.pm * 256) * DM * 2; u.B = XB + (size_t)u.pn * 256 * DM * 2;
        if (u.pm < 2) { u.type = 5; u.cb = 256 * u.pm; } else { u.type = 4; u.cb = 256 * (u.pm - 2); }
        return true;
    }
};
struct SchedMix {
    int G, c, l; const GAS char* ws;
    __device__ __forceinline__ bool next(int i, Unit& u) const {
        const int L = i * G + c; if (L >= 256) return false;
        pg8::tile_of(L, 128, 2, u.pm, u.pn);
        u.type = 0; u.cb = 256 * u.pn; u.A = ws + WS_YG + (size_t)u.pm * 256 * 512 * 2; u.B = ws + WS_WGLU + ((size_t)l * 512 + (size_t)u.pn * 256) * 512 * 2;
        return true;
    }
};
struct SchedOut {
    int G, c, l; const GAS char* ws;
    __device__ __forceinline__ bool next(int i, Unit& u) const {
        const int L = i * G + c; if (L >= 1024) return false;
        pg8::tile_of(L, 128, 8, u.pm, u.pn); u.type = 0; u.cb = 256 * u.pn;
        u.A = ws + WS_Y + (size_t)u.pm * 256 * DM * 2; u.B = ws + WS_WOUT + ((size_t)l * DM + (size_t)u.pn * 256) * DM * 2; return true;
    }
};

struct EpiIn {
    GAS unsigned char* ws; int l; const LAS float* rtab; int rbase;
    __device__ __forceinline__ float rstd_of(int row) const { if (rbase < 0) { const u64* ssq = (const u64*)(ws + WS_SSQ) + (size_t)l * MTOK; return rsqrtf((float)ssq[row] * (1.0f / (SSQ_SCALE * (float)DM)) + RMS_EPS); } return rtab[row - rbase]; }
    __device__ __forceinline__ void operator()(const f32x4 (&acc)[2][2][4][2], const Unit& u, int wr, int wc, int fr, int fq) const {
        const int type = u.type;
        if (type >= 4) {
            const int col0 = u.pn * 256 + wc * 32 + 8 * fq;
            bf16_t* dstb = (bf16_t*)(ws + (type == 4 ? WS_GVT : WS_XA));
            unsigned long long* lns = (unsigned long long*)(ws + WS_LNS) + (size_t)l * MTOK * 2;
#pragma unroll
            for (int bj = 0; bj < 2; ++bj) {
                float cs[8], sm[8], sq[8];
#pragma unroll
                for (int e = 0; e < 8; ++e) { cs[e] = rstd_of(col0 + bj * 128 + e); sm[e] = 0.f; sq[e] = 0.f; }
#pragma unroll
                for (int ai = 0; ai < 2; ++ai)
#pragma unroll
                    for (int m = 0; m < 4; ++m) {
                        const int r = u.cb + ai * 128 + wr * 64 + m * 16 + fr; bf16_t* rowp = dstb + (size_t)r * MTOK + col0 + bj * 128;
                        const f32x4 v0 = acc[ai][bj][m][0], v1 = acc[ai][bj][m][1]; u32x4 w;
                        float e[8] = {v0[0] * cs[0], v0[1] * cs[1], v0[2] * cs[2], v0[3] * cs[3], v1[0] * cs[4], v1[1] * cs[5], v1[2] * cs[6], v1[3] * cs[7]};
                        if (type == 4) {
#pragma unroll
                            for (int k = 0; k < 8; ++k) { e[k] = gelu_f(e[k]); sm[k] += e[k]; sq[k] += e[k] * e[k]; } }
                        w.x = cvt_pk_bf16(e[0], e[1]); w.y = cvt_pk_bf16(e[2], e[3]); w.z = cvt_pk_bf16(e[4], e[5]); w.w = cvt_pk_bf16(e[6], e[7]);
                        *(u32x4*)rowp = w; __builtin_amdgcn_sched_barrier(0); }
                if (type == 4) {
#pragma unroll
                    for (int k = 0; k < 8; ++k) {
                        { sm[k] = row16_sum(sm[k]); sq[k] = row16_sum(sq[k]); } }
                    { float pick = 0.f;
#pragma unroll
                      for (int k = 0; k < 8; ++k) { pick = (fr == k) ? sm[k] : pick; pick = (fr == 8 + k) ? sq[k] : pick; }
                      atomicAdd(lns + (size_t)(col0 + bj * 128 + (fr & 7)) * 2 + (fr >> 3), (unsigned long long)(long long)(pick * LNS_SCALE)); } }
            }
            return;
        }
        const int row0 = u.pm * 256 + wr * 64 + fr, cw = wc * 32 + 8 * fq;
        if (type == 1) {
#pragma unroll
            for (int ai = 0; ai < 2; ++ai)
#pragma unroll
                for (int m = 0; m < 4; ++m) { const int row = row0 + ai * 128 + m * 16; const float rs = rstd_of(row);
                    const f32x4 a0 = acc[ai][0][m][0] * rs, a1 = acc[ai][0][m][1] * rs, g0 = acc[ai][1][m][0] * rs, g1 = acc[ai][1][m][1] * rs; u32x4 w;
                    w.x = cvt_pk_bf16(gelu_silu_f(a0[0], g0[0]), gelu_silu_f(a0[1], g0[1])); w.y = cvt_pk_bf16(gelu_silu_f(a0[2], g0[2]), gelu_silu_f(a0[3], g0[3]));
                    w.z = cvt_pk_bf16(gelu_silu_f(a1[0], g1[0]), gelu_silu_f(a1[1], g1[1])); w.w = cvt_pk_bf16(gelu_silu_f(a1[2], g1[2]), gelu_silu_f(a1[3], g1[3]));
                    *(u32x4*)((bf16_t*)(ws + WS_UG) + (size_t)row * 1024 + u.cb + cw) = w; }
            return;
        }
        bf16_t* base = (bf16_t*)(ws + (type == 2 ? WS_XC : WS_SG)); const int ld = type == 3 ? 1024 : 512;
#pragma unroll
        for (int ai = 0; ai < 2; ++ai)
#pragma unroll
            for (int m = 0; m < 4; ++m) { const int row = row0 + ai * 128 + m * 16; const float rs = rstd_of(row); bf16_t* rowp = base + (size_t)row * ld + u.cb + cw;
#pragma unroll
                for (int bj = 0; bj < 2; ++bj) { f32x4 v0 = acc[ai][bj][m][0] * rs, v1 = acc[ai][bj][m][1] * rs;
                    if (type == 3) {
#pragma unroll
                        for (int e = 0; e < 4; ++e) { v0[e] = silu_f(v0[e]); v1[e] = silu_f(v1[e]); } }
                    u32x4 w; w.x = cvt_pk_bf16(v0[0], v0[1]); w.y = cvt_pk_bf16(v0[2], v0[3]); w.z = cvt_pk_bf16(v1[0], v1[1]); w.w = cvt_pk_bf16(v1[2], v1[3]);
                    *(u32x4*)(rowp + bj * 128) = w; } }
    }
};
struct EpiMix {
    GAS unsigned char* ws; int l;
    __device__ __forceinline__ void operator()(const f32x4 (&acc)[2][2][4][2], const Unit& u, int wr, int wc, int fr, int fq) const {
        const int row0 = u.pm * 256 + wr * 64 + fr, cw = u.cb + wc * 32 + 8 * fq;
        const bf16_t* YG = (const bf16_t*)(ws + WS_YG); const bf16_t* SG = (const bf16_t*)(ws + WS_SG); bf16_t* Y = (bf16_t*)(ws + WS_Y);
        const float* bglu = (const float*)(ws + WS_PAR) + PAR_BGLU + l * S5W; const float* pscale = (const float*)(ws + WS_PAR) + PAR_PSC + l * POOLW;
        f32x4 cv[2][2];
#pragma unroll
        for (int bj = 0; bj < 2; ++bj)
#pragma unroll
            for (int n = 0; n < 2; ++n) cv[bj][n] = *(const f32x4*)((u.type == 0 ? bglu : pscale) + cw + bj * 128 + 4 * n);
#pragma unroll
        for (int ai = 0; ai < 2; ++ai)
#pragma unroll
            for (int m = 0; m < 4; ++m) { const int row = row0 + ai * 128 + m * 16;
#pragma unroll
                for (int bj = 0; bj < 2; ++bj) { const int col = cw + bj * 128; const f32x4 a0 = acc[ai][bj][m][0], a1 = acc[ai][bj][m][1]; float o[8];
                    if (u.type == 0) {
                        const u32x4 yg = *(const u32x4*)(YG + (size_t)row * 512 + col), sg = *(const u32x4*)(SG + (size_t)row * 1024 + col);
                        o[0] = bf_lo(yg.x) * sigmoid_f(a0[0] + cv[bj][0][0]) * bf_lo(sg.x); o[1] = bf_hi(yg.x) * sigmoid_f(a0[1] + cv[bj][0][1]) * bf_hi(sg.x);
                        o[2] = bf_lo(yg.y) * sigmoid_f(a0[2] + cv[bj][0][2]) * bf_lo(sg.y); o[3] = bf_hi(yg.y) * sigmoid_f(a0[3] + cv[bj][0][3]) * bf_hi(sg.y);
                        o[4] = bf_lo(yg.z) * sigmoid_f(a1[0] + cv[bj][1][0]) * bf_lo(sg.z); o[5] = bf_hi(yg.z) * sigmoid_f(a1[1] + cv[bj][1][1]) * bf_hi(sg.z);
                        o[6] = bf_lo(yg.w) * sigmoid_f(a1[2] + cv[bj][1][2]) * bf_lo(sg.w); o[7] = bf_hi(yg.w) * sigmoid_f(a1[3] + cv[bj][1][3]) * bf_hi(sg.w);
                        u32x4 w; w.x = cvt_pk_bf16(o[0], o[1]); w.y = cvt_pk_bf16(o[2], o[3]); w.z = cvt_pk_bf16(o[4], o[5]); w.w = cvt_pk_bf16(o[6], o[7]);
                        *(u32x4*)(Y + (size_t)row * DM + col) = w;
                    } else {
                        const u32x4 sg = *(const u32x4*)(SG + (size_t)row * 1024 + 512 + col);
                        o[0] = a0[0] * cv[bj][0][0] * bf_lo(sg.x); o[1] = a0[1] * cv[bj][0][1] * bf_hi(sg.x); o[2] = a0[2] * cv[bj][0][2] * bf_lo(sg.y); o[3] = a0[3] * cv[bj][0][3] * bf_hi(sg.y);
                        o[4] = a1[0] * cv[bj][1][0] * bf_lo(sg.z); o[5] = a1[1] * cv[bj][1][1] * bf_hi(sg.z); o[6] = a1[2] * cv[bj][1][2] * bf_lo(sg.w); o[7] = a1[3] * cv[bj][1][3] * bf_hi(sg.w);
                        u32x4 w; w.x = cvt_pk_bf16(o[0], o[1]); w.y = cvt_pk_bf16(o[2], o[3]); w.z = cvt_pk_bf16(o[4], o[5]); w.w = cvt_pk_bf16(o[6], o[7]);
                        *(u32x4*)(Y + (size_t)row * DM + 1536 + col) = w;
                    } } }
    }
};
struct EpiOut {
    GAS unsigned char* ws; int l; int do_ssq;
    __device__ __forceinline__ void operator()(const f32x4 (&acc)[2][2][4][2], const Unit& u, int wr, int wc, int fr, int fq) const {
        const int row0 = u.pm * 256 + wr * 64 + fr, cw = u.cb + wc * 32 + 8 * fq;
        bf16_t* XB = (bf16_t*)(ws + WS_XB); u64* ssq_next = (u64*)(ws + WS_SSQ) + (size_t)(l + 1) * MTOK;
        float pick[2] = {0.f, 0.f};
#pragma unroll
        for (int ai = 0; ai < 2; ++ai)
#pragma unroll
            for (int m = 0; m < 4; ++m) { const int row = row0 + ai * 128 + m * 16; float s = 0.f;
#pragma unroll
                for (int bj = 0; bj < 2; ++bj) { const size_t off = (size_t)row * DM + cw + bj * 128; const u32x4 xb = *(const u32x4*)(XB + off);
                    const f32x4 a0 = acc[ai][bj][m][0], a1 = acc[ai][bj][m][1];
                    const float v0 = bf_lo(xb.x) + a0[0], v1 = bf_hi(xb.x) + a0[1], v2 = bf_lo(xb.y) + a0[2], v3 = bf_hi(xb.y) + a0[3];
                    const float v4 = bf_lo(xb.z) + a1[0], v5 = bf_hi(xb.z) + a1[1], v6 = bf_lo(xb.w) + a1[2], v7 = bf_hi(xb.w) + a1[3];
                    u32x4 w; w.x = cvt_pk_bf16(v0, v1); w.y = cvt_pk_bf16(v2, v3); w.z = cvt_pk_bf16(v4, v5); w.w = cvt_pk_bf16(v6, v7);
                    *(u32x4*)(XB + off) = w;
                    s += (v0 * v0 + v1 * v1) + (v2 * v2 + v3 * v3) + (v4 * v4 + v5 * v5) + (v6 * v6 + v7 * v7); }
                s = xor32_add(xor16_add(s));
                pick[ai] = (fq == m) ? s : pick[ai]; }
        if (do_ssq) {
#pragma unroll
            for (int ai = 0; ai < 2; ++ai) atomicAdd(ssq_next + row0 + ai * 128 + fq * 16, (u64)(pick[ai] * SSQ_SCALE)); }
    }
};

#define XB_TMO      128
#define XB_XCNT(j)  (256  + 64 * (j))
#define XB_XSUB(j)  (1280 + 64 * (j))
#define XB_XGEN(j)  (2304 + 64 * (j))
#define XB_TOP      3328
#define XB_TOPGEN   3392
#define XCD_BAR_WORDS 3456
#define XB_SPIN_CAP (1u << 18)
__device__ __forceinline__ unsigned xb_ld(unsigned* p)              { return __hip_atomic_load(p, __ATOMIC_RELAXED, __HIP_MEMORY_SCOPE_AGENT); }
__device__ __forceinline__ unsigned xb_add(unsigned* p, unsigned v) { return __hip_atomic_fetch_add(p, v, __ATOMIC_RELAXED, __HIP_MEMORY_SCOPE_AGENT); }
__device__ __forceinline__ unsigned xb_xcc_id() { return (unsigned)__builtin_amdgcn_s_getreg((3 << 11) | 20) & 0xFu; }
#define XB_SPIN(cond, bar) do { unsigned _sp = 0; while (cond) { __builtin_amdgcn_s_sleep(1); \
    if ((++_sp & 255u) == 0u) { if (xb_ld(&(bar)[XB_TMO])) break; if (_sp > XB_SPIN_CAP) { atomicAdd(&(bar)[XB_TMO], 1u); break; } } } } while (0)
struct XcdBarrier { unsigned* bar; unsigned x; volatile LAS unsigned* st; };
__device__ __forceinline__ XcdBarrier xcd_barrier_post(unsigned* bar, volatile LAS unsigned* st) {
    XcdBarrier b; b.bar = bar; b.x = xb_xcc_id(); b.st = st;
    if (threadIdx.x == 0) (void)xb_add(&bar[XB_XCNT(b.x)], 1u);
    return b;
}
__device__ __forceinline__ void xcd_barrier_complete(unsigned* bar, unsigned x, unsigned& nloc, unsigned& nx) {
    const unsigned G = gridDim.x * gridDim.y * gridDim.z;
    unsigned sum, cnt, mine, sp = 0u;
    for (;;) {
        sum = 0u; cnt = 0u; mine = 0u;
#pragma unroll
        for (unsigned j = 0; j < 16; ++j) { const unsigned c = xb_ld(&bar[XB_XCNT(j)]); sum += c; cnt += (c > 0u) ? 1u : 0u; mine = (j == x) ? c : mine; }
        if (sum == G) break;
        __builtin_amdgcn_s_sleep(1);
        if ((++sp & 255u) == 0u) { if (xb_ld(&bar[XB_TMO])) break; if (sp > XB_SPIN_CAP) { atomicAdd(&bar[XB_TMO], 1u); break; } }
    }
    nloc = mine > 0u ? mine : 1u; nx = cnt > 0u ? cnt : 1u;
}
__device__ __forceinline__ void xcd_barrier(const XcdBarrier& b) {
    asm volatile("s_waitcnt vmcnt(0)" ::: "memory");
    __syncthreads();
    if (threadIdx.x == 0) {
        unsigned* bar = b.bar;
        __builtin_amdgcn_s_waitcnt(0);
        unsigned nloc = b.st[0], nx = b.st[1];
        if (nloc == 0u) { xcd_barrier_complete(bar, b.x, nloc, nx); b.st[0] = nloc; b.st[1] = nx; }
        const unsigned old = xb_add(&bar[XB_XSUB(b.x)], 1u);
        const unsigned gen = old / nloc;
        if (old + 1u == (gen + 1u) * nloc) {
            __builtin_amdgcn_fence(__ATOMIC_RELEASE, "agent");
            asm volatile("s_waitcnt vmcnt(0)" ::: "memory");
            const unsigned og = xb_add(&bar[XB_TOP], 1u);
            const unsigned tg = og / nx;
            if (og + 1u == (tg + 1u) * nx) xb_add(&bar[XB_TOPGEN], 1u);
            else XB_SPIN(xb_ld(&bar[XB_TOPGEN]) == tg, bar);
            __builtin_amdgcn_fence(__ATOMIC_ACQUIRE, "agent");
            xb_add(&bar[XB_XGEN(b.x)], 1u);
            asm volatile("s_waitcnt vmcnt(0)" ::: "memory");
        } else {
            XB_SPIN(xb_ld(&bar[XB_XGEN(b.x)]) == gen, bar);
            __builtin_amdgcn_fence(__ATOMIC_ACQUIRE, "agent");
            asm volatile("s_waitcnt vmcnt(0)" ::: "memory");
        }
    }
    __syncthreads();
}

constexpr int NWAVES = 8, NTHR = 512;
constexpr int RING_BYTES = 131072, LDS_BYTES = 163840, LDSCTL_OFF = LDS_BYTES - 512;
struct Args { const float* in[21]; float* out; unsigned char* ws; int ph_lo, ph_hi; };
struct Frame {
    LAS unsigned char* lds; int tid, lane, wave, vcu, G, gw, NGW; GAS unsigned char* ws;
};
__device__ __forceinline__ Frame mkframe(GAS unsigned char* ws, LAS unsigned char* lds, int wave_s) {
    Frame F; int tid; asm volatile("v_mbcnt_lo_u32_b32 %0, -1, 0\n\tv_mbcnt_hi_u32_b32 %0, -1, %0" : "=v"(tid)); tid |= wave_s << 6; int bx = blockIdx.x, G = gridDim.x; asm volatile("" : "+s"(bx), "+s"(G));
    F.lds = lds; F.tid = tid; F.lane = tid & 63; F.wave = __builtin_amdgcn_readfirstlane(tid >> 6);
    F.G = G; F.vcu = (G % 8 == 0) ? (bx % 8) * (G / 8) + bx / 8 : bx;
    F.gw = F.vcu * 8 + F.wave; F.NGW = G * 8; F.ws = ws; return F;
}
#define MFMA16(a, b, c) __builtin_amdgcn_mfma_f32_16x16x32_bf16((a), (b), (c), 0, 0, 0)

constexpr int P0_SCR = 64 * 65 * 4;
struct TItem { const float* W; const float* gk; bf16_t* WT; int K, N, k0, n0src, rowdst; };
__device__ __forceinline__ void t_load(const TItem& d, int lane, f32x4 (&vv)[16]) {
    const int c4 = lane & 15, rsub = lane >> 4;
#pragma unroll
    for (int i = 0; i < 16; ++i) vv[i] = __builtin_nontemporal_load((const f32x4*)(d.W + (size_t)(d.k0 + 4 * i + rsub) * d.N + d.n0src + 4 * c4));
}
__device__ __forceinline__ void t_finish(const TItem& d, const f32x4 (&vv)[16], LAS float* scr, int lane) {
    const int c4 = lane & 15, rsub = lane >> 4;
#pragma unroll
    for (int i = 0; i < 16; ++i) { const int kk = 4 * i + rsub; f32x4 v = vv[i]; if (d.gk) v = v * d.gk[d.k0 + kk];
        scr[(4 * c4 + 0) * 65 + kk] = v[0]; scr[(4 * c4 + 1) * 65 + kk] = v[1]; scr[(4 * c4 + 2) * 65 + kk] = v[2]; scr[(4 * c4 + 3) * 65 + kk] = v[3]; }
    asm volatile("s_waitcnt lgkmcnt(0)" ::: "memory");
    const int ck = lane & 7;
#pragma unroll
    for (int j = 0; j < 8; ++j) { const int n = 8 * j + (lane >> 3); const LAS float* s = scr + n * 65 + 8 * ck;
        u32x4 o; o.x = cvt_pk_bf16(s[0], s[1]); o.y = cvt_pk_bf16(s[2], s[3]); o.z = cvt_pk_bf16(s[4], s[5]); o.w = cvt_pk_bf16(s[6], s[7]);
        *(u32x4*)(d.WT + (size_t)(d.rowdst + n) * d.K + d.k0 + 8 * ck) = o; }
    asm volatile("s_waitcnt lgkmcnt(0)" ::: "memory");
}
__device__ __forceinline__ void win_map(int s, int& isB, int& row) {
    isB = 0;
    if (s < 512) { isB = 1; row = s; }
    else if (s < 1536) { const int j = (s - 512) >> 7, i = (s - 512) & 127; row = 256 * j + i; }
    else if (s < 2560) { isB = 1; row = 512 + (s - 1536); }
    else if (s < 3072) row = 2048 + (s - 2560);
    else if (s < 3584) row = 2560 + (s - 3072);
    else if (s < 4608) { const int j = (s - 3584) >> 7, i = (s - 3584) & 127; row = 256 * j + 128 + i; }
    else row = 3072 + (s - 4608);
}
__device__ __forceinline__ void p0_prologue(const Frame& F, const Args& a) {
    const float* x = a.in[0]; const float* norm_g = a.in[1]; const float* w_in = a.in[2];
    const float *lam_re = a.in[3], *lam_im = a.in[4], *b_re = a.in[5], *b_im = a.in[6], *log_dt = a.in[10];
    const float *w_glu = a.in[11], *w_s = a.in[15], *w_pool = a.in[17], *w_out = a.in[19];
    GAS unsigned char* ws = F.ws;
    LAS float* scr = (LAS float*)(F.lds + F.wave * P0_SCR);
    constexpr int I_IN = 32 * 72, I_Q = 32 * 16, I_OUT = 32 * 32, I_GLU = 8 * 8, I_T = I_IN + I_OUT + I_GLU;
    for (int it = F.gw; it < 2 * I_Q; it += F.NGW) {
        const int l = it / I_Q, r = it - l * I_Q;
        const int kb = r >> 4, nb = r & 15, dq = 32 * nb, g = dq >> 7, k0 = 64 * kb, cc = F.lane & 15, qq = F.lane >> 4, row = 2048 + dq;
        bf16_t* WT = (bf16_t*)(ws + WS_WA) + (size_t)l * WA_ROWS * DM;
        f32x4 accq[4][2];
#pragma unroll
        for (int mt = 0; mt < 4; ++mt) { accq[mt][0] = (f32x4){0.f, 0.f, 0.f, 0.f}; accq[mt][1] = (f32x4){0.f, 0.f, 0.f, 0.f}; }
#pragma unroll
        for (int ks = 0; ks < 4; ++ks) {
            bf16x8 bq[2];
#pragma unroll
            for (int nt = 0; nt < 2; ++nt) { const float* wp = w_pool + (((size_t)l * 4 + g) * 128 + 32 * ks + 8 * qq) * 128 + (dq & 127) + 16 * nt + cc; u32x4 p;
                p.x = pk_bf16_c(wp[0], wp[128]); p.y = pk_bf16_c(wp[256], wp[384]); p.z = pk_bf16_c(wp[512], wp[640]); p.w = pk_bf16_c(wp[768], wp[896]); bq[nt] = __builtin_bit_cast(bf16x8, p); }
#pragma unroll
            for (int mt = 0; mt < 4; ++mt) { const int k = k0 + 16 * mt + cc; const float gs = norm_g[l * DM + k];
                const f32x4* ap = (const f32x4*)(w_in + ((size_t)l * DM + k) * INC + 2560 + 128 * g + 32 * ks + 8 * qq); const f32x4 a0 = ap[0] * gs, a1 = ap[1] * gs; u32x4 p;
                p.x = pk_bf16_c(a0[0], a0[1]); p.y = pk_bf16_c(a0[2], a0[3]); p.z = pk_bf16_c(a1[0], a1[1]); p.w = pk_bf16_c(a1[2], a1[3]); const bf16x8 aq = __builtin_bit_cast(bf16x8, p);
                accq[mt][0] = MFMA16(aq, bq[0], accq[mt][0]); accq[mt][1] = MFMA16(aq, bq[1], accq[mt][1]); } }
#pragma unroll
        for (int mt = 0; mt < 4; ++mt)
#pragma unroll
            for (int nt = 0; nt < 2; ++nt) { u32x2 o; o.x = pk_bf16_c(accq[mt][nt][0], accq[mt][nt][1]); o.y = pk_bf16_c(accq[mt][nt][2], accq[mt][nt][3]);
                *(u32x2*)(WT + (size_t)(row + 16 * nt + cc) * DM + k0 + 16 * mt + 4 * qq) = o; }
    }
    {
#define T_DECODE(t_, d_) do { int r_ = (t_); const int l_ = r_ / I_T; r_ -= l_ * I_T; \
        if (r_ < I_IN) { const int kb_ = r_ / 72, j_ = r_ % 72, sb_ = 64 * (j_ < 40 ? j_ : j_ + 8); int isB_, row_; win_map(sb_, isB_, row_); \
            d_.W = w_in + (size_t)l_ * DM * INC; d_.gk = norm_g + l_ * DM; d_.WT = isB_ ? (bf16_t*)(ws + WS_WB) + (size_t)l_ * WB_ROWS * DM : (bf16_t*)(ws + WS_WA) + (size_t)l_ * WA_ROWS * DM; \
            d_.K = DM; d_.N = INC; d_.k0 = 64 * kb_; d_.n0src = sb_; d_.rowdst = row_; } \
        else if (r_ < I_IN + I_OUT) { r_ -= I_IN; d_.W = w_out + (size_t)l_ * DM * DM; d_.gk = nullptr; d_.WT = (bf16_t*)(ws + WS_WOUT) + (size_t)l_ * DM * DM; d_.K = DM; d_.N = DM; d_.k0 = 64 * (r_ >> 5); d_.n0src = 64 * (r_ & 31); d_.rowdst = d_.n0src; } \
        else { r_ -= I_IN + I_OUT; d_.W = w_glu + (size_t)l_ * 512 * 512; d_.gk = nullptr; d_.WT = (bf16_t*)(ws + WS_WGLU) + (size_t)l_ * 512 * 512; d_.K = 512; d_.N = 512; d_.k0 = 64 * (r_ >> 3); d_.n0src = 64 * (r_ & 7); d_.rowdst = d_.n0src; } } while (0)
        constexpr int NT = 2 * I_T;
        int t = (F.gw + F.NGW / 2) % F.NGW; TItem dA, dB; f32x4 vA[16], vB[16];
        bool hasA = t < NT; if (hasA) { T_DECODE(t, dA); t_load(dA, F.lane, vA); }
        while (hasA) {
            const int t2 = t + F.NGW; const bool hasB = t2 < NT; if (hasB) { T_DECODE(t2, dB); t_load(dB, F.lane, vB); }
            t_finish(dA, vA, scr, F.lane);
            if (!hasB) break;
            const int t3 = t2 + F.NGW; hasA = t3 < NT; if (hasA) { T_DECODE(t3, dA); t_load(dA, F.lane, vA); }
            t_finish(dB, vB, scr, F.lane);
            t = t3;
        }
#undef T_DECODE
    }
    { bf16_t* XB = (bf16_t*)(ws + WS_XB); u64* ssq0 = (u64*)(ws + WS_SSQ);
      for (int m2 = F.gw; m2 < MTOK / 2; m2 += F.NGW) {
          f32x4 v[2][4][2];
#pragma unroll
          for (int rr = 0; rr < 2; ++rr) { const f32x4* xr = (const f32x4*)(x + (size_t)(2 * m2 + rr) * DM) + 2 * F.lane;
#pragma unroll
              for (int j = 0; j < 4; ++j) { v[rr][j][0] = __builtin_nontemporal_load(xr + 128 * j); v[rr][j][1] = __builtin_nontemporal_load(xr + 128 * j + 1); } }
#pragma unroll
          for (int rr = 0; rr < 2; ++rr) { u32x4* o = (u32x4*)(XB + (size_t)(2 * m2 + rr) * DM) + F.lane; float s = 0.f;
#pragma unroll
              for (int j = 0; j < 4; ++j) { const f32x4 a = v[rr][j][0], b = v[rr][j][1];
                  s += (a[0] * a[0] + a[1] * a[1]) + (a[2] * a[2] + a[3] * a[3]) + (b[0] * b[0] + b[1] * b[1]) + (b[2] * b[2] + b[3] * b[3]);
                  u32x4 w; w.x = cvt_pk_bf16(a[0], a[1]); w.y = cvt_pk_bf16(a[2], a[3]); w.z = cvt_pk_bf16(b[0], b[1]); w.w = cvt_pk_bf16(b[2], b[3]); o[64 * j] = w; }
              s = wave_sum(s);
              if (F.lane == 0) ssq0[2 * m2 + rr] = (u64)(s * SSQ_SCALE); }
      } }
    const int gt = F.vcu * NTHR + F.tid, NGT = F.G * NTHR;
    { u64* ssq = (u64*)(ws + WS_SSQ) + MTOK; for (int i = gt; i < 2 * MTOK; i += NGT) ssq[i] = 0ull;
      u64* lns = (u64*)(ws + WS_LNS); for (int i = gt; i < 2 * MTOK * 2; i += NGT) lns[i] = 0ull; }
    { float* PAR = (float*)(ws + WS_PAR);
      for (int i = gt; i < PAR_N; i += NGT) { float v;
          if (i < PAR_LNG) v = a.in[12][i - PAR_BGLU]; else if (i < PAR_LNB) v = a.in[13][i - PAR_LNG]; else if (i < PAR_BS) v = a.in[14][i - PAR_LNB];
          else if (i < PAR_PSC) v = a.in[16][i - PAR_BS]; else if (i < PAR_FG) v = a.in[18][i - PAR_PSC]; else v = a.in[20][i - PAR_FG];
          PAR[i] = v; } }
    { bf16_t* WSG = (bf16_t*)(ws + WS_WSG);
      for (int i = gt; i < 2 * 8 * 128 * 128; i += NGT) { const int s = i & 127, t = (i >> 7) & 127; WSG[i] = (bf16_t)(cvt_pk_bf16(s <= t ? w_s[i] : 0.f, 0.f) & 0xffffu); }
    }
    { f32x2* POW = (f32x2*)(ws + WS_POW); f32x2* BBAR = (f32x2*)(ws + WS_BBAR);
      for (int e = gt; e < 2 * S5G * S5P * 17; e += NGT) { const int i = e / 17, n = e - 17 * i; const double dt = exp((double)log_dt[i >> 6]);
          const double mg = exp((double)lam_re[i] * dt * n), th = (double)lam_im[i] * dt * n; POW[e] = (f32x2){(float)(mg * cos(th)), (float)(mg * sin(th))}; }
      for (int i = gt; i < 2 * S5G * S5P; i += NGT) { const int lg = i >> 6;
          const double dt = exp((double)log_dt[lg]), lr = (double)lam_re[i], li = (double)lam_im[i];
          const double mg = exp(lr * dt), th = li * dt, nr = mg * cos(th) - 1.0, ni = mg * sin(th), den = lr * lr + li * li;
          const double qr = (nr * lr + ni * li) / den, qi = (ni * lr - nr * li) / den;
          for (int h = 0; h < 16; ++h) { const double br = (double)b_re[(size_t)i * 16 + h], bi = (double)b_im[(size_t)i * 16 + h];
              BBAR[(size_t)i * 16 + h] = (f32x2){(float)(qr * br - qi * bi), (float)(qr * bi + qi * br)}; } } }
}
__device__ __forceinline__ void s5_tables_a(const Frame& F, const Args& a) {
    const float *c_re = a.in[7], *c_im = a.in[8], *d_skip = a.in[9];
    GAS unsigned char* ws = F.ws; const f32x2* POW = (const f32x2*)(ws + WS_POW); const f32x2* BBAR = (const f32x2*)(ws + WS_BBAR);
    const int gt = F.vcu * NTHR + F.tid, NGT = F.G * NTHR;
    float* KT = (float*)(ws + WS_KT);
    for (int i = gt; i < 2 * S5G * 16 * 256; i += NGT) {
        const int h2 = i & 15, h = (i >> 4) & 15, d = (i >> 8) & 15, lg = i >> 12; float s = 0.f;
        for (int p = 0; p < 64; ++p) { const f32x2 pw = POW[((size_t)lg * 64 + p) * 17 + d], bb = BBAR[((size_t)lg * 64 + p) * 16 + h2];
            const float cr = c_re[((size_t)lg * 16 + h) * 64 + p], ci = c_im[((size_t)lg * 16 + h) * 64 + p];
            const float zr = pw.x * bb.x - pw.y * bb.y, zi = pw.x * bb.y + pw.y * bb.x; s += cr * zr - ci * zi; }
        if (d == 0 && h == h2) s += d_skip[lg * 16 + h];
        KT[i] = s; }
    bf16_t* WEND = (bf16_t*)(ws + WS_WEND);
    for (int i = gt; i < 2 * S5G * 128 * 256; i += NGT) {
        const int t = i & 15, h = (i >> 4) & 15, p2 = (i >> 8) & 127, lg = i >> 15, p = p2 & 63;
        const f32x2 pw = POW[((size_t)lg * 64 + p) * 17 + (15 - t)], bb = BBAR[((size_t)lg * 64 + p) * 16 + h];
        const float v = p2 < 64 ? pw.x * bb.x - pw.y * bb.y : pw.x * bb.y + pw.y * bb.x;
        WEND[i] = (bf16_t)(cvt_pk_bf16(v, 0.f) & 0xffffu); }
    bf16_t* WS5 = (bf16_t*)(ws + WS_WS5);
    for (int i = gt; i < 2 * S5G * 256 * 128; i += NGT) {
        const int p2 = i & 127, row = (i >> 7) & 255, lg = i >> 15, p = p2 & 63, rr = row >> 4, t = 4 * (rr >> 2) + ((row >> 2) & 3), h = 4 * (rr & 3) + (row & 3);
        const f32x2 pw = POW[((size_t)lg * 64 + p) * 17 + (t + 1)];
        const float cr = c_re[((size_t)lg * 16 + h) * 64 + p], ci = c_im[((size_t)lg * 16 + h) * 64 + p];
        const float v = p2 < 64 ? cr * pw.x - ci * pw.y : -(cr * pw.y + ci * pw.x);
        WS5[((size_t)lg * 256 + row) * 384 + 256 + p2] = (bf16_t)(cvt_pk_bf16(v, 0.f) & 0xffffu); }
}
__device__ __forceinline__ void s5_tables_b(const Frame& F) {
    GAS unsigned char* ws = F.ws; const float* KT = (const float*)(ws + WS_KT); bf16_t* WS5 = (bf16_t*)(ws + WS_WS5);
    const int gt = F.vcu * NTHR + F.tid, NGT = F.G * NTHR;
    for (int i = gt; i < 2 * S5G * 256 * 256; i += NGT) {
        const int k = i & 255, row = (i >> 8) & 255, lg = i >> 16, rr = row >> 4, t = 4 * (rr >> 2) + ((row >> 2) & 3), h = 4 * (rr & 3) + (row & 3), h2 = k >> 4, t2 = k & 15;
        const float v = t2 <= t ? KT[(((size_t)lg * 16 + (t - t2)) * 16 + h) * 16 + h2] : 0.f;
        WS5[((size_t)lg * 256 + row) * 384 + k] = (bf16_t)(cvt_pk_bf16(v, 0.f) & 0xffffu); }
}

__device__ __forceinline__ void p2_ln(const Frame& F, const float* ln_g, const float* ln_b, bf16_t* DST) {
    bf16_t* GVT = (bf16_t*)(F.ws + WS_GVT);
    LAS float* red = (LAS float*)F.lds;
    LAS float* stat = (LAS float*)(F.lds + 32768);
    const int o = F.tid & 15, r0 = F.tid >> 4;
    for (int c = F.vcu; c < MTOK / 128; c += F.G) {
        bf16_t* gp = GVT + (size_t)r0 * MTOK + c * 128 + 8 * o; bf16_t* dp = DST + (size_t)r0 * MTOK + c * 128 + 8 * o;
        float s[8], q[8];
#pragma unroll
        for (int j = 0; j < 8; ++j) { s[j] = 0.f; q[j] = 0.f; }
#pragma unroll 4
        for (int i = 0; i < 32; ++i) { const u32x4 v = *(const u32x4*)(gp + (size_t)(32 * i) * MTOK);
            const float e0 = bf_lo(v.x), e1 = bf_hi(v.x), e2 = bf_lo(v.y), e3 = bf_hi(v.y), e4 = bf_lo(v.z), e5 = bf_hi(v.z), e6 = bf_lo(v.w), e7 = bf_hi(v.w);
            s[0] += e0; q[0] += e0 * e0; s[1] += e1; q[1] += e1 * e1; s[2] += e2; q[2] += e2 * e2; s[3] += e3; q[3] += e3 * e3;
            s[4] += e4; q[4] += e4 * e4; s[5] += e5; q[5] += e5 * e5; s[6] += e6; q[6] += e6 * e6; s[7] += e7; q[7] += e7 * e7; }
#pragma unroll
        for (int j = 0; j < 8; ++j) { red[(r0 * 128 + 8 * o + j) * 2] = s[j]; red[(r0 * 128 + 8 * o + j) * 2 + 1] = q[j]; }
        __syncthreads();
        if (F.tid < 128) { float ss = 0.f, qq = 0.f;
            for (int r = 0; r < 32; ++r) { ss += red[(r * 128 + F.tid) * 2]; qq += red[(r * 128 + F.tid) * 2 + 1]; }
            const float mean = ss * (1.0f / 1024.0f), var = fmaxf(qq * (1.0f / 1024.0f) - mean * mean, 0.f);
            stat[F.tid * 2] = mean; stat[F.tid * 2 + 1] = rsqrtf(var + LN_EPS); }
        __syncthreads();
        float mu[8], rs[8];
#pragma unroll
        for (int j = 0; j < 8; ++j) { mu[j] = stat[(8 * o + j) * 2]; rs[j] = stat[(8 * o + j) * 2 + 1]; }
#pragma unroll 4
        for (int i = 0; i < 32; ++i) { const int ch = 32 * i + r0; const float g = ln_g[ch], b = ln_b[ch]; const u32x4 v = *(const u32x4*)(gp + (size_t)(32 * i) * MTOK); u32x4 w;
            w.x = cvt_pk_bf16((bf_lo(v.x) - mu[0]) * rs[0] * g + b, (bf_hi(v.x) - mu[1]) * rs[1] * g + b);
            w.y = cvt_pk_bf16((bf_lo(v.y) - mu[2]) * rs[2] * g + b, (bf_hi(v.y) - mu[3]) * rs[3] * g + b);
            w.z = cvt_pk_bf16((bf_lo(v.z) - mu[4]) * rs[4] * g + b, (bf_hi(v.z) - mu[5]) * rs[5] * g + b);
            w.w = cvt_pk_bf16((bf_lo(v.w) - mu[6]) * rs[6] * g + b, (bf_hi(v.w) - mu[7]) * rs[7] * g + b);
            *(u32x4*)(dp + (size_t)(32 * i) * MTOK) = w; }
        __syncthreads();
    }
}
constexpr int SGU_ROWB = 272;
constexpr int SGU_TILE = 128 * SGU_ROWB;
__device__ __forceinline__ void m1_sgu(const Frame& F, int layer) {
    const bf16_t* GVT = (const bf16_t*)(F.ws + WS_GVT); const bf16_t* UG = (const bf16_t*)(F.ws + WS_UG); bf16_t* Y = (bf16_t*)(F.ws + WS_Y);
    const bf16_t* WSG = (const bf16_t*)(F.ws + WS_WSG) + (size_t)layer * 8 * 128 * 128;
    const float* PAR = (const float*)(F.ws + WS_PAR);
    const float* ln_g = PAR + PAR_LNG + layer * SGUW; const float* ln_b = PAR + PAR_LNB + layer * SGUW; const float* b_s = PAR + PAR_BS + layer * 1024;
    const long long* lns = (const long long*)(F.ws + WS_LNS) + (size_t)layer * MTOK * 2;
    LAS unsigned char* tiles = F.lds;
    const int o = F.tid & 15, r0 = F.tid >> 4, c = F.lane & 15, q = F.lane >> 4, w = F.wave;
    for (int ch = F.vcu; ch < MTOK / 128; ch += F.G) {
        const bf16_t* gp = GVT + (size_t)r0 * MTOK + ch * 128 + 8 * o;
        float mu[8], rs[8];
#pragma unroll
        for (int j = 0; j < 8; ++j) { const long long* sp = lns + (size_t)(ch * 128 + 8 * o + j) * 2; const float mean = (float)sp[0] * (1.0f / (LNS_SCALE * 1024.0f)), ex2 = (float)sp[1] * (1.0f / (LNS_SCALE * 1024.0f));
            mu[j] = mean; rs[j] = rsqrtf(fmaxf(ex2 - mean * mean, 0.f) + LN_EPS); }
        u32x4 stg[2][4]; bf16x8 wcur[2][4];
#pragma unroll
        for (int hh = 0; hh < 2; ++hh) { const int t0n = 16 * ((w + hh) & 7);
#pragma unroll
            for (int i = 0; i < 4; ++i) stg[hh][i] = __builtin_nontemporal_load((const u32x4*)(gp + (size_t)(hh * 128 + 32 * i) * MTOK));
#pragma unroll
            for (int ks = 0; ks < 4; ++ks) wcur[hh][ks] = *(const bf16x8*)(WSG + ((size_t)hh * 128 + t0n + c) * 128 + 8 * q + 32 * ks); }
#pragma unroll 1
        for (int hp = 0; hp < 4; ++hp) {
#pragma unroll
            for (int hh = 0; hh < 2; ++hh) { LAS unsigned char* tile = tiles + ((hp & 1) * 2 + hh) * SGU_TILE; const int h = 2 * hp + hh;
#pragma unroll
                for (int i = 0; i < 4; ++i) { const int d = r0 + 32 * i, chn = h * 128 + d, rho = 16 * (2 * (d >> 5) + ((d >> 2) & 1)) + 4 * ((d >> 3) & 3) + (d & 3); const float g = ln_g[chn], b = ln_b[chn]; const u32x4 sv = stg[hh][i]; u32x4 wv;
                    wv.x = cvt_pk_bf16((bf_lo(sv.x) - mu[0]) * rs[0] * g + b, (bf_hi(sv.x) - mu[1]) * rs[1] * g + b);
                    wv.y = cvt_pk_bf16((bf_lo(sv.y) - mu[2]) * rs[2] * g + b, (bf_hi(sv.y) - mu[3]) * rs[3] * g + b);
                    wv.z = cvt_pk_bf16((bf_lo(sv.z) - mu[4]) * rs[4] * g + b, (bf_hi(sv.z) - mu[5]) * rs[5] * g + b);
                    wv.w = cvt_pk_bf16((bf_lo(sv.w) - mu[6]) * rs[6] * g + b, (bf_hi(sv.w) - mu[7]) * rs[7] * g + b);
                    *(LAS u32x4*)(tile + rho * SGU_ROWB + 16 * o) = wv; } }
            u32x4 ugv[2][4];
#pragma unroll
            for (int hh = 0; hh < 2; ++hh) { const int h = 2 * hp + hh, m = ch * 128 + 16 * ((w + h) & 7) + c;
#pragma unroll
                for (int j = 0; j < 4; ++j) ugv[hh][j] = __builtin_nontemporal_load((const u32x4*)(UG + (size_t)m * 1024 + h * 128 + 32 * j + 8 * q)); }
            if (hp < 3) {
#pragma unroll
                for (int hh = 0; hh < 2; ++hh) { const int h = 2 * (hp + 1) + hh;
#pragma unroll
                    for (int i = 0; i < 4; ++i) stg[hh][i] = __builtin_nontemporal_load((const u32x4*)(gp + (size_t)(h * 128 + 32 * i) * MTOK)); } }
            __syncthreads();
            f32x4 acc[2][8];
#pragma unroll
            for (int hh = 0; hh < 2; ++hh) { const int h = 2 * hp + hh, tt = (w + h) & 7, nks = (tt >> 1) + 1;
                const LAS unsigned char* ab = tiles + ((hp & 1) * 2 + hh) * SGU_TILE + c * SGU_ROWB + 16 * q;
#pragma unroll
                for (int r = 0; r < 8; ++r) acc[hh][r] = (f32x4){0.f, 0.f, 0.f, 0.f};
#pragma unroll
                for (int ks = 0; ks < 4; ++ks) { if (ks < nks) {
#pragma unroll
                    for (int r = 0; r < 8; ++r) { const bf16x8 av = *(const LAS bf16x8*)(ab + (16 * r) * SGU_ROWB + 64 * ks); acc[hh][r] = MFMA16(av, wcur[hh][ks], acc[hh][r]); } } } }
            if (hp < 3) {
#pragma unroll
                for (int hh = 0; hh < 2; ++hh) { const int h = 2 * (hp + 1) + hh, t0n = 16 * ((w + h) & 7);
#pragma unroll
                    for (int ks = 0; ks < 4; ++ks) wcur[hh][ks] = *(const bf16x8*)(WSG + ((size_t)h * 128 + t0n + c) * 128 + 8 * q + 32 * ks); } }
#pragma unroll
            for (int hh = 0; hh < 2; ++hh) { const int h = 2 * hp + hh, t0 = 16 * ((w + h) & 7), m = ch * 128 + t0 + c;
                const float bs = b_s[h * 128 + t0 + c];
#pragma unroll
                for (int j = 0; j < 4; ++j) { const int col = h * 128 + 32 * j + 8 * q; const u32x4 ug = ugv[hh][j]; u32x4 wv;
                    wv.x = cvt_pk_bf16((acc[hh][2 * j][0] + bs) * bf_lo(ug.x), (acc[hh][2 * j][1] + bs) * bf_hi(ug.x)); wv.y = cvt_pk_bf16((acc[hh][2 * j][2] + bs) * bf_lo(ug.y), (acc[hh][2 * j][3] + bs) * bf_hi(ug.y));
                    wv.z = cvt_pk_bf16((acc[hh][2 * j + 1][0] + bs) * bf_lo(ug.z), (acc[hh][2 * j + 1][1] + bs) * bf_hi(ug.z)); wv.w = cvt_pk_bf16((acc[hh][2 * j + 1][2] + bs) * bf_lo(ug.w), (acc[hh][2 * j + 1][3] + bs) * bf_hi(ug.w));
                    *(u32x4*)(Y + (size_t)m * DM + 512 + col) = wv; } }
        }
        __syncthreads();
    }
}
constexpr int WE_ROWB = 528;
__device__ __forceinline__ void m1_send(const Frame& F, int layer) {
    const bf16_t* WEND = (const bf16_t*)(F.ws + WS_WEND) + (size_t)layer * S5G * 128 * 256;
    const bf16_t* XAT = (const bf16_t*)(F.ws + WS_XA); float* SE = (float*)(F.ws + WS_SE);
    const int c = F.lane & 15, q = F.lane >> 4, w = F.wave;
    for (int it = F.vcu; it < S5G * 8; it += F.G) {
        const int g = it & 31, rg = it >> 5;
        const bf16_t* xb = XAT + (size_t)(16 * g + (q >> 1)) * MTOK + 8 * (q & 1);
        bf16x8 bx[2][8];
#pragma unroll
        for (int s = 0; s < 2; ++s)
#pragma unroll
            for (int ks = 0; ks < 8; ++ks) bx[s][ks] = *(const bf16x8*)(xb + (size_t)(2 * ks) * MTOK + (size_t)((16 * rg + 2 * w + s) * 16 + c) * 16);
#pragma unroll
        for (int i = 0; i < 8; ++i) { const int e = F.tid + 512 * i, row = e >> 5, ch = e & 31;
            *(LAS u32x4*)(F.lds + row * WE_ROWB + 16 * ch) = *(const u32x4*)(WEND + ((size_t)g * 128 + row) * 256 + 8 * ch); }
        __syncthreads();
#pragma unroll
        for (int s = 0; s < 2; ++s) { const int seg = (16 * rg + 2 * w + s) * 16 + c;
#pragma unroll
            for (int r = 0; r < 8; ++r) { f32x4 acc = (f32x4){0.f, 0.f, 0.f, 0.f};
#pragma unroll
                for (int ks = 0; ks < 8; ++ks) { const bf16x8 aw = *(const LAS bf16x8*)(F.lds + (16 * r + c) * WE_ROWB + 64 * ks + 16 * q); acc = MFMA16(aw, bx[s][ks], acc); }
                *(f32x4*)(SE + ((size_t)seg * 32 + g) * 128 + 16 * r + 4 * q) = acc; } }
        __syncthreads();
    }
}
template <int W> __device__ __forceinline__ void pool_item(const Frame& F, int layer, int r4, int g) {
    constexpr int R = 8;
    const bf16_t* Q = (const bf16_t*)(F.ws + WS_XC); const bf16_t* SG = (const bf16_t*)(F.ws + WS_SG); bf16_t* Y = (bf16_t*)(F.ws + WS_Y);
    const float* psc = (const float*)(F.ws + WS_PAR) + PAR_PSC + layer * POOLW;
    const int o16 = F.lane & 15, sub = F.lane >> 4, m0 = (r4 * 4 + sub) * R, tl0 = m0 & (SEQ - 1), col = g * 128 + 8 * o16;
    u32x4 xs[W - 1 + R];
#pragma unroll
    for (int k = 0; k < W - 1 + R; ++k) { const int tl = tl0 - (W - 1) + k;
        xs[k] = tl >= 0 ? *(const u32x4*)(Q + (size_t)(m0 - (W - 1) + k) * 512 + col) : (u32x4){0u, 0u, 0u, 0u}; }
    const f32x4 p0 = *(const f32x4*)(psc + col), p1 = *(const f32x4*)(psc + col + 4);
    float S[8];
#pragma unroll
    for (int e = 0; e < 8; ++e) S[e] = 0.f;
#pragma unroll
    for (int k = 0; k < W - 1; ++k) { S[0] += bf_lo(xs[k].x); S[1] += bf_hi(xs[k].x); S[2] += bf_lo(xs[k].y); S[3] += bf_hi(xs[k].y); S[4] += bf_lo(xs[k].z); S[5] += bf_hi(xs[k].z); S[6] += bf_lo(xs[k].w); S[7] += bf_hi(xs[k].w); }
#pragma unroll
    for (int i = 0; i < R; ++i) { const u32x4 xv = xs[i + W - 1];
        const float xe[8] = {bf_lo(xv.x), bf_hi(xv.x), bf_lo(xv.y), bf_hi(xv.y), bf_lo(xv.z), bf_hi(xv.z), bf_lo(xv.w), bf_hi(xv.w)};
#pragma unroll
        for (int e = 0; e < 8; ++e) S[e] += xe[e];
        const int cnt = tl0 + i + 1 < W ? tl0 + i + 1 : W; const float inv = 1.0f / (float)cnt;
        const u32x4 sg = __builtin_nontemporal_load((const u32x4*)(SG + (size_t)(m0 + i) * 1024 + 512 + col)); u32x4 wv;
        wv.x = cvt_pk_bf16((S[0] * inv - xe[0]) * p0[0] * bf_lo(sg.x), (S[1] * inv - xe[1]) * p0[1] * bf_hi(sg.x));
        wv.y = cvt_pk_bf16((S[2] * inv - xe[2]) * p0[2] * bf_lo(sg.y), (S[3] * inv - xe[3]) * p0[3] * bf_hi(sg.y));
        wv.z = cvt_pk_bf16((S[4] * inv - xe[4]) * p1[0] * bf_lo(sg.z), (S[5] * inv - xe[5]) * p1[1] * bf_hi(sg.z));
        wv.w = cvt_pk_bf16((S[6] * inv - xe[6]) * p1[2] * bf_lo(sg.w), (S[7] * inv - xe[7]) * p1[3] * bf_hi(sg.w));
        *(u32x4*)(Y + (size_t)(m0 + i) * DM + 1536 + col) = wv;
        const u32x4 ov = xs[i];
        S[0] -= bf_lo(ov.x); S[1] -= bf_hi(ov.x); S[2] -= bf_lo(ov.y); S[3] -= bf_hi(ov.y); S[4] -= bf_lo(ov.z); S[5] -= bf_hi(ov.z); S[6] -= bf_lo(ov.w); S[7] -= bf_hi(ov.w); }
}
__device__ __forceinline__ void p2_pool(const Frame& F, int layer) {
    for (int it = F.gw; it < (MTOK / 32) * 4; it += F.NGW) { const int g = it & 3, r4 = it >> 2;
        if (g == 0) pool_item<2>(F, layer, r4, 0); else if (g == 1) pool_item<4>(F, layer, r4, 1); else if (g == 2) pool_item<8>(F, layer, r4, 2); else pool_item<16>(F, layer, r4, 3); }
}

constexpr int CAR_ROWB = 272;
__device__ __forceinline__ void m3_s5(const Frame& F, int layer) {
    const f32x2* POW = (const f32x2*)(F.ws + WS_POW); const float* SE = (const float*)(F.ws + WS_SE);
    const bf16_t* WS5 = (const bf16_t*)(F.ws + WS_WS5) + (size_t)layer * S5G * 256 * 384;
    const bf16_t* XAT = (const bf16_t*)(F.ws + WS_XA); bf16_t* YG = (bf16_t*)(F.ws + WS_YG);
    LAS unsigned char* car = F.lds;
    LAS f32x2* ends = (LAS f32x2*)(F.lds + 256 * CAR_ROWB);
    const int c = F.lane & 15, q = F.lane >> 4, w = F.wave, p = F.lane, sc = F.wave;
    for (int it = F.vcu; it < NB * S5G * 2; it += F.G) {
        const int b = it >> 6, g = (it >> 1) & 31, half = it & 1;
        { const f32x2 l16 = POW[(((size_t)layer * S5G + g) * 64 + p) * 17 + 16];
          const float* e0 = SE + ((size_t)(b * SEGB + sc * 64) * 32 + g) * 128 + p;
          float er[64], ei[64];
          const bool need = sc < 4 * (half + 1);
          if (need) {
#pragma unroll
              for (int j = 0; j < 64; ++j) { er[j] = e0[(size_t)j * 4096]; ei[j] = e0[(size_t)j * 4096 + 64]; } }
          else {
#pragma unroll
              for (int j = 0; j < 64; ++j) { er[j] = 0.f; ei[j] = 0.f; } }
          float sr = 0.f, si = 0.f;
#pragma unroll
          for (int j = 0; j < 64; ++j) { const float nr = l16.x * sr - l16.y * si + er[j], ni = l16.x * si + l16.y * sr + ei[j]; sr = nr; si = ni; }
          ends[sc * 64 + p] = (f32x2){sr, si};
          float mr = l16.x, mi = l16.y;
#pragma unroll
          for (int k = 0; k < 6; ++k) { const float tr = mr * mr - mi * mi, ti = 2.f * mr * mi; mr = tr; mi = ti; }
          __syncthreads();
          float cr = 0.f, ci = 0.f;
          for (int k = 0; k < sc; ++k) { const f32x2 e = ends[k * 64 + p]; const float nr = mr * cr - mi * ci + e.x, ni = mr * ci + mi * cr + e.y; cr = nr; ci = ni; }
          if ((sc >> 2) == half) { sr = cr; si = ci; LAS unsigned char* rowp = car + ((sc & 3) * 64) * CAR_ROWB + 2 * p;
#pragma unroll
              for (int j = 0; j < 64; ++j) { *(LAS bf16_t*)(rowp + j * CAR_ROWB) = (bf16_t)f2bf_rne(sr); *(LAS bf16_t*)(rowp + j * CAR_ROWB + 128) = (bf16_t)f2bf_rne(si);
                  const float nr = l16.x * sr - l16.y * si + er[j], ni = l16.x * si + l16.y * sr + ei[j]; sr = nr; si = ni; } }
          __syncthreads(); }
        bf16x8 aw[2][12];
#pragma unroll
        for (int rr = 0; rr < 2; ++rr)
#pragma unroll
            for (int ks = 0; ks < 12; ++ks) aw[rr][ks] = *(const bf16x8*)(WS5 + ((size_t)g * 256 + 16 * (2 * w + rr) + c) * 384 + 32 * ks + 8 * q);
        const bf16_t* xw = XAT + (size_t)(16 * g + 2 * w + (q >> 1)) * MTOK + 8 * (q & 1);
        const int segbase = b * SEGB + half * 256;
        LAS unsigned char* xfr = F.lds + 256 * CAR_ROWB + 4096;
        u32x4 pre[4];
#pragma unroll
        for (int s = 0; s < 4; ++s) pre[s] = *(const u32x4*)(xw + (size_t)(segbase + s * 16 + c) * 16);
#pragma unroll 1
        for (int sg4 = 0; sg4 < 4; ++sg4) {
#pragma unroll
            for (int s = 0; s < 4; ++s) *(LAS u32x4*)(xfr + ((s * 8 + w) * 64 + F.lane) * 16) = pre[s];
            if (sg4 < 3) {
#pragma unroll
                for (int s = 0; s < 4; ++s) pre[s] = *(const u32x4*)(xw + (size_t)(segbase + (4 * (sg4 + 1) + s) * 16 + c) * 16); }
            __syncthreads();
#pragma unroll
            for (int s = 0; s < 4; ++s) { const int st = 4 * sg4 + s, seg = segbase + st * 16 + c;
                f32x4 a0 = (f32x4){0.f, 0.f, 0.f, 0.f}, a1 = (f32x4){0.f, 0.f, 0.f, 0.f};
#pragma unroll
                for (int ks = 0; ks < 4; ++ks) { const bf16x8 bc = *(const LAS bf16x8*)(car + (st * 16 + c) * CAR_ROWB + 64 * ks + 16 * q); a0 = MFMA16(aw[0][8 + ks], bc, a0); a1 = MFMA16(aw[1][8 + ks], bc, a1); }
#pragma unroll
                for (int ks = 0; ks < 8; ++ks) { const bf16x8 bx = *(const LAS bf16x8*)(xfr + ((s * 8 + ks) * 64 + F.lane) * 16); a0 = MFMA16(aw[0][ks], bx, a0); a1 = MFMA16(aw[1][ks], bx, a1); }
                const int m = seg * 16 + 4 * (w >> 1) + q; u32x4 o;
                o.x = cvt_pk_bf16(gelu_f(a0[0]), gelu_f(a0[1])); o.y = cvt_pk_bf16(gelu_f(a0[2]), gelu_f(a0[3])); o.z = cvt_pk_bf16(gelu_f(a1[0]), gelu_f(a1[1])); o.w = cvt_pk_bf16(gelu_f(a1[2]), gelu_f(a1[3]));
                *(u32x4*)(YG + (size_t)m * 512 + 16 * g + 8 * (w & 1)) = o; }
            __syncthreads();
        }
        __syncthreads();
    }
}

__device__ __forceinline__ void p_final(const Frame& F, float* out, const float* final_g) {
    const u64* ssq = (const u64*)(F.ws + WS_SSQ) + 2 * (size_t)MTOK; const bf16_t* XB = (const bf16_t*)(F.ws + WS_XB);
    for (int m = F.gw; m < MTOK; m += F.NGW) {
        const float rs = rsqrtf((float)ssq[m] * (1.0f / (SSQ_SCALE * (float)DM)) + RMS_EPS);
        const u32x4* xr = (const u32x4*)(XB + (size_t)m * DM) + F.lane; f32x4* orow = (f32x4*)(out + (size_t)m * DM) + 2 * F.lane; const f32x4* gr = (const f32x4*)final_g + 2 * F.lane;
#pragma unroll
        for (int j = 0; j < 4; ++j) { const u32x4 v = __builtin_nontemporal_load(xr + 64 * j); const f32x4 g0 = gr[128 * j], g1 = gr[128 * j + 1];
            __builtin_nontemporal_store((f32x4){bf_lo(v.x) * rs * g0[0], bf_hi(v.x) * rs * g0[1], bf_lo(v.y) * rs * g0[2], bf_hi(v.y) * rs * g0[3]}, orow + 128 * j);
            __builtin_nontemporal_store((f32x4){bf_lo(v.z) * rs * g1[0], bf_hi(v.z) * rs * g1[1], bf_lo(v.w) * rs * g1[2], bf_hi(v.w) * rs * g1[3]}, orow + 128 * j + 1); }
    }
}

constexpr int N_PHASES = 12;
#ifndef PROBE_PHASE
#define PROBE_PHASE (-1)
#endif
#ifndef PROBE_REPS
#define PROBE_REPS 1
#endif
#ifndef PROBE_SUB
#define PROBE_SUB 0
#endif
__global__ void __launch_bounds__(NTHR, 2) hybrid_fwd(Args args) {
    extern __shared__ __attribute__((aligned(16))) unsigned char lds_raw[];
    LAS unsigned char* lds = (LAS unsigned char*)lds_raw;
    volatile LAS unsigned* MISC = (volatile LAS unsigned*)(lds + LDSCTL_OFF);
    if (threadIdx.x < 64) MISC[threadIdx.x] = 0u;
    const int wave_s = __builtin_amdgcn_readfirstlane(threadIdx.x >> 6);
    __syncthreads();
    unsigned char* ws0 = args.ws;
    XcdBarrier bar; bar.bar = (unsigned*)(ws0 + WS_CTL) + 1024; bar.x = 0; bar.st = nullptr;
#if !MK_MULTI
    bar = xcd_barrier_post((unsigned*)(ws0 + WS_CTL) + 1024, MISC + 8);
#endif
#pragma unroll 1
    for (int ph = args.ph_lo; ph < args.ph_hi; ++ph) {
        const int l = ph == 0 ? 0 : (ph - 1) / 5, sub = ph == 0 ? 0 : (ph == N_PHASES - 1 ? 6 : 1 + (ph - 1) % 5);
        const int nrep = (ph == PROBE_PHASE) ? PROBE_REPS : 1;
#pragma unroll 1
        for (int rep = 0; rep < nrep; ++rep) {
            unsigned char* wsl = ws0; asm volatile("" : "+s"(wsl)); GAS unsigned char* ws = (GAS unsigned char*)wsl;
            int bx = blockIdx.x, gx = gridDim.x; asm volatile("" : "+s"(bx), "+s"(gx));
            if (sub == 0) { const Frame F = mkframe(ws, lds, wave_s); p0_prologue(F, args); }
            else if (sub == 1) {
                if (l == 0 && rep == 0) { const Frame F = mkframe(ws, lds, wave_s); s5_tables_a(F, args); }
                const int rbase = (gx % 8 == 0 && gx == 256) ? 4096 * (bx & 7) : -1;
                LAS float* rtab = (LAS float*)(lds + RING_BYTES);
                { const Frame F = mkframe(ws, lds, wave_s); const u64* ssq = (const u64*)(ws + WS_SSQ) + (size_t)l * MTOK;
                  if (rbase >= 0) { for (int i = F.tid; i < 4096; i += NTHR) rtab[i] = rsqrtf((float)ssq[rbase + i] * (1.0f / (SSQ_SCALE * (float)DM)) + RMS_EPS); }
                  __syncthreads(); }
                SchedIn S{gx, bx, l, (const GAS char*)ws};
                EpiIn E{ws, l, rtab, rbase};
                pg8::gemm_phase<EpiIn, SchedIn, true, true>(lds, wave_s, DM, DM, DM, S, E);
            } else if (sub == 2) {
                if (l == 0 && rep == 0) { const Frame F = mkframe(ws, lds, wave_s); s5_tables_b(F); }
                if (PROBE_SUB == 0 || PROBE_SUB == 1 || rep == 0) { const Frame F = mkframe(ws, lds, wave_s); m1_sgu(F, l); }
                if (PROBE_SUB == 0 || PROBE_SUB == 2 || rep == 0) { const Frame F = mkframe(ws, lds, wave_s); m1_send(F, l); }
                if (PROBE_SUB == 0 || PROBE_SUB == 3 || rep == 0) { const Frame F = mkframe(ws, lds, wave_s); p2_pool(F, l); }
            } else if (sub == 3) { const Frame F = mkframe(ws, lds, wave_s); m3_s5(F, l); }
            else if (sub == 4) {
                SchedMix S{gx, bx, l, (const GAS char*)ws};
                EpiMix E{ws, l};
                pg8::gemm_phase<EpiMix, SchedMix, true, true>(lds, wave_s, 512, 512, 512, S, E);
            } else if (sub == 5) {
                SchedOut S{gx, bx, l, (const GAS char*)ws};
                EpiOut E{ws, l, rep == 0 ? 1 : 0};
                pg8::gemm_phase<EpiOut, SchedOut, true, true>(lds, wave_s, DM, DM, DM, S, E);
            } else { const Frame F = mkframe(ws, lds, wave_s); p_final(F, args.out, (const float*)(ws + WS_PAR) + PAR_FG); }
#if !MK_MULTI
            if (rep + 1 < nrep) xcd_barrier(bar);
#endif
        }
#if !MK_MULTI
        if (ph + 1 < args.ph_hi) xcd_barrier(bar);
#endif
    }
}

extern "C" void kernel_launch(void* const* d_in, const int* in_sizes, int n_in, void* d_out, int out_size, void* d_ws, size_t ws_size, hipStream_t stream) {
    static int grid = 0;
    if (grid == 0) {
        if (n_in != 21 || in_sizes[0] != MTOK * DM || out_size != MTOK * DM || ws_size < WS_END) { fprintf(stderr, "kernel_launch: unexpected shapes (n_in %d, in0 %d, out %d, ws %zu)\n", n_in, n_in > 0 ? in_sizes[0] : -1, out_size, ws_size); grid = -1; return; }
        int dev = 0, cus = 0, per_cu = 0;
        if (hipGetDevice(&dev) != hipSuccess || hipDeviceGetAttribute(&cus, hipDeviceAttributeMultiprocessorCount, dev) != hipSuccess) { grid = -1; return; }
        if (hipFuncSetAttribute((const void*)hybrid_fwd, hipFuncAttributeMaxDynamicSharedMemorySize, LDS_BYTES) != hipSuccess) { fprintf(stderr, "kernel_launch: hipFuncSetAttribute failed\n"); grid = -1; return; }
        if (hipOccupancyMaxActiveBlocksPerMultiprocessor(&per_cu, (const void*)hybrid_fwd, NTHR, LDS_BYTES) != hipSuccess || per_cu < 1) { fprintf(stderr, "kernel_launch: occupancy query says %d blocks per CU\n", per_cu); per_cu = 1; }
        (void)hipGetLastError();
        grid = cus;
    }
    if (grid < 0) return;
    (void)hipMemsetAsync((char*)d_ws + WS_CTL, 0, CTL_ZERO_BYTES, stream);
    Args a{};
    for (int i = 0; i < 21; ++i) a.in[i] = (const float*)d_in[i];
    a.out = (float*)d_out; a.ws = (unsigned char*)d_ws;
#if MK_MULTI
    for (int ph = 0; ph < N_PHASES; ++ph) { a.ph_lo = ph; a.ph_hi = ph + 1; hipLaunchKernelGGL(hybrid_fwd, dim3(grid), dim3(NTHR), LDS_BYTES, stream, a); }
#else
    a.ph_lo = 0; a.ph_hi = N_PHASES;
    void* kargs[] = {&a};
    hipError_t e = hipLaunchCooperativeKernel((const void*)hybrid_fwd, dim3(grid), dim3(NTHR), kargs, LDS_BYTES, stream);
    if (e != hipSuccess) fprintf(stderr, "kernel_launch: cooperative launch failed: %s (grid %d)\n", hipGetErrorString(e), grid);
#endif
}
```
